# Optimizing an MI355X kernel written in HIP

```python
import jax, jax.numpy as jnp
from jax import lax
import numpy as np

D_MODEL = 2048
BATCH = 4
SEQ = 2048
DEPTH = 4

D_FF = 5504
RMS_EPS = 1e-6

S5_WIDTH = 1024
S5_GROUP = 16
S5_GROUPS = S5_WIDTH // S5_GROUP
S5_STATE = 64
DT_MIN = 1e-3
DT_MAX = 1e-1

ATTN_HEAD_DIM = 64
ATTN_HEADS_PER_GROUP = 8
DIL_PATTERNS = ((128, 1), (512, 4), (2048, 16))
N_DIL = len(DIL_PATTERNS)
ATTN_WIDTH = N_DIL * ATTN_HEADS_PER_GROUP * ATTN_HEAD_DIM
ATTN_OUT = ATTN_HEADS_PER_GROUP * ATTN_HEAD_DIM
Q_BLOCK = 128
ALIBI_MAX_BIAS = 8.0

RWKV_HEAD_DIM = 64
RWKV_HEADS = 16
RWKV_WIDTH = RWKV_HEADS * RWKV_HEAD_DIM
DECAY_LORA = 96
AAA_LORA = 96
MV_LORA = 64
GATE_LORA = 256
RWKV_GN_EPS = 64e-5
RWKV_SPLITS = (RWKV_WIDTH, RWKV_WIDTH, RWKV_WIDTH, DECAY_LORA, AAA_LORA, GATE_LORA)
RWKV_PART = sum(RWKV_SPLITS)

N_BRANCH = 3
IN_SPLITS = (S5_WIDTH, ATTN_WIDTH, ATTN_WIDTH, ATTN_WIDTH, RWKV_PART, N_BRANCH * D_MODEL)
D_IN = sum(IN_SPLITS)

kernel_name = 'hybrid_s5_dilattn_rwkv7_macaron'


def _split_points(sizes):
    return np.cumsum(sizes)[:-1].tolist()


def rms_norm(x, gain, eps=RMS_EPS):
    xf = x.astype(jnp.float32)
    y = xf * lax.rsqrt(jnp.mean(xf * xf, axis=-1, keepdims=True) + eps)
    return (y * gain.astype(jnp.float32)).astype(x.dtype)


def swiglu_ffn(x, norm_gain, w_up, w_down):
    h = rms_norm(x, norm_gain)
    a, b = jnp.split(h @ w_up, 2, axis=-1)
    return (jax.nn.silu(a) * b) @ w_down


def _complex_linear_combine(e1, e2):
    a1r, a1i, b1r, b1i = e1
    a2r, a2i, b2r, b2i = e2
    ar = a2r * a1r - a2i * a1i
    ai = a2r * a1i + a2i * a1r
    br = a2r * b1r - a2i * b1i + b2r
    bi = a2r * b1i + a2i * b1r + b2i
    return ar, ai, br, bi


def s5_mixer(u, a_re, a_im, b_re, b_im, c_re, c_im, log_dt, d_skip, w_glu):
    f32 = jnp.float32
    bsz, t, _ = u.shape
    uf = u.astype(f32)
    ug = uf.reshape(bsz, t, S5_GROUPS, S5_GROUP)
    lam_re = jnp.minimum(a_re.astype(f32), -1e-4)
    lam_im = a_im.astype(f32)
    dt = jnp.exp(log_dt.astype(f32))[:, None]
    mag = jnp.exp(lam_re * dt)
    ab_re = mag * jnp.cos(lam_im * dt)
    ab_im = mag * jnp.sin(lam_im * dt)
    den = lam_re * lam_re + lam_im * lam_im
    num_re = ab_re - 1.0
    coef_re = (num_re * lam_re + ab_im * lam_im) / den
    coef_im = (ab_im * lam_re - num_re * lam_im) / den
    br = b_re.astype(f32)
    bi = b_im.astype(f32)
    bb_re = coef_re[..., None] * br - coef_im[..., None] * bi
    bb_im = coef_re[..., None] * bi + coef_im[..., None] * br
    bu_re = jnp.einsum('gph,btgh->btgp', bb_re, ug)
    bu_im = jnp.einsum('gph,btgh->btgp', bb_im, ug)
    a_re_t = jnp.broadcast_to(ab_re, bu_re.shape)
    a_im_t = jnp.broadcast_to(ab_im, bu_im.shape)
    _, _, s_re, s_im = lax.associative_scan(
        _complex_linear_combine, (a_re_t, a_im_t, bu_re, bu_im), axis=1)
    y = (jnp.einsum('ghp,btgp->btgh', c_re.astype(f32), s_re)
         - jnp.einsum('ghp,btgp->btgh', c_im.astype(f32), s_im))
    y = y.reshape(bsz, t, S5_WIDTH) + d_skip.astype(f32) * uf
    z = jax.nn.gelu(y).astype(u.dtype)
    return z * jax.nn.sigmoid(z @ w_glu)


def alibi_slopes(n_heads):
    s = 2.0 ** (-ALIBI_MAX_BIAS * (np.arange(n_heads) + 1) / n_heads)
    return jnp.asarray(s, dtype=jnp.float32)


def dilated_group_attention(q, k, v, slopes, window, dilation):
    f32 = jnp.float32
    bsz, t, h, hd = q.shape
    n_keys = window // dilation + 1
    offs = dilation * jnp.arange(n_keys)
    bias = -slopes[:, None] * offs[None, :].astype(f32)
    scale = hd ** -0.5

    def block(t0):
        qb = lax.dynamic_slice_in_dim(q, t0, Q_BLOCK, axis=1)
        pos = t0 + jnp.arange(Q_BLOCK)
        kpos = pos[:, None] - offs[None, :]
        valid = kpos >= 0
        kidx = jnp.maximum(kpos, 0)
        kb = jnp.take(k, kidx, axis=1)
        vb = jnp.take(v, kidx, axis=1)
        s = jnp.einsum('bqhd,bqkhd->bhqk', qb, kb).astype(f32) * scale + bias[None, :, None, :]
        s = jnp.where(valid[None, None], s, -jnp.inf)
        lse = jax.nn.logsumexp(s, axis=-1)
        p = jnp.exp(s - lse[..., None])
        o = jnp.einsum('bhqk,bqkhd->bqhd', p, vb.astype(f32))
        return o, lse

    starts = jnp.arange(t // Q_BLOCK, dtype=jnp.int32) * Q_BLOCK
    o, lse = lax.map(block, starts)
    o = jnp.moveaxis(o, 0, 1).reshape(bsz, t, h, hd)
    lse = jnp.moveaxis(lse, 0, 2).reshape(bsz, h, t)
    return o, lse


def dilated_attention_mixer(q, k, v, q_gain, k_gain):
    bsz, t, _ = q.shape
    shp = (bsz, t, N_DIL, ATTN_HEADS_PER_GROUP, ATTN_HEAD_DIM)
    q = rms_norm(q.reshape(shp), q_gain)
    k = rms_norm(k.reshape(shp), k_gain)
    v = v.reshape(shp)
    slopes = alibi_slopes(N_DIL * ATTN_HEADS_PER_GROUP).reshape(N_DIL, ATTN_HEADS_PER_GROUP)
    outs, lses = [], []
    for gi, (window, dilation) in enumerate(DIL_PATTERNS):
        o, lse = dilated_group_attention(q[:, :, gi], k[:, :, gi], v[:, :, gi],
                                         slopes[gi], window, dilation)
        outs.append(o)
        lses.append(lse)
    w = jax.nn.softmax(jnp.stack(lses, axis=0), axis=0)
    w = jnp.transpose(w, (0, 1, 3, 2))[..., None]
    o = jnp.sum(w * jnp.stack(outs, axis=0), axis=0)
    return o.reshape(bsz, t, ATTN_OUT).astype(q.dtype)


def wkv7_scan(r, w, k, v, a, b):
    bsz, t, h, n = r.shape

    def step(S, inp):
        r_t, w_t, k_t, v_t, a_t, b_t = inp
        sa = jnp.einsum('bhij,bhj->bhi', S, a_t)
        S = (S * w_t[:, :, None, :] + sa[..., None] * b_t[:, :, None, :]
             + v_t[..., None] * k_t[:, :, None, :])
        return S, jnp.einsum('bhij,bhj->bhi', S, r_t)

    xs = tuple(jnp.moveaxis(z, 1, 0) for z in (r, w, k, v, a, b))
    S0 = jnp.zeros((bsz, h, n, n), jnp.float32)
    _, y = lax.scan(step, S0, xs)
    return jnp.moveaxis(y, 0, 1)


def rwkv7_mixer(p, v_first, shift_mu, w0, w2, a0, a2, g2, k_k, k_a, r_k, ln_w, ln_b, vres):
    f32 = jnp.float32
    bsz, t, _ = p.shape
    p_prev = jnp.pad(p, ((0, 0), (1, 0), (0, 0)))[:, :-1]
    p = p + (p_prev - p) * shift_mu
    r, k, v, wd, ad, gd = jnp.split(p, _split_points(RWKV_SPLITS), axis=-1)
    w = -jax.nn.softplus(-(w0 + jnp.tanh(wd) @ w2)) - 0.5
    a = jax.nn.sigmoid(a0 + ad @ a2)
    g = jax.nn.sigmoid(gd) @ g2
    if vres is None:
        v_first = v
    else:
        v0, v1, v2 = vres
        v = v + (v_first - v) * jax.nn.sigmoid(v0 + (v @ v1) @ v2)

    def heads(z):
        return z.reshape(bsz, t, RWKV_HEADS, RWKV_HEAD_DIM).astype(f32)

    kk = heads(k * k_k)
    kk = kk * lax.rsqrt(jnp.maximum(jnp.sum(kk * kk, axis=-1, keepdims=True), 1e-24))
    k = k * (1.0 + (a - 1.0) * k_a)
    decay = jnp.exp(-jnp.exp(heads(w)))
    rh, kh, vh = heads(r), heads(k), heads(v)
    y = wkv7_scan(rh, decay, kh, vh, -kk, kk * heads(a))
    mean = jnp.mean(y, axis=-1, keepdims=True)
    var = jnp.mean(jnp.square(y - mean), axis=-1, keepdims=True)
    y = (y - mean) * lax.rsqrt(var + RWKV_GN_EPS)
    y = y * ln_w.astype(f32).reshape(RWKV_HEADS, RWKV_HEAD_DIM) + ln_b.astype(f32).reshape(RWKV_HEADS, RWKV_HEAD_DIM)
    y = y + jnp.sum(rh * kh * r_k.astype(f32), axis=-1, keepdims=True) * vh
    y = y.reshape(bsz, t, RWKV_WIDTH).astype(p.dtype)
    return y * g, v_first


def setup_inputs(seed: int = 0) -> dict:
    key = jax.random.key(seed)
    keys = jax.random.split(key, 48)
    counter = [0]
    f32 = jnp.float32

    def nk():
        kk = keys[counter[0]]
        counter[0] += 1
        return kk

    def nrm(shape, scale):
        return scale * jax.random.normal(nk(), shape, f32)

    def gain(shape):
        return 1.0 + nrm(shape, 0.02)

    L, D = DEPTH, D_MODEL
    G, P, Hc = S5_GROUPS, S5_STATE, S5_GROUP
    RW = RWKV_WIDTH
    inp = {}
    inp['x'] = nrm((BATCH, SEQ, D), 1.0)
    inp['ffn1_norm'] = gain((L, D))
    inp['ffn1_up'] = nrm((L, D, 2 * D_FF), D ** -0.5)
    inp['ffn1_down'] = nrm((L, D_FF, D), D_FF ** -0.5)
    inp['mix_norm'] = gain((L, D))
    inp['w_in'] = nrm((L, D, D_IN), D ** -0.5)
    inp['s5_a_re'] = -0.5 + nrm((L, G, P), 0.01)
    inp['s5_a_im'] = np.pi * jnp.arange(P, dtype=f32) + nrm((L, G, P), 0.01)
    inp['s5_b_re'] = nrm((L, G, P, Hc), (2 * Hc) ** -0.5)
    inp['s5_b_im'] = nrm((L, G, P, Hc), (2 * Hc) ** -0.5)
    inp['s5_c_re'] = nrm((L, G, Hc, P), P ** -0.5)
    inp['s5_c_im'] = nrm((L, G, Hc, P), P ** -0.5)
    inp['s5_log_dt'] = jax.random.uniform(nk(), (L, G), f32, float(np.log(DT_MIN)), float(np.log(DT_MAX)))
    inp['s5_d'] = nrm((L, S5_WIDTH), 1.0)
    inp['s5_w_glu'] = nrm((L, S5_WIDTH, S5_WIDTH), S5_WIDTH ** -0.5)
    inp['attn_q_gain'] = gain((L, ATTN_HEAD_DIM))
    inp['attn_k_gain'] = gain((L, ATTN_HEAD_DIM))
    inp['rwkv_shift_mu'] = jax.random.uniform(nk(), (L, RWKV_PART), f32)
    inp['rwkv_w0'] = jnp.tile(jnp.linspace(-6.5, -1.5, RWKV_HEAD_DIM, dtype=f32), RWKV_HEADS) + nrm((L, RW), 0.1)
    inp['rwkv_w2'] = nrm((L, DECAY_LORA, RW), 0.5 * DECAY_LORA ** -0.5)
    inp['rwkv_a0'] = nrm((L, RW), 0.1)
    inp['rwkv_a2'] = nrm((L, AAA_LORA, RW), AAA_LORA ** -0.5)
    inp['rwkv_g2'] = nrm((L, GATE_LORA, RW), GATE_LORA ** -0.5)
    inp['rwkv_k_k'] = 0.85 + nrm((L, RW), 0.02)
    inp['rwkv_k_a'] = gain((L, RW))
    inp['rwkv_r_k'] = nrm((L, RWKV_HEADS, RWKV_HEAD_DIM), 0.1)
    inp['rwkv_ln_w'] = gain((L, RW))
    inp['rwkv_ln_b'] = nrm((L, RW), 0.01)
    inp['rwkv_v0'] = 1.0 + nrm((L - 1, RW), 0.1)
    inp['rwkv_v1'] = nrm((L - 1, RW, MV_LORA), RW ** -0.5)
    inp['rwkv_v2'] = nrm((L - 1, MV_LORA, RW), MV_LORA ** -0.5)
    inp['w_branch_s5'] = nrm((L, S5_WIDTH, D), S5_WIDTH ** -0.5)
    inp['w_branch_attn'] = nrm((L, ATTN_OUT, D), ATTN_OUT ** -0.5)
    inp['w_branch_rwkv'] = nrm((L, RW, D), RW ** -0.5)
    inp['w_out'] = nrm((L, D, D), D ** -0.5)
    inp['ffn2_norm'] = gain((L, D))
    inp['ffn2_up'] = nrm((L, D, 2 * D_FF), D ** -0.5)
    inp['ffn2_down'] = nrm((L, D_FF, D), D_FF ** -0.5)
    return inp


def reference(x, ffn1_norm, ffn1_up, ffn1_down, mix_norm, w_in,
              s5_a_re, s5_a_im, s5_b_re, s5_b_im, s5_c_re, s5_c_im, s5_log_dt, s5_d, s5_w_glu,
              attn_q_gain, attn_k_gain,
              rwkv_shift_mu, rwkv_w0, rwkv_w2, rwkv_a0, rwkv_a2, rwkv_g2, rwkv_k_k, rwkv_k_a,
              rwkv_r_k, rwkv_ln_w, rwkv_ln_b, rwkv_v0, rwkv_v1, rwkv_v2,
              w_branch_s5, w_branch_attn, w_branch_rwkv, w_out,
              ffn2_norm, ffn2_up, ffn2_down):
    bsz, t, _ = x.shape
    v_first = None
    for l in range(DEPTH):
        x = x + 0.5 * swiglu_ffn(x, ffn1_norm[l], ffn1_up[l], ffn1_down[l])
        h = rms_norm(x, mix_norm[l])
        proj = h @ w_in[l]
        u_s5, q, k, v, p_rwkv, gate_logits = jnp.split(proj, _split_points(IN_SPLITS), axis=-1)
        y_s5 = s5_mixer(u_s5, s5_a_re[l], s5_a_im[l], s5_b_re[l], s5_b_im[l],
                        s5_c_re[l], s5_c_im[l], s5_log_dt[l], s5_d[l], s5_w_glu[l])
        y_attn = dilated_attention_mixer(q, k, v, attn_q_gain[l], attn_k_gain[l])
        vres = None if l == 0 else (rwkv_v0[l - 1], rwkv_v1[l - 1], rwkv_v2[l - 1])
        y_rwkv, v_first = rwkv7_mixer(p_rwkv, v_first, rwkv_shift_mu[l], rwkv_w0[l], rwkv_w2[l],
                                      rwkv_a0[l], rwkv_a2[l], rwkv_g2[l], rwkv_k_k[l], rwkv_k_a[l],
                                      rwkv_r_k[l], rwkv_ln_w[l], rwkv_ln_b[l], vres)
        gates = jax.nn.sigmoid(gate_logits).reshape(bsz, t, N_BRANCH, D_MODEL)
        merged = (gates[:, :, 0] * (y_s5 @ w_branch_s5[l])
                  + gates[:, :, 1] * (y_attn @ w_branch_attn[l])
                  + gates[:, :, 2] * (y_rwkv @ w_branch_rwkv[l]))
        x = x + merged @ w_out[l]
        x = x + 0.5 * swiglu_ffn(x, ffn2_norm[l], ffn2_up[l], ffn2_down[l])
    return x
```

```cpp
#include <hip/hip_runtime.h>
#include <cstdio>
#include <cstdint>

#ifndef MK_ONE_LAUNCH
#define MK_ONE_LAUNCH 1
#endif

namespace pg8 {
#define PG8_LAS __attribute__((address_space(3)))
typedef unsigned short bf16_t;
typedef short bf16x8 __attribute__((ext_vector_type(8)));
typedef float f32x4 __attribute__((ext_vector_type(4)));
typedef unsigned u32x4 __attribute__((ext_vector_type(4)));
constexpr int BM = 256, BK = 64, HALF = 128, HTB = HALF * BK * 2, STAGE_BYTES = 8 * HTB, NXCD = 8, WGM = 8;

__host__ __device__ __forceinline__ int lds_byte(int r, int c) { const int st = (r >> 4) * 2 + (c >> 5), rr = r & 15, cc = c & 31, ob = rr * 64 + cc * 2; return st * 1024 + (ob ^ (((ob >> 9) & 1) << 5)); }
__host__ __device__ __forceinline__ void stage_rc(int b, int& R, int& C) { const int st = b / 1024, sb = b % 1024, swz = sb ^ (((sb >> 9) & 1) << 5); R = (st >> 1) * 16 + swz / 64; C = (st & 1) * 32 + (swz % 64) / 2; }
__host__ __device__ __forceinline__ int perm32(int rho) { const int n = rho >> 4, i = rho & 15; return 8 * (i >> 2) + 4 * n + (i & 3); }

struct Unit { int pm, pn; };
struct Gemm { const bf16_t* A; const bf16_t* Bt; int M, N, K, lda, ldb; };

struct StaticOrder {
    int nM, nN, nwg, G, c;
    __host__ __device__ void init(int M, int N, int G_, int c_) { nM = M / BM; nN = N / BM; nwg = nM * nN; G = G_; c = c_; }
    __host__ __device__ bool next(int i, Unit& u) const {
        const long L = (long)i * G + c; if (L >= nwg) return false;
        int wgid = (int)L; { const int q = nwg / NXCD, r = nwg % NXCD, xcd = wgid % NXCD, off = wgid / NXCD; wgid = (xcd < r ? xcd * (q + 1) : r * (q + 1) + (xcd - r) * q) + off; }
        const int nig = WGM * nN, gid = wgid / nig, fm = gid * WGM, gsz = (nM - fm) < WGM ? (nM - fm) : WGM;
        u.pm = fm + ((wgid % nig) % gsz); u.pn = (wgid % nig) / gsz; return true;
    }
    __device__ __forceinline__ void a_ready(const Unit&) const {}
    __device__ __forceinline__ void done(const Unit&) const {}
};

__device__ __forceinline__ unsigned cvt_pk_bf16(float lo, float hi) { unsigned r; asm volatile("v_cvt_pk_bf16_f32 %0, %1, %2" : "=v"(r) : "v"(lo), "v"(hi)); return r; }

template <class Epi, class Sched, bool ALIGN_EPI = false, bool SP2 = false>
__device__ __forceinline__ void gemm_phase(PG8_LAS unsigned char* lds, const Gemm g, const Sched& S, const Epi& E, int tid_) {
    asm volatile("" : "+v"(tid_));
    const int tid = tid_, wid = __builtin_amdgcn_readfirstlane(tid >> 6), lane = tid & 63, wr = wid >> 2, wc = wid & 3, fr = lane & 15, fq = lane >> 4;
    const int K = g.K, nt = K / BK;
    unsigned voffA[2], voffB[2];
#pragma unroll
    for (int i = 0; i < 2; ++i) { int R, C; stage_rc(tid * 16 + i * 8192, R, C); const int Rb = Epi::PERM ? ((R & ~31) + perm32(R & 31)) : R;
        voffA[i] = (unsigned)(R * g.lda + C) * 2u; voffB[i] = (unsigned)(Rb * g.ldb + C) * 2u; }
    const size_t kstep = (size_t)(BK * 2);
    const size_t hstepA = (size_t)HALF * g.lda * 2, hstepB = (size_t)HALF * g.ldb * 2;
    const size_t tstepA = 2 * hstepA, tstepB = 2 * hstepB;
    const unsigned ldsw = (unsigned)wid * 1024u;
    const int aoff = lds_byte(wr * 64 + fr, fq * 8), boff = lds_byte(wc * 32 + fr, fq * 8);
#define PG8_SA(b, h) (((b) * 2 + (h)) * HTB)
#define PG8_SB(b, h) ((4 + (b) * 2 + (h)) * HTB)
#define PG8_STAGE(bufoff, gbase, voff) do { _Pragma("unroll") for (int _i = 0; _i < 2; ++_i) \
        __builtin_amdgcn_global_load_lds((const unsigned*)((const char*)(gbase) + (voff)[_i]), (PG8_LAS unsigned*)(lds + (bufoff) + ldsw + _i * 8192), 16, 0, 0); } while (0)
#define PG8_LDA(dst, b, h) do { _Pragma("unroll") for (int m = 0; m < 4; ++m) _Pragma("unroll") for (int k = 0; k < 2; ++k) dst[m][k] = *(const PG8_LAS bf16x8*)(lds + PG8_SA(b, h) + aoff + m * 2048 + k * 1024); } while (0)
#define PG8_LDB(dst, b, h) do { _Pragma("unroll") for (int n = 0; n < 2; ++n) _Pragma("unroll") for (int k = 0; k < 2; ++k) dst[n][k] = *(const PG8_LAS bf16x8*)(lds + PG8_SB(b, h) + boff + n * 2048 + k * 1024); } while (0)
#define PG8_MMA(ai, bj, At, Bt) do { __builtin_amdgcn_s_setprio(1); _Pragma("unroll") for (int m = 0; m < 4; ++m) _Pragma("unroll") for (int n = 0; n < 2; ++n) _Pragma("unroll") for (int k = 0; k < 2; ++k) \
        acc[ai][bj][m][n] = __builtin_amdgcn_mfma_f32_16x16x32_bf16(Bt[n][k], At[m][k], acc[ai][bj][m][n], 0, 0, 0); __builtin_amdgcn_s_setprio(0); } while (0)
#define PG8_WAIT_V(n) asm volatile("s_waitcnt vmcnt(" #n ")" ::: "memory")
#define PG8_WAIT_L(n) asm volatile("s_waitcnt lgkmcnt(" #n ")" ::: "memory")
#define PG8_BAR __builtin_amdgcn_s_barrier()
#define PG8_SCHED __builtin_amdgcn_sched_barrier(0)
    Unit cur, nxt; int ui = 0;
    if (!S.next(0, cur)) return;
    f32x4 acc[2][2][4][2];
#pragma unroll
    for (int a = 0; a < 2; ++a)
#pragma unroll
        for (int b = 0; b < 2; ++b)
#pragma unroll
            for (int m = 0; m < 4; ++m)
#pragma unroll
                for (int n = 0; n < 2; ++n) acc[a][b][m][n] = (f32x4){0.f, 0.f, 0.f, 0.f};
    bf16x8 At[4][2], B0[2][2], B1[2][2];
    const char* cA = (const char*)g.A + (size_t)cur.pm * tstepA; const char* cB = (const char*)g.Bt + (size_t)cur.pn * tstepB;
    S.a_ready(cur);
    if constexpr (SP2) {
        PG8_STAGE(PG8_SB(0, 0), cB, voffB); PG8_STAGE(PG8_SB(0, 1), cB + hstepB, voffB); PG8_STAGE(PG8_SA(0, 0), cA, voffA); PG8_STAGE(PG8_SA(0, 1), cA + hstepA, voffA);
        if (wr == 1) PG8_BAR;
        PG8_WAIT_V(2); PG8_BAR;
        PG8_STAGE(PG8_SB(1, 0), cB + kstep, voffB); PG8_STAGE(PG8_SA(1, 0), cA + kstep, voffA); PG8_STAGE(PG8_SB(1, 1), cB + hstepB + kstep, voffB);
        PG8_WAIT_V(6); PG8_BAR;
    } else {
        PG8_STAGE(PG8_SB(0, 0), cB, voffB); PG8_STAGE(PG8_SA(0, 0), cA, voffA); PG8_STAGE(PG8_SB(0, 1), cB + hstepB, voffB); PG8_STAGE(PG8_SA(0, 1), cA + hstepA, voffA);
        if (wr == 1) PG8_BAR;
        PG8_WAIT_V(4); PG8_BAR;
        PG8_STAGE(PG8_SB(1, 0), cB + kstep, voffB); PG8_STAGE(PG8_SA(1, 0), cA + kstep, voffA); PG8_STAGE(PG8_SB(1, 1), cB + hstepB + kstep, voffB);
        PG8_WAIT_V(6); PG8_BAR;
    }
    for (;;) {
        const bool has_next = S.next(ui + 1, nxt);
        const char* nA = has_next ? (const char*)g.A + (size_t)nxt.pm * tstepA : cA; const char* nB = has_next ? (const char*)g.Bt + (size_t)nxt.pn * tstepB : cB;
        for (int t = 0; t < nt; t += 2) {
            const bool last = (t == nt - 2);
            const char* a1 = cA + (size_t)(t + 1) * kstep;
            const char* a2 = last ? nA : cA + (size_t)(t + 2) * kstep; const char* b2 = last ? nB : cB + (size_t)(t + 2) * kstep;
            const char* a3 = a2 + kstep; const char* b3 = b2 + kstep;
            if (last && has_next) S.a_ready(nxt);
            if constexpr (SP2) {
            PG8_LDB(B0, 0, 0); PG8_LDB(B1, 0, 1); PG8_SCHED; PG8_LDA(At, 0, 0); PG8_STAGE(PG8_SA(1, 1), a1 + hstepA, voffA);
            PG8_WAIT_V(8); PG8_WAIT_L(0); PG8_BAR; PG8_MMA(0, 0, At, B0); PG8_MMA(0, 1, At, B1); PG8_BAR; PG8_SCHED;
            PG8_LDA(At, 0, 1); PG8_STAGE(PG8_SB(0, 0), b2, voffB); PG8_STAGE(PG8_SB(0, 1), b2 + hstepB, voffB); PG8_STAGE(PG8_SA(0, 0), a2, voffA);
            PG8_WAIT_V(8); PG8_WAIT_L(0); PG8_BAR; PG8_MMA(1, 0, At, B0); PG8_MMA(1, 1, At, B1); PG8_BAR; PG8_SCHED;
            PG8_LDB(B0, 1, 0); PG8_LDB(B1, 1, 1); PG8_SCHED; PG8_LDA(At, 1, 0); PG8_STAGE(PG8_SA(0, 1), a2 + hstepA, voffA);
            PG8_WAIT_V(8); PG8_WAIT_L(0); PG8_BAR; PG8_MMA(0, 0, At, B0); PG8_MMA(0, 1, At, B1); PG8_BAR; PG8_SCHED;
            PG8_LDA(At, 1, 1); PG8_STAGE(PG8_SB(1, 0), b3, voffB); PG8_STAGE(PG8_SB(1, 1), b3 + hstepB, voffB); PG8_STAGE(PG8_SA(1, 0), a3, voffA);
            PG8_WAIT_V(8); PG8_WAIT_L(0); PG8_BAR; PG8_MMA(1, 0, At, B0); PG8_MMA(1, 1, At, B1); PG8_BAR; PG8_SCHED;
            } else {
            PG8_LDB(B0, 0, 0); PG8_SCHED; PG8_LDA(At, 0, 0); PG8_STAGE(PG8_SA(1, 1), a1 + hstepA, voffA);
            PG8_WAIT_L(8); PG8_BAR; PG8_WAIT_L(0); PG8_MMA(0, 0, At, B0); PG8_BAR; PG8_SCHED;
            PG8_LDB(B1, 0, 1); PG8_STAGE(PG8_SB(0, 0), b2, voffB);
            PG8_BAR; PG8_WAIT_L(0); PG8_MMA(0, 1, At, B1); PG8_BAR;
            PG8_LDA(At, 0, 1); PG8_STAGE(PG8_SA(0, 0), a2, voffA);
            PG8_BAR; PG8_WAIT_L(0); PG8_MMA(1, 0, At, B0); PG8_BAR; PG8_SCHED;
            PG8_STAGE(PG8_SB(0, 1), b2 + hstepB, voffB);
            PG8_WAIT_V(6); PG8_BAR; PG8_MMA(1, 1, At, B1); PG8_BAR;
            PG8_LDB(B0, 1, 0); PG8_SCHED; PG8_LDA(At, 1, 0); PG8_STAGE(PG8_SA(0, 1), a2 + hstepA, voffA);
            PG8_WAIT_L(8); PG8_BAR; PG8_WAIT_L(0); PG8_MMA(0, 0, At, B0); PG8_BAR; PG8_SCHED;
            PG8_LDB(B1, 1, 1); PG8_STAGE(PG8_SB(1, 0), b3, voffB);
            PG8_BAR; PG8_WAIT_L(0); PG8_MMA(0, 1, At, B1); PG8_BAR;
            PG8_LDA(At, 1, 1); PG8_STAGE(PG8_SA(1, 0), a3, voffA);
            PG8_BAR; PG8_WAIT_L(0); PG8_MMA(1, 0, At, B0); PG8_BAR; PG8_SCHED;
            PG8_STAGE(PG8_SB(1, 1), b3 + hstepB, voffB);
            PG8_WAIT_V(6); PG8_BAR; PG8_MMA(1, 1, At, B1); PG8_BAR;
            }
        }
        if constexpr (ALIGN_EPI) { if (wr == 0) PG8_BAR; }
        E(acc, cur, wr, wc, fr, fq); S.done(cur);
        if (!has_next) break;
#pragma unroll
        for (int a = 0; a < 2; ++a)
#pragma unroll
            for (int b = 0; b < 2; ++b)
#pragma unroll
                for (int m = 0; m < 4; ++m)
#pragma unroll
                    for (int n = 0; n < 2; ++n) acc[a][b][m][n] = (f32x4){0.f, 0.f, 0.f, 0.f};
        cur = nxt; cA = nA; cB = nB; ++ui;
        if constexpr (ALIGN_EPI) { if (wr == 1) PG8_BAR; }
    }
    PG8_WAIT_V(0);
    if constexpr (!ALIGN_EPI) { if (wr == 0) PG8_BAR; }
    PG8_BAR;
#undef PG8_SA
#undef PG8_SB
#undef PG8_STAGE
#undef PG8_LDA
#undef PG8_LDB
#undef PG8_MMA
#undef PG8_WAIT_V
#undef PG8_WAIT_L
#undef PG8_BAR
#undef PG8_SCHED
}
}

constexpr int NWAVES = 8;
constexpr int M = 8192, T = 2048, D = 2048, DFF = 5504, NUP = 2 * DFF, DIN = 15296, DINP = 15360, DEPTH = 4;
constexpr int U_OFF = 0, Q_OFF = 1024, K_OFF = 2560, V_OFF = 4096, RW_OFF = 5632, GATE_OFF = 9152;
constexpr int RWP = 3520, RW = 1024, AW = 1536;
constexpr float RMS_EPS = 1e-6f;
constexpr int NPH = 15;
constexpr int NPHASES = 1 + DEPTH * NPH;

constexpr size_t MiB = 1u << 20;
constexpr size_t WS_CTL = 0, CTL_ZERO_BYTES = 1 * MiB;
constexpr int CW_BAR = 4096;
constexpr size_t SS_OFF = 256 * 1024;
constexpr size_t WS_X = 1 * MiB;
constexpr size_t WS_XB = WS_X + 64 * MiB;
constexpr size_t WS_HID = WS_XB + 32 * MiB;
constexpr size_t WS_PROJ = WS_HID + 86 * MiB;
constexpr size_t WS_W = WS_PROJ + 240 * MiB;
constexpr size_t W_UP1 = WS_W, W_DN1 = W_UP1 + 43 * MiB, W_IN = W_DN1 + 22 * MiB, W_GLU = W_IN + 60 * MiB, W_W2 = W_GLU + 2 * MiB, W_A2 = W_W2 + MiB / 2,
                 W_G2 = W_A2 + MiB / 2, W_V1 = W_G2 + MiB / 2, W_V2 = W_V1 + MiB / 2, W_BS5 = W_V2 + MiB / 2, W_BAT = W_BS5 + 4 * MiB, W_BRW = W_BAT + 2 * MiB,
                 W_OUT = W_BRW + 4 * MiB, W_UP2 = W_OUT + 8 * MiB, W_DN2 = W_UP2 + 43 * MiB, WS_WEND = W_DN2 + 22 * MiB;
constexpr size_t WS_RP = WS_WEND, WS_KP = WS_RP + 32 * MiB, WS_VP = WS_KP + 32 * MiB, WS_DECAY = WS_VP + 32 * MiB, WS_ASIG = WS_DECAY + 32 * MiB, WS_G = WS_ASIG + 32 * MiB,
                 WS_KK = WS_G + 32 * MiB, WS_VFIRST = WS_KK + 32 * MiB, WS_YRAW = WS_VFIRST + 32 * MiB;
constexpr size_t WS_LORA = WS_YRAW + 32 * MiB;
constexpr size_t WS_AV = WS_LORA + 12 * MiB;
constexpr size_t WS_V1O = WS_AV + 16 * MiB;
constexpr size_t WS_QN = WS_V1O + 4 * MiB, WS_KN = WS_QN + 24 * MiB;
constexpr size_t WS_Z = WS_KN + 24 * MiB, WS_YS5 = WS_Z + 16 * MiB, WS_YATT = WS_YS5 + 16 * MiB, WS_YRWKV = WS_YATT + 8 * MiB;
constexpr size_t WS_MERGED = WS_YRWKV + 16 * MiB, WS_MERGEDB = WS_MERGED + 64 * MiB;
constexpr size_t WS_SBUF = WS_MERGEDB + 32 * MiB;
constexpr size_t WS_SSP = WS_SBUF + 256 * MiB;
constexpr size_t WS_END = WS_SSP + 16 * MiB;

constexpr int RING_OFF = 0, RING_BYTES = 131072, LDSCTL_OFF = RING_BYTES, LDS_BYTES = 147456;

#define GAS __attribute__((address_space(1)))
#define LAS __attribute__((address_space(3)))
typedef unsigned short bf16;
typedef unsigned v4u __attribute__((ext_vector_type(4)));
typedef unsigned v2u __attribute__((ext_vector_type(2)));
typedef float f32x4 __attribute__((ext_vector_type(4)));
typedef float f32x2 __attribute__((ext_vector_type(2)));
#define LDS_WAIT() asm volatile("s_waitcnt lgkmcnt(0)" ::: "memory")
#define VM_WAIT() asm volatile("s_waitcnt vmcnt(0)" ::: "memory")
__device__ __forceinline__ unsigned f2bf(float f) { unsigned u = __builtin_bit_cast(unsigned, f); return (u + 0x7fffu + ((u >> 16) & 1u)) >> 16; }
__device__ __forceinline__ unsigned pk2(float lo, float hi) { return f2bf(lo) | (f2bf(hi) << 16); }
__device__ __forceinline__ float bf2f(unsigned short b) { return __builtin_bit_cast(float, (unsigned)b << 16); }
__device__ __forceinline__ float bflo(unsigned w) { return __builtin_bit_cast(float, w << 16); }
__device__ __forceinline__ float bfhi(unsigned w) { return __builtin_bit_cast(float, w & 0xffff0000u); }
__device__ __forceinline__ float wave_sum(float v) {
#pragma unroll
    for (int o = 32; o >= 1; o >>= 1) v += __shfl_xor(v, o);
    return v;
}
__device__ __forceinline__ float sigmoidf_(float x) { return 1.0f / (1.0f + __expf(-x)); }

#define XB_TMO      128
#define XB_XCNT(j)  (256  + 64 * (j))
#define XB_XSUB(j)  (1280 + 64 * (j))
#define XB_XGEN(j)  (2304 + 64 * (j))
#define XB_TOP      3328
#define XB_TOPGEN   3392
#define XCD_BAR_WORDS 3456
#define XB_SPIN_CAP (1u << 18)
__device__ __forceinline__ unsigned xb_ld(unsigned* p)              { return __hip_atomic_load(p, __ATOMIC_RELAXED, __HIP_MEMORY_SCOPE_AGENT); }
__device__ __forceinline__ unsigned xb_add(unsigned* p, unsigned v) { return __hip_atomic_fetch_add(p, v, __ATOMIC_RELAXED, __HIP_MEMORY_SCOPE_AGENT); }
__device__ __forceinline__ unsigned xb_xcc_id() { return (unsigned)__builtin_amdgcn_s_getreg((3 << 11) | 20) & 0xFu; }
#define XB_SPIN(cond, bar) do { unsigned _sp = 0; while (cond) { __builtin_amdgcn_s_sleep(1); \
    if ((++_sp & 255u) == 0u) { if (xb_ld(&(bar)[XB_TMO])) break; if (_sp > XB_SPIN_CAP) { atomicAdd(&(bar)[XB_TMO], 1u); break; } } } } while (0)
struct XcdBarrier { unsigned* bar; unsigned x; volatile LAS unsigned* st; };
__device__ __forceinline__ XcdBarrier xcd_barrier_post(unsigned* bar, volatile LAS unsigned* st) {
    XcdBarrier b; b.bar = bar; b.x = xb_xcc_id(); b.st = st;
    if (threadIdx.x == 0) (void)xb_add(&bar[XB_XCNT(b.x)], 1u);
    return b;
}
__device__ __forceinline__ void xcd_barrier_complete(unsigned* bar, unsigned x, unsigned& nloc, unsigned& nx) {
    const unsigned G = gridDim.x * gridDim.y * gridDim.z;
    unsigned sum, cnt, mine, sp = 0u;
    for (;;) {
        sum = 0u; cnt = 0u; mine = 0u;
#pragma unroll
        for (unsigned j = 0; j < 16; ++j) { const unsigned c = xb_ld(&bar[XB_XCNT(j)]); sum += c; cnt += (c > 0u) ? 1u : 0u; mine = (j == x) ? c : mine; }
        if (sum == G) break;
        __builtin_amdgcn_s_sleep(1);
        if ((++sp & 255u) == 0u) { if (xb_ld(&bar[XB_TMO])) break; if (sp > XB_SPIN_CAP) { atomicAdd(&bar[XB_TMO], 1u); break; } }
    }
    nloc = mine > 0u ? mine : 1u; nx = cnt > 0u ? cnt : 1u;
}
__device__ __forceinline__ void xcd_barrier(const XcdBarrier& b) {
    asm volatile("s_waitcnt vmcnt(0)" ::: "memory");
    __syncthreads();
    if (threadIdx.x == 0) {
        unsigned* bar = b.bar;
        __builtin_amdgcn_s_waitcnt(0);
        unsigned nloc = b.st[0], nx = b.st[1];
        if (nloc == 0u) { xcd_barrier_complete(bar, b.x, nloc, nx); b.st[0] = nloc; b.st[1] = nx; }
        const unsigned old = xb_add(&bar[XB_XSUB(b.x)], 1u);
        const unsigned gen = old / nloc;
        if (old + 1u == (gen + 1u) * nloc) {
            __builtin_amdgcn_fence(__ATOMIC_RELEASE, "agent");
            asm volatile("s_waitcnt vmcnt(0)" ::: "memory");
            const unsigned og = xb_add(&bar[XB_TOP], 1u);
            const unsigned tg = og / nx;
            if (og + 1u == (tg + 1u) * nx) xb_add(&bar[XB_TOPGEN], 1u);
            else XB_SPIN(xb_ld(&bar[XB_TOPGEN]) == tg, bar);
            __builtin_amdgcn_fence(__ATOMIC_ACQUIRE, "agent");
            xb_add(&bar[XB_XGEN(b.x)], 1u);
            asm volatile("s_waitcnt vmcnt(0)" ::: "memory");
        } else {
            XB_SPIN(xb_ld(&bar[XB_XGEN(b.x)]) == gen, bar);
            __builtin_amdgcn_fence(__ATOMIC_ACQUIRE, "agent");
            asm volatile("s_waitcnt vmcnt(0)" ::: "memory");
        }
    }
    __syncthreads();
}

using pg8::Unit; using pg8::cvt_pk_bf16;
__device__ __forceinline__ int fresh_lane() { int l; asm volatile("v_mbcnt_lo_u32_b32 %0, -1, 0\n\tv_mbcnt_hi_u32_b32 %0, -1, %0" : "=v"(l)); return l; }
typedef const f32x4 (&AccRef)[2][2][4][2];

__device__ __forceinline__ float row_rstd(const float* ssp, int row) {
    const f32x4* p = (const f32x4*)(ssp + (size_t)row * 32); float s = 0.f;
#pragma unroll
    for (int j = 0; j < 8; ++j) { const f32x4 v = p[j]; s += (v.x + v.y) + (v.z + v.w); }
    return rsqrtf(s * (1.0f / D) + RMS_EPS);
}
struct EpiSwiGLU {
    static constexpr bool PERM = true;
    bf16* H; const float* ss;
    __device__ __forceinline__ void operator()(AccRef acc, const Unit& u, int wr, int wc, int, int) const {
        const int ln_ = fresh_lane(), fr = ln_ & 15, fq = ln_ >> 4;
        const int row0 = u.pm * 256 + wr * 64 + fr, col0 = u.pn * 128 + wc * 32 + 8 * fq;
#pragma unroll
        for (int ai = 0; ai < 2; ++ai)
#pragma unroll
            for (int m = 0; m < 4; ++m) {
                const int row = row0 + ai * 128 + m * 16;
                const float r = row_rstd(ss, row);
                float h[8];
#pragma unroll
                for (int n = 0; n < 2; ++n)
#pragma unroll
                    for (int j = 0; j < 4; ++j) { const float a = acc[ai][0][m][n][j] * r, b = acc[ai][1][m][n][j] * r; h[4 * n + j] = a * __builtin_amdgcn_rcpf(1.0f + __expf(-a)) * b; }
                v4u w; w.x = cvt_pk_bf16(h[0], h[1]); w.y = cvt_pk_bf16(h[2], h[3]); w.z = cvt_pk_bf16(h[4], h[5]); w.w = cvt_pk_bf16(h[6], h[7]);
                *(v4u*)(H + (size_t)row * DFF + col0) = w;
            }
    }
};
struct EpiResid {
    static constexpr bool PERM = true;
    const float* xin; float* xout; bf16* xb; float* ss; float alpha;
    __device__ __forceinline__ void operator()(AccRef acc, const Unit& u, int wr, int wc, int, int) const {
        const int ln_ = fresh_lane(), fr = ln_ & 15, fq = ln_ >> 4;
        const int row0 = u.pm * 256 + wr * 64 + fr, col0 = u.pn * 256 + wc * 32 + 8 * fq;
#pragma unroll
        for (int ai = 0; ai < 2; ++ai)
#pragma unroll
            for (int m = 0; m < 4; ++m) {
                const int row = row0 + ai * 128 + m * 16; float s = 0.f;
#pragma unroll
                for (int bj = 0; bj < 2; ++bj) {
                    const size_t p = (size_t)row * D + col0 + bj * 128;
                    f32x4 x0 = *(const f32x4*)(xin + p), x1 = *(const f32x4*)(xin + p + 4);
                    x0 = x0 + alpha * acc[ai][bj][m][0]; x1 = x1 + alpha * acc[ai][bj][m][1];
                    *(f32x4*)(xout + p) = x0; *(f32x4*)(xout + p + 4) = x1;
                    v4u w; w.x = cvt_pk_bf16(x0[0], x0[1]); w.y = cvt_pk_bf16(x0[2], x0[3]); w.z = cvt_pk_bf16(x1[0], x1[1]); w.w = cvt_pk_bf16(x1[2], x1[3]);
                    *(v4u*)(xb + p) = w;
                    s += (x0[0] * x0[0] + x0[1] * x0[1]) + (x0[2] * x0[2] + x0[3] * x0[3]) + (x1[0] * x1[0] + x1[1] * x1[1]) + (x1[2] * x1[2] + x1[3] * x1[3]);
                }
                s += __shfl_xor(s, 16); s += __shfl_xor(s, 32);
                if (fq == 0) ss[(size_t)row * 32 + u.pn * 4 + wc] = s;
                asm volatile("" ::: "memory");
            }
    }
};
struct EpiProj {
    static constexpr bool PERM = true;
    bf16* O; const float* ss;
    __device__ __forceinline__ void operator()(AccRef acc, const Unit& u, int wr, int wc, int, int) const {
        const int ln_ = fresh_lane(), fr = ln_ & 15, fq = ln_ >> 4;
        const int row0 = u.pm * 256 + wr * 64 + fr, col0 = u.pn * 256 + wc * 32 + 8 * fq;
#pragma unroll
        for (int ai = 0; ai < 2; ++ai)
#pragma unroll
            for (int m = 0; m < 4; ++m) {
                const int row = row0 + ai * 128 + m * 16;
                const float r = row_rstd(ss, row);
#pragma unroll
                for (int bj = 0; bj < 2; ++bj) {
                    const f32x4 v0 = acc[ai][bj][m][0] * r, v1 = acc[ai][bj][m][1] * r;
                    v4u w; w.x = cvt_pk_bf16(v0[0], v0[1]); w.y = cvt_pk_bf16(v0[2], v0[3]); w.z = cvt_pk_bf16(v1[0], v1[1]); w.w = cvt_pk_bf16(v1[2], v1[3]);
                    *(v4u*)(O + (size_t)row * DINP + col0 + bj * 128) = w;
                }
            }
    }
};
template <class F> struct EpiF {
    static constexpr bool PERM = true;
    F f;
    __device__ __forceinline__ void operator()(AccRef acc, const Unit& u, int wr, int wc, int, int) const {
        const int ln_ = fresh_lane(), fr = ln_ & 15, fq = ln_ >> 4;
        const int row0 = u.pm * 256 + wr * 64 + fr, col0 = u.pn * 256 + wc * 32 + 8 * fq;
#pragma unroll
        for (int ai = 0; ai < 2; ++ai)
#pragma unroll
            for (int m = 0; m < 4; ++m)
#pragma unroll
                for (int bj = 0; bj < 2; ++bj) { f(row0 + ai * 128 + m * 16, col0 + bj * 128, acc[ai][bj][m][0], acc[ai][bj][m][1]); asm volatile("" ::: "memory"); }
    }
};
struct FDecay { const float* w0; float* out;
    __device__ __forceinline__ void operator()(int row, int col, f32x4 v0, f32x4 v1) const {
        float o[8];
#pragma unroll
        for (int j = 0; j < 8; ++j) { const float x = w0[col + j] + (j < 4 ? v0[j & 3] : v1[j & 3]); o[j] = __expf(-0.6065306597126334f * sigmoidf_(x)); }
        float* p = out + (size_t)row * RW + col; *(f32x4*)p = (f32x4){o[0], o[1], o[2], o[3]}; *(f32x4*)(p + 4) = (f32x4){o[4], o[5], o[6], o[7]}; } };
struct FASig { const float* a0; float* out;
    __device__ __forceinline__ void operator()(int row, int col, f32x4 v0, f32x4 v1) const {
        float o[8];
#pragma unroll
        for (int j = 0; j < 8; ++j) o[j] = sigmoidf_(a0[col + j] + (j < 4 ? v0[j & 3] : v1[j & 3]));
        float* p = out + (size_t)row * RW + col; *(f32x4*)p = (f32x4){o[0], o[1], o[2], o[3]}; *(f32x4*)(p + 4) = (f32x4){o[4], o[5], o[6], o[7]}; } };
struct FStoreF32 { float* out; int ld;
    __device__ __forceinline__ void operator()(int row, int col, f32x4 v0, f32x4 v1) const { float* p = out + (size_t)row * ld + col; *(f32x4*)p = v0; *(f32x4*)(p + 4) = v1; } };
struct FStoreBf16 { bf16* out; int ld;
    __device__ __forceinline__ void operator()(int row, int col, f32x4 v0, f32x4 v1) const {
        v4u w; w.x = cvt_pk_bf16(v0[0], v0[1]); w.y = cvt_pk_bf16(v0[2], v0[3]); w.z = cvt_pk_bf16(v1[0], v1[1]); w.w = cvt_pk_bf16(v1[2], v1[3]);
        *(v4u*)(out + (size_t)row * ld + col) = w; } };
struct FVres { const float* v0p; float* VP; const float* VF;
    __device__ __forceinline__ void operator()(int row, int col, f32x4 a0, f32x4 a1) const {
        const size_t p = (size_t)row * RW + col;
        f32x4 x0 = *(const f32x4*)(VP + p), x1 = *(const f32x4*)(VP + p + 4); const f32x4 f0 = *(const f32x4*)(VF + p), f1 = *(const f32x4*)(VF + p + 4);
#pragma unroll
        for (int j = 0; j < 4; ++j) { x0[j] = x0[j] + (f0[j] - x0[j]) * sigmoidf_(v0p[col + j] + a0[j]); x1[j] = x1[j] + (f1[j] - x1[j]) * sigmoidf_(v0p[col + 4 + j] + a1[j]); }
        *(f32x4*)(VP + p) = x0; *(f32x4*)(VP + p + 4) = x1; } };
struct FGlu { const bf16* Z; bf16* Y;
    __device__ __forceinline__ void operator()(int row, int col, f32x4 a0, f32x4 a1) const {
        const size_t p = (size_t)row * 1024 + col; const v4u z = *(const v4u*)(Z + p);
        const float z0 = bflo(z.x), z1 = bfhi(z.x), z2 = bflo(z.y), z3 = bfhi(z.y), z4 = bflo(z.z), z5 = bfhi(z.z), z6 = bflo(z.w), z7 = bfhi(z.w);
        v4u w; w.x = cvt_pk_bf16(z0 * sigmoidf_(a0[0]), z1 * sigmoidf_(a0[1])); w.y = cvt_pk_bf16(z2 * sigmoidf_(a0[2]), z3 * sigmoidf_(a0[3]));
        w.z = cvt_pk_bf16(z4 * sigmoidf_(a1[0]), z5 * sigmoidf_(a1[1])); w.w = cvt_pk_bf16(z6 * sigmoidf_(a1[2]), z7 * sigmoidf_(a1[3]));
        *(v4u*)(Y + p) = w; } };
template <int MODE> struct FBranch { const bf16* PROJ; int goff; float* MG; bf16* MGB;
    __device__ __forceinline__ void operator()(int row, int col, f32x4 a0, f32x4 a1) const {
        const v4u gq = *(const v4u*)(PROJ + (size_t)row * DINP + goff + col);
        const float g0 = sigmoidf_(bflo(gq.x)), g1 = sigmoidf_(bfhi(gq.x)), g2 = sigmoidf_(bflo(gq.y)), g3 = sigmoidf_(bfhi(gq.y)), g4 = sigmoidf_(bflo(gq.z)), g5 = sigmoidf_(bfhi(gq.z)), g6 = sigmoidf_(bflo(gq.w)), g7 = sigmoidf_(bfhi(gq.w));
        const size_t p = (size_t)row * D + col;
        f32x4 x0 = (f32x4){g0 * a0[0], g1 * a0[1], g2 * a0[2], g3 * a0[3]}, x1 = (f32x4){g4 * a1[0], g5 * a1[1], g6 * a1[2], g7 * a1[3]};
        if (MODE != 0) { x0 = x0 + *(const f32x4*)(MG + p); x1 = x1 + *(const f32x4*)(MG + p + 4); }
        if (MODE != 2) { *(f32x4*)(MG + p) = x0; *(f32x4*)(MG + p + 4) = x1; }
        else { v4u w; w.x = cvt_pk_bf16(x0[0], x0[1]); w.y = cvt_pk_bf16(x0[2], x0[3]); w.z = cvt_pk_bf16(x1[0], x1[1]); w.w = cvt_pk_bf16(x1[2], x1[3]); *(v4u*)(MGB + p) = w; } } };

__device__ __forceinline__ void conv_item(const float* W, int ldw, int Ksrc, int srcc, const float* ks, bf16* dst, int ldd, int drow0, int k0, LAS float* scr, int lane) {
#pragma unroll 8
    for (int i = 0; i < 32; ++i) { const int kk = 2 * i + (lane >> 5), k = k0 + kk; float v = 0.f;
        if (srcc >= 0 && k < Ksrc) { v = W[(size_t)k * ldw + srcc + (lane & 31)]; if (ks) v *= ks[k]; }
        scr[kk * 33 + (lane & 31)] = v; }
    LDS_WAIT(); asm volatile("" ::: "memory");
    const int c = lane & 7;
#pragma unroll
    for (int j = 0; j < 4; ++j) { const int n = (lane >> 3) + 8 * j; const LAS float* s = scr + (8 * c) * 33 + n;
        v4u o; o.x = pk2(s[0 * 33], s[1 * 33]); o.y = pk2(s[2 * 33], s[3 * 33]); o.z = pk2(s[4 * 33], s[5 * 33]); o.w = pk2(s[6 * 33], s[7 * 33]);
        *(v4u*)(dst + (size_t)(drow0 + n) * ldd + k0 + 8 * c) = o; }
    LDS_WAIT(); asm volatile("" ::: "memory");
}
template <int MAP> __device__ __forceinline__ void conv_mat_item(const float* W, int ldw, int Ksrc, int Kdst, int Nsrc, int Ndst, const float* ks, bf16* dst, int item, LAS float* scr, int lane) {
    const int nblk = Ndst / 32, kb = item / nblk, nb = item % nblk, n0 = 32 * nb;
    int srcc;
    if (MAP == 0) srcc = (n0 < Nsrc) ? n0 : -1;
    else { const int tile = n0 >> 8, within = n0 & 255, bj = within >> 7, c = within & 127; srcc = bj * DFF + tile * 128 + c; }
    conv_item(W, ldw, Ksrc, srcc, ks, dst, Kdst, n0, 64 * kb, scr, lane);
}

__device__ __forceinline__ bool in_range(int lo, int hi, int k) { asm volatile("" : "+s"(k)); return lo <= k && k < hi; }
struct Args { const float* in[38]; float* out; unsigned char* ws; int ph_lo, ph_hi, use_bar, pad; };
typedef const Args __attribute__((address_space(4)))* KArgs;

__global__ void __launch_bounds__(NWAVES * 64, 2) mk_fwd(Args args) {
    extern __shared__ __attribute__((aligned(16))) unsigned char lds_raw[];
    LAS unsigned char* lds = (LAS unsigned char*)lds_raw;
    for (int u = threadIdx.x; u < (LDS_BYTES - LDSCTL_OFF) / 4; u += NWAVES * 64) ((LAS unsigned*)(lds + LDSCTL_OFF))[u] = 0u;
    __syncthreads();
    XcdBarrier bar; bar.bar = (unsigned*)(args.ws + WS_CTL) + CW_BAR; bar.x = 0; bar.st = nullptr;
    if (args.use_bar) bar = xcd_barrier_post((unsigned*)(args.ws + WS_CTL) + CW_BAR, (volatile LAS unsigned*)(lds + LDSCTL_OFF + 64));

    const int lo = args.ph_lo, hi = args.ph_hi, use_bar = args.use_bar;
    const int wave0 = __builtin_amdgcn_readfirstlane((int)threadIdx.x >> 6);
#ifndef PHMASK
#define PHMASK 0xFFFF
#endif
#define EN(p) ((PHMASK >> (p)) & 1)
#define IN(k) in_range(lo, hi, (k))
#define SEAM(k) do { if (IN(k) && IN((k) + 1)) { if (use_bar) { XcdBarrier b_ = bar; asm volatile("" : "+s"(b_.bar), "+s"(b_.x)); xcd_barrier(b_); } } } while (0)
#define PH_LOCALS \
    int lane; asm volatile("v_mbcnt_lo_u32_b32 %0, -1, 0\n\tv_mbcnt_hi_u32_b32 %0, -1, %0" : "=v"(lane)); int wave = wave0; asm volatile("" : "+s"(wave)); const int tid = wave * 64 + lane; \
    int G = gridDim.x, bid = blockIdx.x; asm volatile("" : "+s"(G), "+s"(bid)); \
    KArgs ka = (KArgs)__builtin_amdgcn_kernarg_segment_ptr(); asm volatile("" : "+s"(ka)); \
    unsigned char* ws = ka->ws; \
    const int gw = bid * NWAVES + wave, NGW = G * NWAVES; const size_t gtid = (size_t)bid * (NWAVES * 64) + tid, NT = (size_t)G * (NWAVES * 64); \
    (void)lane; (void)gw; (void)NGW; (void)gtid; (void)NT;
#define P_X ((float*)(ws + WS_X))
#define P_XB ((bf16*)(ws + WS_XB))
#define P_HID ((bf16*)(ws + WS_HID))
#define P_PROJ ((bf16*)(ws + WS_PROJ))
#define P_SS ((float*)(ws + WS_SSP))
#define P_RP ((float*)(ws + WS_RP))
#define P_KP ((float*)(ws + WS_KP))
#define P_VP ((float*)(ws + WS_VP))
#define P_DECAY ((float*)(ws + WS_DECAY))
#define P_ASIG ((float*)(ws + WS_ASIG))
#define P_GG ((float*)(ws + WS_G))
#define P_KK ((float*)(ws + WS_KK))
#define P_VFIRST ((float*)(ws + WS_VFIRST))
#define P_YRAW ((float*)(ws + WS_YRAW))
#define P_LORA ((bf16*)(ws + WS_LORA))
#define P_AV ((bf16*)(ws + WS_AV))
#define P_V1O ((bf16*)(ws + WS_V1O))
#define P_QN ((bf16*)(ws + WS_QN))
#define P_KN ((bf16*)(ws + WS_KN))
#define P_Z ((bf16*)(ws + WS_Z))
#define P_YS5 ((bf16*)(ws + WS_YS5))
#define P_YATT ((bf16*)(ws + WS_YATT))
#define P_YRWKV ((bf16*)(ws + WS_YRWKV))
#define P_MERGED ((float*)(ws + WS_MERGED))
#define P_MERGEDB ((bf16*)(ws + WS_MERGEDB))
#define P_SBUF ((f32x2*)(ws + WS_SBUF))

    if (IN(0)) {
        PH_LOCALS
        const float* x = ka->in[0];
        for (int m = gw; m < M; m += NGW) {
            const f32x4* xr = (const f32x4*)(x + (size_t)m * D) + lane; float s = 0.f;
            v2u* o = (v2u*)(P_XB + (size_t)m * D) + lane;
#pragma unroll
            for (int j = 0; j < 8; ++j) { const f32x4 v = xr[64 * j]; s += (v.x * v.x + v.y * v.y) + (v.z * v.z + v.w * v.w); v2u w; w.x = pk2(v.x, v.y); w.y = pk2(v.z, v.w); o[64 * j] = w; }
            s = wave_sum(s);
            if (lane < 32) P_SS[(size_t)m * 32 + lane] = lane == 0 ? s : 0.f;
        }
    }
    SEAM(0);

    for (int l = 0; l < DEPTH; ++l) {
        const int pb = 1 + l * NPH;
        if (hi <= pb || lo >= pb + NPH) continue;
        if (EN(0) && IN(pb + 0)) {
            PH_LOCALS
            LAS float* scr = (LAS float*)(lds + RING_OFF + wave * 16384);
            constexpr int I_UP = (D / 64) * (NUP / 32), I_DN = (DFF / 64) * (D / 32), I_IN = (D / 64) * (DINP / 32), I_GLU = 16 * 32, I_L = 4 * 32, I_V1 = 16 * 8, I_V2 = 4 * 32,
                          I_BS5 = 16 * 64, I_BAT = 8 * 64, I_BRW = 16 * 64, I_OUT = 32 * 64;
            constexpr int NITEMS = 2 * I_UP + 2 * I_DN + I_IN + I_GLU + 3 * I_L + I_V1 + I_V2 + I_BS5 + I_BAT + I_BRW + I_OUT;
            const int lv = l > 0 ? l - 1 : 0;
            for (int it = gw; it < NITEMS; it += NGW) {
                int r = it;
                if (r < I_UP) { conv_mat_item<1>(ka->in[2] + (size_t)l * D * NUP, NUP, D, D, NUP, NUP, ka->in[1] + l * D, (bf16*)(ws + W_UP1), r, scr, lane); continue; } r -= I_UP;
                if (r < I_UP) { conv_mat_item<1>(ka->in[36] + (size_t)l * D * NUP, NUP, D, D, NUP, NUP, ka->in[35] + l * D, (bf16*)(ws + W_UP2), r, scr, lane); continue; } r -= I_UP;
                if (r < I_IN) { conv_mat_item<0>(ka->in[5] + (size_t)l * D * DIN, DIN, D, D, DIN, DINP, ka->in[4] + l * D, (bf16*)(ws + W_IN), r, scr, lane); continue; } r -= I_IN;
                if (r < I_DN) { conv_mat_item<0>(ka->in[3] + (size_t)l * DFF * D, D, DFF, DFF, D, D, nullptr, (bf16*)(ws + W_DN1), r, scr, lane); continue; } r -= I_DN;
                if (r < I_DN) { conv_mat_item<0>(ka->in[37] + (size_t)l * DFF * D, D, DFF, DFF, D, D, nullptr, (bf16*)(ws + W_DN2), r, scr, lane); continue; } r -= I_DN;
                if (r < I_OUT) { conv_mat_item<0>(ka->in[34] + (size_t)l * D * D, D, D, D, D, D, nullptr, (bf16*)(ws + W_OUT), r, scr, lane); continue; } r -= I_OUT;
                if (r < I_BS5) { conv_mat_item<0>(ka->in[31] + (size_t)l * 1024 * D, D, 1024, 1024, D, D, nullptr, (bf16*)(ws + W_BS5), r, scr, lane); continue; } r -= I_BS5;
                if (r < I_BAT) { conv_mat_item<0>(ka->in[32] + (size_t)l * 512 * D, D, 512, 512, D, D, nullptr, (bf16*)(ws + W_BAT), r, scr, lane); continue; } r -= I_BAT;
                if (r < I_BRW) { conv_mat_item<0>(ka->in[33] + (size_t)l * 1024 * D, D, 1024, 1024, D, D, nullptr, (bf16*)(ws + W_BRW), r, scr, lane); continue; } r -= I_BRW;
                if (r < I_GLU) { conv_mat_item<0>(ka->in[14] + (size_t)l * 1024 * 1024, 1024, 1024, 1024, 1024, 1024, nullptr, (bf16*)(ws + W_GLU), r, scr, lane); continue; } r -= I_GLU;
                if (r < I_L) { conv_mat_item<0>(ka->in[19] + (size_t)l * 96 * RW, RW, 96, 256, RW, RW, nullptr, (bf16*)(ws + W_W2), r, scr, lane); continue; } r -= I_L;
                if (r < I_L) { conv_mat_item<0>(ka->in[21] + (size_t)l * 96 * RW, RW, 96, 256, RW, RW, nullptr, (bf16*)(ws + W_A2), r, scr, lane); continue; } r -= I_L;
                if (r < I_L) { conv_mat_item<0>(ka->in[22] + (size_t)l * 256 * RW, RW, 256, 256, RW, RW, nullptr, (bf16*)(ws + W_G2), r, scr, lane); continue; } r -= I_L;
                if (r < I_V1) { conv_mat_item<0>(ka->in[29] + (size_t)lv * RW * 64, 64, RW, RW, 64, 256, nullptr, (bf16*)(ws + W_V1), r, scr, lane); continue; } r -= I_V1;
                conv_mat_item<0>(ka->in[30] + (size_t)lv * 64 * RW, RW, 64, 256, RW, RW, nullptr, (bf16*)(ws + W_V2), r, scr, lane);
            }
        }
        SEAM(pb + 0);
        if (EN(1) && IN(pb + 1)) {
            PH_LOCALS
            pg8::Gemm g{P_XB, (const bf16*)(ws + W_UP1), M, NUP, D, D, D}; pg8::StaticOrder S; S.init(M, NUP, G, bid);
            EpiSwiGLU E{P_HID, P_SS + (size_t)(3 * l + 0) * M * 32};
            pg8::gemm_phase<EpiSwiGLU, pg8::StaticOrder, true, true>(lds + RING_OFF, g, S, E, tid);
        }
        SEAM(pb + 1);
        if (EN(2) && IN(pb + 2)) {
            PH_LOCALS
            pg8::Gemm g{P_HID, (const bf16*)(ws + W_DN1), M, D, DFF, DFF, DFF}; pg8::StaticOrder S; S.init(M, D, G, bid);
            EpiResid E{l == 0 ? ka->in[0] : P_X, P_X, P_XB, P_SS + (size_t)(3 * l + 1) * M * 32, 0.5f};
            pg8::gemm_phase<EpiResid, pg8::StaticOrder, true, true>(lds + RING_OFF, g, S, E, tid);
        }
        SEAM(pb + 2);
        if (EN(3) && IN(pb + 3)) {
            PH_LOCALS
            pg8::Gemm g{P_XB, (const bf16*)(ws + W_IN), M, DINP, D, D, D}; pg8::StaticOrder S; S.init(M, DINP, G, bid);
            EpiProj E{P_PROJ, P_SS + (size_t)(3 * l + 1) * M * 32};
            pg8::gemm_phase<EpiProj, pg8::StaticOrder, true, true>(lds + RING_OFF, g, S, E, tid);
        }
        SEAM(pb + 3);
        if (EN(4) && IN(pb + 4)) {
            PH_LOCALS
            const float* mu = ka->in[17] + (size_t)l * RWP;
            bf16* PROJ = P_PROJ; bf16* LORA = P_LORA;
            for (size_t idx = gtid; idx < (size_t)M * RWP; idx += NT) {
                const int m = (int)(idx / RWP), c = (int)(idx % RWP), t = m % T;
                const float pc = bf2f(PROJ[(size_t)m * DINP + RW_OFF + c]);
                const float pp = t > 0 ? bf2f(PROJ[(size_t)(m - 1) * DINP + RW_OFF + c]) : 0.f;
                const float p = pc + (pp - pc) * mu[c];
                if (c < 1024) P_RP[(size_t)m * RW + c] = p;
                else if (c < 2048) P_KP[(size_t)m * RW + c - 1024] = p;
                else if (c < 3072) { P_VP[(size_t)m * RW + c - 2048] = p; P_AV[(size_t)m * RW + c - 2048] = (bf16)f2bf(p); if (l == 0) P_VFIRST[(size_t)m * RW + c - 2048] = p; }
                else if (c < 3168) LORA[(size_t)m * 768 + c - 3072] = (bf16)f2bf(tanhf(p));
                else if (c < 3264) LORA[(size_t)m * 768 + 256 + c - 3168] = (bf16)f2bf(p);
                else LORA[(size_t)m * 768 + 512 + c - 3264] = (bf16)f2bf(sigmoidf_(p));
            }
            for (size_t idx = gtid; idx < (size_t)M * 320; idx += NT) {
                const int m = (int)(idx / 320), c = (int)(idx % 320);
                LORA[(size_t)m * 768 + (c < 160 ? 96 + c : 352 + (c - 160))] = 0;
            }
            const float* qg = ka->in[15] + l * 64; const float* kg = ka->in[16] + l * 64;
            for (int it = gw; it < M * 48; it += NGW) {
                const int m = it / 48, hh = it % 48, isk = hh >= 24, head = isk ? hh - 24 : hh;
                const float v = bf2f(PROJ[(size_t)m * DINP + (isk ? K_OFF : Q_OFF) + head * 64 + lane]);
                const float ssq = wave_sum(v * v);
                const float o = v * rsqrtf(ssq * (1.0f / 64) + RMS_EPS) * (isk ? kg[lane] : qg[lane]);
                (isk ? P_KN : P_QN)[(size_t)m * AW + head * 64 + lane] = (bf16)f2bf(o);
            }
        }
        SEAM(pb + 4);
        if (EN(5) && IN(pb + 5)) {
            PH_LOCALS
            const bf16* PROJ = P_PROJ;
            if (wave == 0) {
                f32x2* SBUF = P_SBUF;
                for (int item = bid; item < 256; item += G) {
                    const int b = item >> 6, g = item & 63, p = lane;
                    const float a_re = ka->in[6][(l * 64 + g) * 64 + p], a_im = ka->in[7][(l * 64 + g) * 64 + p];
                    const float dt = expf(ka->in[12][l * 64 + g]);
                    const float lam_re = fminf(a_re, -1e-4f), lam_im = a_im;
                    const float mag = expf(lam_re * dt), ab_re = mag * cosf(lam_im * dt), ab_im = mag * sinf(lam_im * dt);
                    const float den = lam_re * lam_re + lam_im * lam_im, num_re = ab_re - 1.0f;
                    const float coef_re = (num_re * lam_re + ab_im * lam_im) / den, coef_im = (ab_im * lam_re - num_re * lam_im) / den;
                    float bbr[16], bbi[16];
                    const float* bre = ka->in[8] + ((size_t)(l * 64 + g) * 64 + p) * 16; const float* bim = ka->in[9] + ((size_t)(l * 64 + g) * 64 + p) * 16;
#pragma unroll
                    for (int h = 0; h < 16; ++h) { const float br = bre[h], bi = bim[h]; bbr[h] = coef_re * br - coef_im * bi; bbi[h] = coef_re * bi + coef_im * br; }
                    float s_re = 0.f, s_im = 0.f;
                    for (int t = 0; t < T; ++t) {
                        const size_t m = (size_t)b * T + t;
                        const v4u u0 = *(const v4u*)(PROJ + m * DINP + U_OFF + g * 16), u1 = *(const v4u*)(PROJ + m * DINP + U_OFF + g * 16 + 8);
                        float uu[16];
                        uu[0] = bflo(u0.x); uu[1] = bfhi(u0.x); uu[2] = bflo(u0.y); uu[3] = bfhi(u0.y); uu[4] = bflo(u0.z); uu[5] = bfhi(u0.z); uu[6] = bflo(u0.w); uu[7] = bfhi(u0.w);
                        uu[8] = bflo(u1.x); uu[9] = bfhi(u1.x); uu[10] = bflo(u1.y); uu[11] = bfhi(u1.y); uu[12] = bflo(u1.z); uu[13] = bfhi(u1.z); uu[14] = bflo(u1.w); uu[15] = bfhi(u1.w);
                        float bur = 0.f, bui = 0.f;
#pragma unroll
                        for (int h = 0; h < 16; ++h) { bur += bbr[h] * uu[h]; bui += bbi[h] * uu[h]; }
                        const float nr = ab_re * s_re - ab_im * s_im + bur, ni = ab_re * s_im + ab_im * s_re + bui;
                        s_re = nr; s_im = ni;
                        SBUF[(m * 64 + g) * 64 + p] = (f32x2){s_re, s_im};
                    }
                }
            }
            const bf16* QN = P_QN; const bf16* KN = P_KN;
            for (int it = gw; it < M * 8; it += NGW) {
                const int m = it >> 3, hh = it & 7, b = m / T, t = m % T;
                float accv = 0.f, den = 0.f, mx = -INFINITY;
#pragma unroll
                for (int gi = 0; gi < 3; ++gi) {
                    const int dil = gi == 0 ? 1 : (gi == 1 ? 4 : 16), head = gi * 8 + hh;
                    const float slope = exp2f(-8.0f * (float)(head + 1) / 24.0f);
                    const float q = bf2f(QN[(size_t)m * AW + head * 64 + lane]) * 0.125f;
                    for (int j = 0; j <= 128; ++j) {
                        const int tk = t - j * dil; if (tk < 0) break;
                        const size_t mk = (size_t)b * T + tk;
                        const float k = bf2f(KN[mk * AW + head * 64 + lane]);
                        const float s = wave_sum(q * k) - slope * (float)(j * dil);
                        const float v = bf2f(PROJ[mk * DINP + V_OFF + head * 64 + lane]);
                        const float mn = fmaxf(mx, s), sc = __expf(mx - mn), pw = __expf(s - mn);
                        accv = accv * sc + pw * v; den = den * sc + pw; mx = mn;
                    }
                }
                P_YATT[(size_t)m * 512 + hh * 64 + lane] = (bf16)f2bf(accv / den);
            }
        }
        SEAM(pb + 5);
        if (EN(6) && IN(pb + 6)) {
            { PH_LOCALS
              pg8::Gemm g{P_LORA, (const bf16*)(ws + W_W2), M, RW, 256, 768, 256}; pg8::StaticOrder S; S.init(M, RW, G, bid);
              EpiF<FDecay> E{FDecay{ka->in[18] + l * RW, P_DECAY}}; pg8::gemm_phase<EpiF<FDecay>, pg8::StaticOrder, true, true>(lds + RING_OFF, g, S, E, tid); }
            { PH_LOCALS
              pg8::Gemm g{P_LORA + 256, (const bf16*)(ws + W_A2), M, RW, 256, 768, 256}; pg8::StaticOrder S; S.init(M, RW, G, (bid + G / 2) % G);
              EpiF<FASig> E{FASig{ka->in[20] + l * RW, P_ASIG}}; pg8::gemm_phase<EpiF<FASig>, pg8::StaticOrder, true, true>(lds + RING_OFF, g, S, E, tid); }
            { PH_LOCALS
              pg8::Gemm g{P_LORA + 512, (const bf16*)(ws + W_G2), M, RW, 256, 768, 256}; pg8::StaticOrder S; S.init(M, RW, G, bid);
              EpiF<FStoreF32> E{FStoreF32{P_GG, RW}}; pg8::gemm_phase<EpiF<FStoreF32>, pg8::StaticOrder, true, true>(lds + RING_OFF, g, S, E, tid); }
            if (l > 0) { PH_LOCALS
              pg8::Gemm g{P_AV, (const bf16*)(ws + W_V1), M, 256, RW, RW, RW}; pg8::StaticOrder S; S.init(M, 256, G, (bid + G / 2) % G);
              EpiF<FStoreBf16> E{FStoreBf16{P_V1O, 256}}; pg8::gemm_phase<EpiF<FStoreBf16>, pg8::StaticOrder, true, true>(lds + RING_OFF, g, S, E, tid); }
            { PH_LOCALS
              const float* cre = ka->in[10] + (size_t)l * 64 * 16 * 64; const float* cim = ka->in[11] + (size_t)l * 64 * 16 * 64; const float* dsk = ka->in[13] + l * 1024;
              const f32x2* SBUF = P_SBUF; const bf16* PROJ = P_PROJ; bf16* Z = P_Z;
              for (size_t idx = gtid; idx < (size_t)M * 1024; idx += NT) {
                const size_t m = idx >> 10; const int gh = (int)(idx & 1023), g = gh >> 4;
                const f32x2* sp = SBUF + (m * 64 + g) * 64; const float* cr = cre + (size_t)gh * 64; const float* ci = cim + (size_t)gh * 64;
                float y = 0.f;
#pragma unroll 8
                for (int p = 0; p < 64; ++p) { const f32x2 s = sp[p]; y += cr[p] * s.x - ci[p] * s.y; }
                y += dsk[gh] * bf2f(PROJ[m * DINP + U_OFF + gh]);
                const float zz = 0.5f * y * (1.0f + tanhf(0.7978845608028654f * (y + 0.044715f * y * y * y)));
                Z[idx] = (bf16)f2bf(zz);
              } }
        }
        SEAM(pb + 6);
        if (EN(7) && IN(pb + 7)) {
            if (l > 0) { PH_LOCALS
              pg8::Gemm g{P_V1O, (const bf16*)(ws + W_V2), M, RW, 256, 256, 256}; pg8::StaticOrder S; S.init(M, RW, G, bid);
              EpiF<FVres> E{FVres{ka->in[28] + (size_t)(l - 1) * RW, P_VP, P_VFIRST}}; pg8::gemm_phase<EpiF<FVres>, pg8::StaticOrder, true, true>(lds + RING_OFF, g, S, E, tid); }
            { PH_LOCALS
              pg8::Gemm g{P_Z, (const bf16*)(ws + W_GLU), M, 1024, 1024, 1024, 1024}; pg8::StaticOrder S; S.init(M, 1024, G, (bid + G / 2) % G);
              EpiF<FGlu> E{FGlu{P_Z, P_YS5}}; pg8::gemm_phase<EpiF<FGlu>, pg8::StaticOrder, true, true>(lds + RING_OFF, g, S, E, tid); }
        }
        SEAM(pb + 7);
        if (EN(8) && IN(pb + 8)) {
            PH_LOCALS
            const float* k_k = ka->in[23] + l * RW; const float* k_a = ka->in[24] + l * RW;
            float* KP = P_KP; float* KK = P_KK; const float* ASIG = P_ASIG;
            for (int it = gw; it < M * 16; it += NGW) {
                const size_t p = (size_t)it * 64 + lane; const int c = (it & 15) * 64 + lane;
                const float kp = KP[p]; float kk = kp * k_k[c];
                const float n2 = wave_sum(kk * kk); kk *= rsqrtf(fmaxf(n2, 1e-24f));
                const float a = ASIG[p];
                KK[p] = kk; KP[p] = kp * (1.0f + (a - 1.0f) * k_a[c]);
            }
        }
        SEAM(pb + 8);
        if (EN(9) && IN(pb + 9)) {
            PH_LOCALS
            if (wave == 0) {
                const float* KK = P_KK; const float* DECAY = P_DECAY; const float* ASIG = P_ASIG; const float* KP = P_KP; const float* RP = P_RP; const float* VP = P_VP; float* YRAW = P_YRAW;
                for (int item = bid; item < 64; item += G) {
                    const int b = item >> 4, h = item & 15;
                    float S[64];
#pragma unroll
                    for (int j = 0; j < 64; ++j) S[j] = 0.f;
                    for (int t = 0; t < T; ++t) {
                        const size_t base = ((size_t)b * T + t) * RW + h * 64;
                        const float vi = VP[base + lane];
                        float sa = 0.f;
#pragma unroll
                        for (int jq = 0; jq < 16; ++jq) { const f32x4 k4 = *(const f32x4*)(KK + base + 4 * jq);
                            sa -= S[4 * jq] * k4.x + S[4 * jq + 1] * k4.y + S[4 * jq + 2] * k4.z + S[4 * jq + 3] * k4.w; }
                        float y = 0.f;
#pragma unroll
                        for (int jq = 0; jq < 16; ++jq) {
                            const f32x4 w4 = *(const f32x4*)(DECAY + base + 4 * jq), k4 = *(const f32x4*)(KK + base + 4 * jq), a4 = *(const f32x4*)(ASIG + base + 4 * jq),
                                        kf = *(const f32x4*)(KP + base + 4 * jq), r4 = *(const f32x4*)(RP + base + 4 * jq);
#pragma unroll
                            for (int e = 0; e < 4; ++e) { const float sn = S[4 * jq + e] * w4[e] + sa * (k4[e] * a4[e]) + vi * kf[e]; S[4 * jq + e] = sn; y += sn * r4[e]; }
                        }
                        YRAW[base + lane] = y;
                    }
                }
            }
        }
        SEAM(pb + 9);
        if (EN(10) && IN(pb + 10)) {
            PH_LOCALS
            const float* lnw = ka->in[26] + l * RW; const float* lnb = ka->in[27] + l * RW; const float* r_k = ka->in[25] + l * RW;
            const float* YRAW = P_YRAW; const float* RP = P_RP; const float* KP = P_KP; const float* VP = P_VP; const float* GG = P_GG; bf16* YRWKV = P_YRWKV;
            for (int it = gw; it < M * 16; it += NGW) {
                const size_t p = (size_t)it * 64 + lane; const int c = (it & 15) * 64 + lane;
                const float y = YRAW[p]; const float mean = wave_sum(y) * (1.0f / 64); const float d = y - mean; const float var = wave_sum(d * d) * (1.0f / 64);
                float yn = d * rsqrtf(var + 64e-5f) * lnw[c] + lnb[c];
                const float rk = wave_sum(RP[p] * KP[p] * r_k[c]);
                yn += rk * VP[p];
                YRWKV[p] = (bf16)f2bf(yn * GG[p]);
            }
        }
        SEAM(pb + 10);
        if (EN(11) && IN(pb + 11)) {
            { PH_LOCALS
              pg8::Gemm g{P_YS5, (const bf16*)(ws + W_BS5), M, D, 1024, 1024, 1024}; pg8::StaticOrder S; S.init(M, D, G, bid);
              EpiF<FBranch<0>> E{FBranch<0>{P_PROJ, GATE_OFF, P_MERGED, P_MERGEDB}}; pg8::gemm_phase<EpiF<FBranch<0>>, pg8::StaticOrder, true, true>(lds + RING_OFF, g, S, E, tid); }
            VM_WAIT(); __syncthreads();
            { PH_LOCALS
              pg8::Gemm g{P_YATT, (const bf16*)(ws + W_BAT), M, D, 512, 512, 512}; pg8::StaticOrder S; S.init(M, D, G, bid);
              EpiF<FBranch<1>> E{FBranch<1>{P_PROJ, GATE_OFF + D, P_MERGED, P_MERGEDB}}; pg8::gemm_phase<EpiF<FBranch<1>>, pg8::StaticOrder, true, true>(lds + RING_OFF, g, S, E, tid); }
            VM_WAIT(); __syncthreads();
            { PH_LOCALS
              pg8::Gemm g{P_YRWKV, (const bf16*)(ws + W_BRW), M, D, 1024, 1024, 1024}; pg8::StaticOrder S; S.init(M, D, G, bid);
              EpiF<FBranch<2>> E{FBranch<2>{P_PROJ, GATE_OFF + 2 * D, P_MERGED, P_MERGEDB}}; pg8::gemm_phase<EpiF<FBranch<2>>, pg8::StaticOrder, true, true>(lds + RING_OFF, g, S, E, tid); }
        }
        SEAM(pb + 11);
        if (EN(12) && IN(pb + 12)) {
            PH_LOCALS
            pg8::Gemm g{P_MERGEDB, (const bf16*)(ws + W_OUT), M, D, D, D, D}; pg8::StaticOrder S; S.init(M, D, G, bid);
            EpiResid E{P_X, P_X, P_XB, P_SS + (size_t)(3 * l + 2) * M * 32, 1.0f};
            pg8::gemm_phase<EpiResid, pg8::StaticOrder, true, true>(lds + RING_OFF, g, S, E, tid);
        }
        SEAM(pb + 12);
        if (EN(13) && IN(pb + 13)) {
            PH_LOCALS
            pg8::Gemm g{P_XB, (const bf16*)(ws + W_UP2), M, NUP, D, D, D}; pg8::StaticOrder S; S.init(M, NUP, G, bid);
            EpiSwiGLU E{P_HID, P_SS + (size_t)(3 * l + 2) * M * 32};
            pg8::gemm_phase<EpiSwiGLU, pg8::StaticOrder, true, true>(lds + RING_OFF, g, S, E, tid);
        }
        SEAM(pb + 13);
        if (EN(14) && IN(pb + 14)) {
            PH_LOCALS
            pg8::Gemm g{P_HID, (const bf16*)(ws + W_DN2), M, D, DFF, DFF, DFF}; pg8::StaticOrder S; S.init(M, D, G, bid);
            EpiResid E{P_X, l == DEPTH - 1 ? ka->out : P_X, P_XB, P_SS + (size_t)(3 * l + 3) * M * 32, 0.5f};
            pg8::gemm_phase<EpiResid, pg8::StaticOrder, true, true>(lds + RING_OFF, g, S, E, tid);
        }
        SEAM(pb + 14);
    }
#undef IN
#undef SEAM
}

extern "C" void kernel_launch(void* const* d_in, const int* in_sizes, int n_in, void* d_out, int out_size, void* d_ws, size_t ws_size, hipStream_t stream) {
    static int grid = 0;
    if (grid == 0) {
        if (n_in != 38 || in_sizes[0] != M * D || out_size != M * D || ws_size < WS_END) {
            fprintf(stderr, "kernel_launch: unexpected shapes/workspace (n_in %d, in0 %d, out %d, ws %zu, need %zu); nothing launched\n", n_in, n_in > 0 ? in_sizes[0] : -1, out_size, ws_size, (size_t)WS_END); grid = -1; return; }
        int dev = 0, cus = 0, per_cu = 0;
        if (hipGetDevice(&dev) != hipSuccess || hipDeviceGetAttribute(&cus, hipDeviceAttributeMultiprocessorCount, dev) != hipSuccess) { grid = -1; return; }
        if (hipFuncSetAttribute((const void*)mk_fwd, hipFuncAttributeMaxDynamicSharedMemorySize, LDS_BYTES) != hipSuccess) { fprintf(stderr, "kernel_launch: hipFuncSetAttribute failed\n"); grid = -1; return; }
        if (hipOccupancyMaxActiveBlocksPerMultiprocessor(&per_cu, (const void*)mk_fwd, NWAVES * 64, LDS_BYTES) != hipSuccess || per_cu < 1)
            fprintf(stderr, "kernel_launch: note: occupancy query reports %d workgroups per CU\n", per_cu);
        (void)hipGetLastError();
        grid = cus;
    }
    if (grid < 0) return;
    if (hipMemsetAsync((char*)d_ws + WS_CTL, 0, CTL_ZERO_BYTES, stream) != hipSuccess) { fprintf(stderr, "kernel_launch: memset failed\n"); return; }
#ifdef DBG_ZERO_WS
    (void)hipMemsetAsync((char*)d_ws + CTL_ZERO_BYTES, 0, WS_END - CTL_ZERO_BYTES, stream);
#endif
    Args a{};
    for (int i = 0; i < 38; ++i) a.in[i] = (const float*)d_in[i];
    a.out = (float*)d_out; a.ws = (unsigned char*)d_ws; a.pad = 0;
#if MK_ONE_LAUNCH
    a.ph_lo = 0; a.ph_hi = NPHASES; a.use_bar = 1;
    hipLaunchKernelGGL(mk_fwd, dim3(grid), dim3(NWAVES * 64), LDS_BYTES, stream, a);
#else
    for (int ph = 0; ph < NPHASES; ++ph) {
        a.ph_lo = ph; a.ph_hi = ph + 1; a.use_bar = 0;
        hipLaunchKernelGGL(mk_fwd, dim3(grid), dim3(NWAVES * 64), LDS_BYTES, stream, a);
    }
#endif
    const hipError_t le = hipPeekAtLastError();
    if (le != hipSuccess) fprintf(stderr, "kernel_launch: launch failed: %s\n", hipGetErrorName(le));
}
```

```cpp
#include <hip/hip_runtime.h>
#include <cstdio>
#include <cstdint>

#ifndef MK_ONE_LAUNCH
#define MK_ONE_LAUNCH 1
#endif

namespace pg8 {
#define PG8_LAS __attribute__((address_space(3)))
typedef unsigned short bf16_t;
typedef short bf16x8 __attribute__((ext_vector_type(8)));
typedef float f32x4 __attribute__((ext_vector_type(4)));
typedef unsigned u32x4 __attribute__((ext_vector_type(4)));
constexpr int BM = 256, BK = 64, HALF = 128, HTB = HALF * BK * 2, STAGE_BYTES = 8 * HTB, NXCD = 8, WGM = 8;

__host__ __device__ __forceinline__ int lds_byte(int r, int c) { const int st = (r >> 4) * 2 + (c >> 5), rr = r & 15, cc = c & 31, ob = rr * 64 + cc * 2; return st * 1024 + (ob ^ (((ob >> 9) & 1) << 5)); }
__host__ __device__ __forceinline__ void stage_rc(int b, int& R, int& C) { const int st = b / 1024, sb = b % 1024, swz = sb ^ (((sb >> 9) & 1) << 5); R = (st >> 1) * 16 + swz / 64; C = (st & 1) * 32 + (swz % 64) / 2; }
__host__ __device__ __forceinline__ int perm32(int rho) { const int n = rho >> 4, i = rho & 15; return 8 * (i >> 2) + 4 * n + (i & 3); }

struct Unit { int pm, pn; };
struct Gemm { const bf16_t* A; const bf16_t* Bt; int M, N, K, lda, ldb; };

struct StaticOrder {
    int nM, nN, nwg, G, c;
    __host__ __device__ void init(int M, int N, int G_, int c_) { nM = M / BM; nN = N / BM; nwg = nM * nN; G = G_; c = c_; }
    __host__ __device__ bool next(int i, Unit& u) const {
        const long L = (long)i * G + c; if (L >= nwg) return false;
        int wgid = (int)L; { const int q = nwg / NXCD, r = nwg % NXCD, xcd = wgid % NXCD, off = wgid / NXCD; wgid = (xcd < r ? xcd * (q + 1) : r * (q + 1) + (xcd - r) * q) + off; }
        const int nig = WGM * nN, gid = wgid / nig, fm = gid * WGM, gsz = (nM - fm) < WGM ? (nM - fm) : WGM;
        u.pm = fm + ((wgid % nig) % gsz); u.pn = (wgid % nig) / gsz; return true;
    }
    __device__ __forceinline__ void a_ready(const Unit&) const {}
    __device__ __forceinline__ void done(const Unit&) const {}
};

__device__ __forceinline__ unsigned cvt_pk_bf16(float lo, float hi) { unsigned r; asm volatile("v_cvt_pk_bf16_f32 %0, %1, %2" : "=v"(r) : "v"(lo), "v"(hi)); return r; }

template <class Epi, class Sched, bool ALIGN_EPI = false, bool SP2 = false>
__device__ __forceinline__ void gemm_phase(PG8_LAS unsigned char* lds, const Gemm g, const Sched& S, const Epi& E, int tid_) {
    asm volatile("" : "+v"(tid_));
    const int tid = tid_, wid = __builtin_amdgcn_readfirstlane(tid >> 6), lane = tid & 63, wr = wid >> 2, wc = wid & 3, fr = lane & 15, fq = lane >> 4;
    const int K = g.K, nt = K / BK;
    unsigned voffA[2], voffB[2];
#pragma unroll
    for (int i = 0; i < 2; ++i) { int R, C; stage_rc(tid * 16 + i * 8192, R, C); const int Rb = Epi::PERM ? ((R & ~31) + perm32(R & 31)) : R;
        voffA[i] = (unsigned)(R * g.lda + C) * 2u; voffB[i] = (unsigned)(Rb * g.ldb + C) * 2u; }
    const size_t kstep = (size_t)(BK * 2);
    const size_t hstepA = (size_t)HALF * g.lda * 2, hstepB = (size_t)HALF * g.ldb * 2;
    const size_t tstepA = 2 * hstepA, tstepB = 2 * hstepB;
    const unsigned ldsw = (unsigned)wid * 1024u;
    const int aoff = lds_byte(wr * 64 + fr, fq * 8), boff = lds_byte(wc * 32 + fr, fq * 8);
#define PG8_SA(b, h) (((b) * 2 + (h)) * HTB)
#define PG8_SB(b, h) ((4 + (b) * 2 + (h)) * HTB)
#define PG8_STAGE(bufoff, gbase, voff) do { _Pragma("unroll") for (int _i = 0; _i < 2; ++_i) \
        __builtin_amdgcn_global_load_lds((const unsigned*)((const char*)(gbase) + (voff)[_i]), (PG8_LAS unsigned*)(lds + (bufoff) + ldsw + _i * 8192), 16, 0, 0); } while (0)
#define PG8_LDA(dst, b, h) do { _Pragma("unroll") for (int m = 0; m < 4; ++m) _Pragma("unroll") for (int k = 0; k < 2; ++k) dst[m][k] = *(const PG8_LAS bf16x8*)(lds + PG8_SA(b, h) + aoff + m * 2048 + k * 1024); } while (0)
#define PG8_LDB(dst, b, h) do { _Pragma("unroll") for (int n = 0; n < 2; ++n) _Pragma("unroll") for (int k = 0; k < 2; ++k) dst[n][k] = *(const PG8_LAS bf16x8*)(lds + PG8_SB(b, h) + boff + n * 2048 + k * 1024); } while (0)
#define PG8_MMA(ai, bj, At, Bt) do { __builtin_amdgcn_s_setprio(1); _Pragma("unroll") for (int m = 0; m < 4; ++m) _Pragma("unroll") for (int n = 0; n < 2; ++n) _Pragma("unroll") for (int k = 0; k < 2; ++k) \
        acc[ai][bj][m][n] = __builtin_amdgcn_mfma_f32_16x16x32_bf16(Bt[n][k], At[m][k], acc[ai][bj][m][n], 0, 0, 0); __builtin_amdgcn_s_setprio(0); } while (0)
#define PG8_WAIT_V(n) asm volatile("s_waitcnt vmcnt(" #n ")" ::: "memory")
#define PG8_WAIT_L(n) asm volatile("s_waitcnt lgkmcnt(" #n ")" ::: "memory")
#define PG8_BAR __builtin_amdgcn_s_barrier()
#define PG8_SCHED __builtin_amdgcn_sched_barrier(0)
    Unit cur, nxt; int ui = 0;
    if (!S.next(0, cur)) return;
    f32x4 acc[2][2][4][2];
#pragma unroll
    for (int a = 0; a < 2; ++a)
#pragma unroll
        for (int b = 0; b < 2; ++b)
#pragma unroll
            for (int m = 0; m < 4; ++m)
#pragma unroll
                for (int n = 0; n < 2; ++n) acc[a][b][m][n] = (f32x4){0.f, 0.f, 0.f, 0.f};
    bf16x8 At[4][2], B0[2][2], B1[2][2];
    const char* cA = (const char*)g.A + (size_t)cur.pm * tstepA; const char* cB = (const char*)g.Bt + (size_t)cur.pn * tstepB;
    S.a_ready(cur);
    if constexpr (SP2) {
        PG8_STAGE(PG8_SB(0, 0), cB, voffB); PG8_STAGE(PG8_SB(0, 1), cB + hstepB, voffB); PG8_STAGE(PG8_SA(0, 0), cA, voffA); PG8_STAGE(PG8_SA(0, 1), cA + hstepA, voffA);
        if (wr == 1) PG8_BAR;
        PG8_WAIT_V(2); PG8_BAR;
        PG8_STAGE(PG8_SB(1, 0), cB + kstep, voffB); PG8_STAGE(PG8_SA(1, 0), cA + kstep, voffA); PG8_STAGE(PG8_SB(1, 1), cB + hstepB + kstep, voffB);
        PG8_WAIT_V(6); PG8_BAR;
    } else {
        PG8_STAGE(PG8_SB(0, 0), cB, voffB); PG8_STAGE(PG8_SA(0, 0), cA, voffA); PG8_STAGE(PG8_SB(0, 1), cB + hstepB, voffB); PG8_STAGE(PG8_SA(0, 1), cA + hstepA, voffA);
        if (wr == 1) PG8_BAR;
        PG8_WAIT_V(4); PG8_BAR;
        PG8_STAGE(PG8_SB(1, 0), cB + kstep, voffB); PG8_STAGE(PG8_SA(1, 0), cA + kstep, voffA); PG8_STAGE(PG8_SB(1, 1), cB + hstepB + kstep, voffB);
        PG8_WAIT_V(6); PG8_BAR;
    }
    for (;;) {
        const bool has_next = S.next(ui + 1, nxt);
        const char* nA = has_next ? (const char*)g.A + (size_t)nxt.pm * tstepA : cA; const char* nB = has_next ? (const char*)g.Bt + (size_t)nxt.pn * tstepB : cB;
        for (int t = 0; t < nt; t += 2) {
            const bool last = (t == nt - 2);
            const char* a1 = cA + (size_t)(t + 1) * kstep;
            const char* a2 = last ? nA : cA + (size_t)(t + 2) * kstep; const char* b2 = last ? nB : cB + (size_t)(t + 2) * kstep;
            const char* a3 = a2 + kstep; const char* b3 = b2 + kstep;
            if (last && has_next) S.a_ready(nxt);
            if constexpr (SP2) {
            PG8_LDB(B0, 0, 0); PG8_LDB(B1, 0, 1); PG8_SCHED; PG8_LDA(At, 0, 0); PG8_STAGE(PG8_SA(1, 1), a1 + hstepA, voffA);
            PG8_WAIT_V(8); PG8_WAIT_L(0); PG8_BAR; PG8_MMA(0, 0, At, B0); PG8_MMA(0, 1, At, B1); PG8_BAR; PG8_SCHED;
            PG8_LDA(At, 0, 1); PG8_STAGE(PG8_SB(0, 0), b2, voffB); PG8_STAGE(PG8_SB(0, 1), b2 + hstepB, voffB); PG8_STAGE(PG8_SA(0, 0), a2, voffA);
            PG8_WAIT_V(8); PG8_WAIT_L(0); PG8_BAR; PG8_MMA(1, 0, At, B0); PG8_MMA(1, 1, At, B1); PG8_BAR; PG8_SCHED;
            PG8_LDB(B0, 1, 0); PG8_LDB(B1, 1, 1); PG8_SCHED; PG8_LDA(At, 1, 0); PG8_STAGE(PG8_SA(0, 1), a2 + hstepA, voffA);
            PG8_WAIT_V(8); PG8_WAIT_L(0); PG8_BAR; PG8_MMA(0, 0, At, B0); PG8_MMA(0, 1, At, B1); PG8_BAR; PG8_SCHED;
            PG8_LDA(At, 1, 1); PG8_STAGE(PG8_SB(1, 0), b3, voffB); PG8_STAGE(PG8_SB(1, 1), b3 + hstepB, voffB); PG8_STAGE(PG8_SA(1, 0), a3, voffA);
            PG8_WAIT_V(8); PG8_WAIT_L(0); PG8_BAR; PG8_MMA(1, 0, At, B0); PG8_MMA(1, 1, At, B1); PG8_BAR; PG8_SCHED;
            } else {
            PG8_LDB(B0, 0, 0); PG8_SCHED; PG8_LDA(At, 0, 0); PG8_STAGE(PG8_SA(1, 1), a1 + hstepA, voffA);
            PG8_WAIT_L(8); PG8_BAR; PG8_WAIT_L(0); PG8_MMA(0, 0, At, B0); PG8_BAR; PG8_SCHED;
            PG8_LDB(B1, 0, 1); PG8_STAGE(PG8_SB(0, 0), b2, voffB);
            PG8_BAR; PG8_WAIT_L(0); PG8_MMA(0, 1, At, B1); PG8_BAR;
            PG8_LDA(At, 0, 1); PG8_STAGE(PG8_SA(0, 0), a2, voffA);
            PG8_BAR; PG8_WAIT_L(0); PG8_MMA(1, 0, At, B0); PG8_BAR; PG8_SCHED;
            PG8_STAGE(PG8_SB(0, 1), b2 + hstepB, voffB);
            PG8_WAIT_V(6); PG8_BAR; PG8_MMA(1, 1, At, B1); PG8_BAR;
            PG8_LDB(B0, 1, 0); PG8_SCHED; PG8_LDA(At, 1, 0); PG8_STAGE(PG8_SA(0, 1), a2 + hstepA, voffA);
            PG8_WAIT_L(8); PG8_BAR; PG8_WAIT_L(0); PG8_MMA(0, 0, At, B0); PG8_BAR; PG8_SCHED;
            PG8_LDB(B1, 1, 1); PG8_STAGE(PG8_SB(1, 0), b3, voffB);
            PG8_BAR; PG8_WAIT_L(0); PG8_MMA(0, 1, At, B1); PG8_BAR;
            PG8_LDA(At, 1, 1); PG8_STAGE(PG8_SA(1, 0), a3, voffA);
            PG8_BAR; PG8_WAIT_L(0); PG8_MMA(1, 0, At, B0); PG8_BAR; PG8_SCHED;
            PG8_STAGE(PG8_SB(1, 1), b3 + hstepB, voffB);
            PG8_WAIT_V(6); PG8_BAR; PG8_MMA(1, 1, At, B1); PG8_BAR;
            }
        }
        if constexpr (ALIGN_EPI) { if (wr == 0) PG8_BAR; }
        E(acc, cur, wr, wc, fr, fq); S.done(cur);
        if (!has_next) break;
#pragma unroll
        for (int a = 0; a < 2; ++a)
#pragma unroll
            for (int b = 0; b < 2; ++b)
#pragma unroll
                for (int m = 0; m < 4; ++m)
#pragma unroll
                    for (int n = 0; n < 2; ++n) acc[a][b][m][n] = (f32x4){0.f, 0.f, 0.f, 0.f};
        cur = nxt; cA = nA; cB = nB; ++ui;
        if constexpr (ALIGN_EPI) { if (wr == 1) PG8_BAR; }
    }
    PG8_WAIT_V(0);
    if constexpr (!ALIGN_EPI) { if (wr == 0) PG8_BAR; }
    PG8_BAR;
#undef PG8_SA
#undef PG8_SB
#undef PG8_STAGE
#undef PG8_LDA
#undef PG8_LDB
#undef PG8_MMA
#undef PG8_WAIT_V
#undef PG8_WAIT_L
#undef PG8_BAR
#undef PG8_SCHED
}
}

constexpr int NWAVES = 8;
constexpr int M = 8192, T = 2048, D = 2048, DFF = 5504, NUP = 2 * DFF, DIN = 15296, DINP = 15360, DEPTH = 4;
constexpr int U_OFF = 0, Q_OFF = 1024, K_OFF = 2560, V_OFF = 4096, RW_OFF = 5632, GATE_OFF = 9152;
constexpr int RWP = 3520, RW = 1024, AW = 1536;
constexpr float RMS_EPS = 1e-6f;
constexpr int NPH = 15;
constexpr int NPHASES = 1 + DEPTH * NPH;

constexpr size_t MiB = 1u << 20;
constexpr size_t WS_CTL = 0, CTL_ZERO_BYTES = 1 * MiB;
constexpr int CW_BAR = 4096;
constexpr size_t SS_OFF = 256 * 1024;
constexpr size_t WS_X = 1 * MiB;
constexpr size_t WS_XB = WS_X + 64 * MiB;
constexpr size_t WS_HID = WS_XB + 32 * MiB;
constexpr size_t WS_PROJ = WS_HID + 86 * MiB;
constexpr size_t WS_W = WS_PROJ + 240 * MiB;
constexpr size_t W_UP1 = WS_W, W_DN1 = W_UP1 + 43 * MiB, W_IN = W_DN1 + 22 * MiB, W_GLU = W_IN + 60 * MiB, W_W2 = W_GLU + 2 * MiB, W_A2 = W_W2 + MiB / 2,
                 W_G2 = W_A2 + MiB / 2, W_V1 = W_G2 + MiB / 2, W_V2 = W_V1 + MiB / 2, W_BS5 = W_V2 + MiB / 2, W_BAT = W_BS5 + 4 * MiB, W_BRW = W_BAT + 2 * MiB,
                 W_OUT = W_BRW + 4 * MiB, W_UP2 = W_OUT + 8 * MiB, W_DN2 = W_UP2 + 43 * MiB, WS_WEND = W_DN2 + 22 * MiB;
constexpr size_t WS_RP = WS_WEND, WS_KP = WS_RP + 32 * MiB, WS_VP = WS_KP + 32 * MiB, WS_DECAY = WS_VP + 32 * MiB, WS_ASIG = WS_DECAY + 32 * MiB, WS_G = WS_ASIG + 32 * MiB,
                 WS_KK = WS_G + 32 * MiB, WS_VFIRST = WS_KK + 32 * MiB, WS_YRAW = WS_VFIRST + 32 * MiB;
constexpr size_t WS_LORA = WS_YRAW + 32 * MiB;
constexpr size_t WS_AV = WS_LORA + 12 * MiB;
constexpr size_t WS_V1O = WS_AV + 16 * MiB;
constexpr size_t WS_QN = WS_V1O + 4 * MiB, WS_KN = WS_QN + 24 * MiB;
constexpr size_t WS_Z = WS_KN + 24 * MiB, WS_YS5 = WS_Z + 16 * MiB, WS_YATT = WS_YS5 + 16 * MiB, WS_YRWKV = WS_YATT + 8 * MiB;
constexpr size_t WS_MERGED = WS_YRWKV + 16 * MiB, WS_MERGEDB = WS_MERGED + 64 * MiB;
constexpr size_t WS_SBUF = WS_MERGEDB + 32 * MiB;
constexpr size_t WS_SSP = WS_SBUF + 256 * MiB;
constexpr size_t WS_END = WS_SSP + 16 * MiB;

constexpr int RING_OFF = 0, RING_BYTES = 131072, LDSCTL_OFF = RING_BYTES, LDS_BYTES = 147456;

#define GAS __attribute__((address_space(1)))
#define LAS __attribute__((address_space(3)))
typedef unsigned short bf16;
typedef unsigned v4u __attribute__((ext_vector_type(4)));
typedef unsigned v2u __attribute__((ext_vector_type(2)));
typedef float f32x4 __attribute__((ext_vector_type(4)));
typedef float f32x2 __attribute__((ext_vector_type(2)));
#define LDS_WAIT() asm volatile("s_waitcnt lgkmcnt(0)" ::: "memory")
#define VM_WAIT() asm volatile("s_waitcnt vmcnt(0)" ::: "memory")
__device__ __forceinline__ unsigned f2bf(float f) { unsigned u = __builtin_bit_cast(unsigned, f); return (u + 0x7fffu + ((u >> 16) & 1u)) >> 16; }
__device__ __forceinline__ unsigned pk2(float lo, float hi) { return f2bf(lo) | (f2bf(hi) << 16); }
__device__ __forceinline__ float bf2f(unsigned short b) { return __builtin_bit_cast(float, (unsigned)b << 16); }
__device__ __forceinline__ float bflo(unsigned w) { return __builtin_bit_cast(float, w << 16); }
__device__ __forceinline__ float bfhi(unsigned w) { return __builtin_bit_cast(float, w & 0xffff0000u); }
__device__ __forceinline__ float shx(float v, int o, int lane) { return __builtin_bit_cast(float, __builtin_amdgcn_ds_bpermute((lane ^ o) << 2, __builtin_bit_cast(int, v))); }
__device__ __forceinline__ float wave_sum(float v, int lane) {
#pragma unroll
    for (int o = 32; o >= 1; o >>= 1) v += shx(v, o, lane);
    return v;
}
__device__ __forceinline__ float row16_sum(float v) {
    v += __builtin_bit_cast(float, __builtin_amdgcn_update_dpp(0, __builtin_bit_cast(int, v), 0x128, 0xf, 0xf, false));
    v += __builtin_bit_cast(float, __builtin_amdgcn_update_dpp(0, __builtin_bit_cast(int, v), 0x124, 0xf, 0xf, false));
    v += __builtin_bit_cast(float, __builtin_amdgcn_update_dpp(0, __builtin_bit_cast(int, v), 0x122, 0xf, 0xf, false));
    v += __builtin_bit_cast(float, __builtin_amdgcn_update_dpp(0, __builtin_bit_cast(int, v), 0x121, 0xf, 0xf, false));
    return v;
}
__device__ __forceinline__ float sigmoidf_(float x) { return 1.0f / (1.0f + __expf(-x)); }

#define XB_TMO      128
#define XB_XCNT(j)  (256  + 64 * (j))
#define XB_XSUB(j)  (1280 + 64 * (j))
#define XB_XGEN(j)  (2304 + 64 * (j))
#define XB_TOP      3328
#define XB_TOPGEN   3392
#define XCD_BAR_WORDS 3456
#define XB_SPIN_CAP (1u << 18)
__device__ __forceinline__ unsigned xb_ld(unsigned* p)              { return __hip_atomic_load(p, __ATOMIC_RELAXED, __HIP_MEMORY_SCOPE_AGENT); }
__device__ __forceinline__ unsigned xb_add(unsigned* p, unsigned v) { return __hip_atomic_fetch_add(p, v, __ATOMIC_RELAXED, __HIP_MEMORY_SCOPE_AGENT); }
__device__ __forceinline__ unsigned xb_xcc_id() { return (unsigned)__builtin_amdgcn_s_getreg((3 << 11) | 20) & 0xFu; }
#define XB_SPIN(cond, bar) do { unsigned _sp = 0; while (cond) { __builtin_amdgcn_s_sleep(1); \
    if ((++_sp & 255u) == 0u) { if (xb_ld(&(bar)[XB_TMO])) break; if (_sp > XB_SPIN_CAP) { atomicAdd(&(bar)[XB_TMO], 1u); break; } } } } while (0)
struct XcdBarrier { unsigned* bar; unsigned x; volatile LAS unsigned* st; };
__device__ __forceinline__ XcdBarrier xcd_barrier_post(unsigned* bar, volatile LAS unsigned* st) {
    XcdBarrier b; b.bar = bar; b.x = xb_xcc_id(); b.st = st;
    if (threadIdx.x == 0) (void)xb_add(&bar[XB_XCNT(b.x)], 1u);
    return b;
}
__device__ __forceinline__ void xcd_barrier_complete(unsigned* bar, unsigned x, unsigned& nloc, unsigned& nx) {
    const unsigned G = gridDim.x * gridDim.y * gridDim.z;
    unsigned sum, cnt, mine, sp = 0u;
    for (;;) {
        sum = 0u; cnt = 0u; mine = 0u;
#pragma unroll
        for (unsigned j = 0; j < 16; ++j) { const unsigned c = xb_ld(&bar[XB_XCNT(j)]); sum += c; cnt += (c > 0u) ? 1u : 0u; mine = (j == x) ? c : mine; }
        if (sum == G) break;
        __builtin_amdgcn_s_sleep(1);
        if ((++sp & 255u) == 0u) { if (xb_ld(&bar[XB_TMO])) break; if (sp > XB_SPIN_CAP) { atomicAdd(&bar[XB_TMO], 1u); break; } }
    }
    nloc = mine > 0u ? mine : 1u; nx = cnt > 0u ? cnt : 1u;
}
__device__ __forceinline__ void xcd_barrier(const XcdBarrier& b) {
    asm volatile("s_waitcnt vmcnt(0)" ::: "memory");
    __syncthreads();
    if (threadIdx.x == 0) {
        unsigned* bar = b.bar;
        __builtin_amdgcn_s_waitcnt(0);
        unsigned nloc = b.st[0], nx = b.st[1];
        if (nloc == 0u) { xcd_barrier_complete(bar, b.x, nloc, nx); b.st[0] = nloc; b.st[1] = nx; }
        const unsigned old = xb_add(&bar[XB_XSUB(b.x)], 1u);
        const unsigned gen = old / nloc;
        if (old + 1u == (gen + 1u) * nloc) {
            __builtin_amdgcn_fence(__ATOMIC_RELEASE, "agent");
            asm volatile("s_waitcnt vmcnt(0)" ::: "memory");
            const unsigned og = xb_add(&bar[XB_TOP], 1u);
            const unsigned tg = og / nx;
            if (og + 1u == (tg + 1u) * nx) xb_add(&bar[XB_TOPGEN], 1u);
            else XB_SPIN(xb_ld(&bar[XB_TOPGEN]) == tg, bar);
            __builtin_amdgcn_fence(__ATOMIC_ACQUIRE, "agent");
            xb_add(&bar[XB_XGEN(b.x)], 1u);
            asm volatile("s_waitcnt vmcnt(0)" ::: "memory");
        } else {
            XB_SPIN(xb_ld(&bar[XB_XGEN(b.x)]) == gen, bar);
            __builtin_amdgcn_fence(__ATOMIC_ACQUIRE, "agent");
            asm volatile("s_waitcnt vmcnt(0)" ::: "memory");
        }
    }
    __syncthreads();
}

using pg8::Unit; using pg8::cvt_pk_bf16;
__device__ __forceinline__ int fresh_lane() { int l; asm volatile("v_mbcnt_lo_u32_b32 %0, -1, 0\n\tv_mbcnt_hi_u32_b32 %0, -1, %0" : "=v"(l)); return l; }
typedef const f32x4 (&AccRef)[2][2][4][2];

__device__ __forceinline__ float row_rstd(const float* ssp, int row) {
    const f32x4* p = (const f32x4*)(ssp + (size_t)row * 32); float s = 0.f;
#pragma unroll
    for (int j = 0; j < 8; ++j) { const f32x4 v = p[j]; s += (v.x + v.y) + (v.z + v.w); }
    return rsqrtf(s * (1.0f / D) + RMS_EPS);
}
struct EpiSwiGLU {
    static constexpr bool PERM = true;
    bf16* H; const float* ss;
    __device__ __forceinline__ void operator()(AccRef acc, const Unit& u, int wr, int wc, int, int) const {
        const int ln_ = fresh_lane(), fr = ln_ & 15, fq = ln_ >> 4;
        const int row0 = u.pm * 256 + wr * 64 + fr, col0 = u.pn * 128 + wc * 32 + 8 * fq;
#pragma unroll
        for (int ai = 0; ai < 2; ++ai)
#pragma unroll
            for (int m = 0; m < 4; ++m) {
                const int row = row0 + ai * 128 + m * 16;
                const float r = row_rstd(ss, row);
                float h[8];
#pragma unroll
                for (int n = 0; n < 2; ++n)
#pragma unroll
                    for (int j = 0; j < 4; ++j) { const float a = acc[ai][0][m][n][j] * r, b = acc[ai][1][m][n][j] * r; h[4 * n + j] = a * __builtin_amdgcn_rcpf(1.0f + __expf(-a)) * b; }
                v4u w; w.x = cvt_pk_bf16(h[0], h[1]); w.y = cvt_pk_bf16(h[2], h[3]); w.z = cvt_pk_bf16(h[4], h[5]); w.w = cvt_pk_bf16(h[6], h[7]);
                *(v4u*)(H + (size_t)row * DFF + col0) = w;
            }
    }
};
struct EpiResid {
    static constexpr bool PERM = true;
    const float* xin; float* xout; bf16* xb; float* ss; float alpha;
    __device__ __forceinline__ void operator()(AccRef acc, const Unit& u, int wr, int wc, int, int) const {
        const int ln_ = fresh_lane(), fr = ln_ & 15, fq = ln_ >> 4;
        const int row0 = u.pm * 256 + wr * 64 + fr, col0 = u.pn * 256 + wc * 32 + 8 * fq;
#pragma unroll
        for (int ai = 0; ai < 2; ++ai)
#pragma unroll
            for (int m = 0; m < 4; ++m) {
                const int row = row0 + ai * 128 + m * 16; float s = 0.f;
#pragma unroll
                for (int bj = 0; bj < 2; ++bj) {
                    const size_t p = (size_t)row * D + col0 + bj * 128;
                    f32x4 x0 = *(const f32x4*)(xin + p), x1 = *(const f32x4*)(xin + p + 4);
                    x0 = x0 + alpha * acc[ai][bj][m][0]; x1 = x1 + alpha * acc[ai][bj][m][1];
                    *(f32x4*)(xout + p) = x0; *(f32x4*)(xout + p + 4) = x1;
                    v4u w; w.x = cvt_pk_bf16(x0[0], x0[1]); w.y = cvt_pk_bf16(x0[2], x0[3]); w.z = cvt_pk_bf16(x1[0], x1[1]); w.w = cvt_pk_bf16(x1[2], x1[3]);
                    *(v4u*)(xb + p) = w;
                    s += (x0[0] * x0[0] + x0[1] * x0[1]) + (x0[2] * x0[2] + x0[3] * x0[3]) + (x1[0] * x1[0] + x1[1] * x1[1]) + (x1[2] * x1[2] + x1[3] * x1[3]);
                }
                s += shx(s, 16, ln_); s += shx(s, 32, ln_);
                if (fq == 0) ss[(size_t)row * 32 + u.pn * 4 + wc] = s;
                asm volatile("" ::: "memory");
            }
    }
};
struct EpiProj {
    static constexpr bool PERM = true;
    bf16* O; const float* ss;
    __device__ __forceinline__ void operator()(AccRef acc, const Unit& u, int wr, int wc, int, int) const {
        const int ln_ = fresh_lane(), fr = ln_ & 15, fq = ln_ >> 4;
        const int row0 = u.pm * 256 + wr * 64 + fr, col0 = u.pn * 256 + wc * 32 + 8 * fq;
#pragma unroll
        for (int ai = 0; ai < 2; ++ai)
#pragma unroll
            for (int m = 0; m < 4; ++m) {
                const int row = row0 + ai * 128 + m * 16;
                const float r = row_rstd(ss, row);
#pragma unroll
                for (int bj = 0; bj < 2; ++bj) {
                    const f32x4 v0 = acc[ai][bj][m][0] * r, v1 = acc[ai][bj][m][1] * r;
                    v4u w; w.x = cvt_pk_bf16(v0[0], v0[1]); w.y = cvt_pk_bf16(v0[2], v0[3]); w.z = cvt_pk_bf16(v1[0], v1[1]); w.w = cvt_pk_bf16(v1[2], v1[3]);
                    *(v4u*)(O + (size_t)row * DINP + col0 + bj * 128) = w;
                }
            }
    }
};
template <class F> struct EpiF {
    static constexpr bool PERM = true;
    F f;
    __device__ __forceinline__ void operator()(AccRef acc, const Unit& u, int wr, int wc, int, int) const {
        const int ln_ = fresh_lane(), fr = ln_ & 15, fq = ln_ >> 4;
        const int row0 = u.pm * 256 + wr * 64 + fr, col0 = u.pn * 256 + wc * 32 + 8 * fq;
#pragma unroll
        for (int ai = 0; ai < 2; ++ai)
#pragma unroll
            for (int m = 0; m < 4; ++m)
#pragma unroll
                for (int bj = 0; bj < 2; ++bj) { f(row0 + ai * 128 + m * 16, col0 + bj * 128, acc[ai][bj][m][0], acc[ai][bj][m][1]); asm volatile("" ::: "memory"); }
    }
};
struct FDecay { const float* w0; float* out;
    __device__ __forceinline__ void operator()(int row, int col, f32x4 v0, f32x4 v1) const {
        float o[8];
#pragma unroll
        for (int j = 0; j < 8; ++j) { const float x = w0[col + j] + (j < 4 ? v0[j & 3] : v1[j & 3]); o[j] = __expf(-0.6065306597126334f * sigmoidf_(x)); }
        float* p = out + (size_t)row * RW + col; *(f32x4*)p = (f32x4){o[0], o[1], o[2], o[3]}; *(f32x4*)(p + 4) = (f32x4){o[4], o[5], o[6], o[7]}; } };
struct FASig { const float* a0; float* out;
    __device__ __forceinline__ void operator()(int row, int col, f32x4 v0, f32x4 v1) const {
        float o[8];
#pragma unroll
        for (int j = 0; j < 8; ++j) o[j] = sigmoidf_(a0[col + j] + (j < 4 ? v0[j & 3] : v1[j & 3]));
        float* p = out + (size_t)row * RW + col; *(f32x4*)p = (f32x4){o[0], o[1], o[2], o[3]}; *(f32x4*)(p + 4) = (f32x4){o[4], o[5], o[6], o[7]}; } };
struct FStoreF32 { float* out; int ld;
    __device__ __forceinline__ void operator()(int row, int col, f32x4 v0, f32x4 v1) const { float* p = out + (size_t)row * ld + col; *(f32x4*)p = v0; *(f32x4*)(p + 4) = v1; } };
struct FStoreBf16 { bf16* out; int ld;
    __device__ __forceinline__ void operator()(int row, int col, f32x4 v0, f32x4 v1) const {
        v4u w; w.x = cvt_pk_bf16(v0[0], v0[1]); w.y = cvt_pk_bf16(v0[2], v0[3]); w.z = cvt_pk_bf16(v1[0], v1[1]); w.w = cvt_pk_bf16(v1[2], v1[3]);
        *(v4u*)(out + (size_t)row * ld + col) = w; } };
struct FVres { const float* v0p; float* VP; const float* VF;
    __device__ __forceinline__ void operator()(int row, int col, f32x4 a0, f32x4 a1) const {
        const size_t p = (size_t)row * RW + col;
        f32x4 x0 = *(const f32x4*)(VP + p), x1 = *(const f32x4*)(VP + p + 4); const f32x4 f0 = *(const f32x4*)(VF + p), f1 = *(const f32x4*)(VF + p + 4);
#pragma unroll
        for (int j = 0; j < 4; ++j) { x0[j] = x0[j] + (f0[j] - x0[j]) * sigmoidf_(v0p[col + j] + a0[j]); x1[j] = x1[j] + (f1[j] - x1[j]) * sigmoidf_(v0p[col + 4 + j] + a1[j]); }
        *(f32x4*)(VP + p) = x0; *(f32x4*)(VP + p + 4) = x1; } };
struct FGlu { const bf16* Z; bf16* Y;
    __device__ __forceinline__ void operator()(int row, int col, f32x4 a0, f32x4 a1) const {
        const size_t p = (size_t)row * 1024 + col; const v4u z = *(const v4u*)(Z + p);
        const float z0 = bflo(z.x), z1 = bfhi(z.x), z2 = bflo(z.y), z3 = bfhi(z.y), z4 = bflo(z.z), z5 = bfhi(z.z), z6 = bflo(z.w), z7 = bfhi(z.w);
        v4u w; w.x = cvt_pk_bf16(z0 * sigmoidf_(a0[0]), z1 * sigmoidf_(a0[1])); w.y = cvt_pk_bf16(z2 * sigmoidf_(a0[2]), z3 * sigmoidf_(a0[3]));
        w.z = cvt_pk_bf16(z4 * sigmoidf_(a1[0]), z5 * sigmoidf_(a1[1])); w.w = cvt_pk_bf16(z6 * sigmoidf_(a1[2]), z7 * sigmoidf_(a1[3]));
        *(v4u*)(Y + p) = w; } };
template <int MODE> struct FBranch { const bf16* PROJ; int goff; float* MG; bf16* MGB;
    __device__ __forceinline__ void operator()(int row, int col, f32x4 a0, f32x4 a1) const {
        const v4u gq = *(const v4u*)(PROJ + (size_t)row * DINP + goff + col);
        const float g0 = sigmoidf_(bflo(gq.x)), g1 = sigmoidf_(bfhi(gq.x)), g2 = sigmoidf_(bflo(gq.y)), g3 = sigmoidf_(bfhi(gq.y)), g4 = sigmoidf_(bflo(gq.z)), g5 = sigmoidf_(bfhi(gq.z)), g6 = sigmoidf_(bflo(gq.w)), g7 = sigmoidf_(bfhi(gq.w));
        const size_t p = (size_t)row * D + col;
        f32x4 x0 = (f32x4){g0 * a0[0], g1 * a0[1], g2 * a0[2], g3 * a0[3]}, x1 = (f32x4){g4 * a1[0], g5 * a1[1], g6 * a1[2], g7 * a1[3]};
        if (MODE != 0) { x0 = x0 + *(const f32x4*)(MG + p); x1 = x1 + *(const f32x4*)(MG + p + 4); }
        if (MODE != 2) { *(f32x4*)(MG + p) = x0; *(f32x4*)(MG + p + 4) = x1; }
        else { v4u w; w.x = cvt_pk_bf16(x0[0], x0[1]); w.y = cvt_pk_bf16(x0[2], x0[3]); w.z = cvt_pk_bf16(x1[0], x1[1]); w.w = cvt_pk_bf16(x1[2], x1[3]); *(v4u*)(MGB + p) = w; } } };

__device__ __forceinline__ void conv_item(const float* W, int ldw, int Ksrc, int srcc, const float* ks, bf16* dst, int ldd, int drow0, int k0, LAS float* scr, int lane) {
#pragma unroll 8
    for (int i = 0; i < 32; ++i) { const int kk = 2 * i + (lane >> 5), k = k0 + kk; float v = 0.f;
        if (srcc >= 0 && k < Ksrc) { v = W[(size_t)k * ldw + srcc + (lane & 31)]; if (ks) v *= ks[k]; }
        scr[kk * 33 + (lane & 31)] = v; }
    LDS_WAIT(); asm volatile("" ::: "memory");
    const int c = lane & 7;
#pragma unroll
    for (int j = 0; j < 4; ++j) { const int n = (lane >> 3) + 8 * j; const LAS float* s = scr + (8 * c) * 33 + n;
        v4u o; o.x = pk2(s[0 * 33], s[1 * 33]); o.y = pk2(s[2 * 33], s[3 * 33]); o.z = pk2(s[4 * 33], s[5 * 33]); o.w = pk2(s[6 * 33], s[7 * 33]);
        *(v4u*)(dst + (size_t)(drow0 + n) * ldd + k0 + 8 * c) = o; }
    LDS_WAIT(); asm volatile("" ::: "memory");
}
template <int MAP> __device__ __forceinline__ void conv_mat_item(const float* W, int ldw, int Ksrc, int Kdst, int Nsrc, int Ndst, const float* ks, bf16* dst, int item, LAS float* scr, int lane) {
    const int nblk = Ndst / 32, kb = item / nblk, nb = item % nblk, n0 = 32 * nb;
    int srcc;
    if (MAP == 0) srcc = (n0 < Nsrc) ? n0 : -1;
    else { const int tile = n0 >> 8, within = n0 & 255, bj = within >> 7, c = within & 127; srcc = bj * DFF + tile * 128 + c; }
    conv_item(W, ldw, Ksrc, srcc, ks, dst, Kdst, n0, 64 * kb, scr, lane);
}

__device__ __forceinline__ bool in_range(int lo, int hi, int k) { asm volatile("" : "+s"(k)); return lo <= k && k < hi; }
struct Args { const float* in[38]; float* out; unsigned char* ws; int ph_lo, ph_hi, use_bar, pad; };
typedef const Args __attribute__((address_space(4)))* KArgs;

__global__ void __launch_bounds__(NWAVES * 64, 2) mk_fwd(Args args) {
    extern __shared__ __attribute__((aligned(16))) unsigned char lds_raw[];
    LAS unsigned char* lds = (LAS unsigned char*)lds_raw;
    for (int u = threadIdx.x; u < (LDS_BYTES - LDSCTL_OFF) / 4; u += NWAVES * 64) ((LAS unsigned*)(lds + LDSCTL_OFF))[u] = 0u;
    __syncthreads();
    XcdBarrier bar; bar.bar = (unsigned*)(args.ws + WS_CTL) + CW_BAR; bar.x = 0; bar.st = nullptr;
    if (args.use_bar) bar = xcd_barrier_post((unsigned*)(args.ws + WS_CTL) + CW_BAR, (volatile LAS unsigned*)(lds + LDSCTL_OFF + 64));

    const int lo = args.ph_lo, hi = args.ph_hi, use_bar = args.use_bar;
    const int wave0 = __builtin_amdgcn_readfirstlane((int)threadIdx.x >> 6);
#ifndef PHMASK
#define PHMASK 0xFFFF
#endif
#define EN(p) ((PHMASK >> (p)) & 1)
#define IN(k) in_range(lo, hi, (k))
#define SEAM(k) do { if (IN(k) && IN((k) + 1)) { if (use_bar) { XcdBarrier b_ = bar; asm volatile("" : "+s"(b_.bar), "+s"(b_.x)); xcd_barrier(b_); } } } while (0)
#define PH_LOCALS \
    int lane; asm volatile("v_mbcnt_lo_u32_b32 %0, -1, 0\n\tv_mbcnt_hi_u32_b32 %0, -1, %0" : "=v"(lane)); int wave = wave0; asm volatile("" : "+s"(wave)); const int tid = wave * 64 + lane; \
    int G = gridDim.x, bid = blockIdx.x; asm volatile("" : "+s"(G), "+s"(bid)); \
    KArgs ka = (KArgs)__builtin_amdgcn_kernarg_segment_ptr(); asm volatile("" : "+s"(ka)); \
    unsigned char* ws = ka->ws; \
    const int gw = bid * NWAVES + wave, NGW = G * NWAVES; const size_t gtid = (size_t)bid * (NWAVES * 64) + tid, NT = (size_t)G * (NWAVES * 64); \
    (void)lane; (void)gw; (void)NGW; (void)gtid; (void)NT;
#define P_X ((float*)(ws + WS_X))
#define P_XB ((bf16*)(ws + WS_XB))
#define P_HID ((bf16*)(ws + WS_HID))
#define P_PROJ ((bf16*)(ws + WS_PROJ))
#define P_SS ((float*)(ws + WS_SSP))
#define P_RP ((float*)(ws + WS_RP))
#define P_KP ((float*)(ws + WS_KP))
#define P_VP ((float*)(ws + WS_VP))
#define P_DECAY ((float*)(ws + WS_DECAY))
#define P_ASIG ((float*)(ws + WS_ASIG))
#define P_GG ((float*)(ws + WS_G))
#define P_KK ((float*)(ws + WS_KK))
#define P_VFIRST ((float*)(ws + WS_VFIRST))
#define P_YRAW ((float*)(ws + WS_YRAW))
#define P_LORA ((bf16*)(ws + WS_LORA))
#define P_AV ((bf16*)(ws + WS_AV))
#define P_V1O ((bf16*)(ws + WS_V1O))
#define P_QN ((bf16*)(ws + WS_QN))
#define P_KN ((bf16*)(ws + WS_KN))
#define P_Z ((bf16*)(ws + WS_Z))
#define P_YS5 ((bf16*)(ws + WS_YS5))
#define P_YATT ((bf16*)(ws + WS_YATT))
#define P_YRWKV ((bf16*)(ws + WS_YRWKV))
#define P_MERGED ((float*)(ws + WS_MERGED))
#define P_MERGEDB ((bf16*)(ws + WS_MERGEDB))
#define P_SBUF ((f32x2*)(ws + WS_SBUF))

    if (IN(0)) {
        PH_LOCALS
        const float* x = ka->in[0];
        for (int m = gw; m < M; m += NGW) {
            const f32x4* xr = (const f32x4*)(x + (size_t)m * D) + lane; float s = 0.f;
            v2u* o = (v2u*)(P_XB + (size_t)m * D) + lane;
#pragma unroll
            for (int j = 0; j < 8; ++j) { const f32x4 v = xr[64 * j]; s += (v.x * v.x + v.y * v.y) + (v.z * v.z + v.w * v.w); v2u w; w.x = pk2(v.x, v.y); w.y = pk2(v.z, v.w); o[64 * j] = w; }
            s = wave_sum(s, lane);
            if (lane < 32) P_SS[(size_t)m * 32 + lane] = lane == 0 ? s : 0.f;
        }
    }
    SEAM(0);

    for (int l = 0; l < DEPTH; ++l) {
        const int pb = 1 + l * NPH;
        if (hi <= pb || lo >= pb + NPH) continue;
        if (EN(0) && IN(pb + 0)) {
            PH_LOCALS
            LAS float* scr = (LAS float*)(lds + RING_OFF + wave * 16384);
            constexpr int I_UP = (D / 64) * (NUP / 32), I_DN = (DFF / 64) * (D / 32), I_IN = (D / 64) * (DINP / 32), I_GLU = 16 * 32, I_L = 4 * 32, I_V1 = 16 * 8, I_V2 = 4 * 32,
                          I_BS5 = 16 * 64, I_BAT = 8 * 64, I_BRW = 16 * 64, I_OUT = 32 * 64;
            constexpr int NITEMS = 2 * I_UP + 2 * I_DN + I_IN + I_GLU + 3 * I_L + I_V1 + I_V2 + I_BS5 + I_BAT + I_BRW + I_OUT;
            const int lv = l > 0 ? l - 1 : 0;
            for (int it = gw; it < NITEMS; it += NGW) {
                int r = it;
                if (r < I_UP) { conv_mat_item<1>(ka->in[2] + (size_t)l * D * NUP, NUP, D, D, NUP, NUP, ka->in[1] + l * D, (bf16*)(ws + W_UP1), r, scr, lane); continue; } r -= I_UP;
                if (r < I_UP) { conv_mat_item<1>(ka->in[36] + (size_t)l * D * NUP, NUP, D, D, NUP, NUP, ka->in[35] + l * D, (bf16*)(ws + W_UP2), r, scr, lane); continue; } r -= I_UP;
                if (r < I_IN) { conv_mat_item<0>(ka->in[5] + (size_t)l * D * DIN, DIN, D, D, DIN, DINP, ka->in[4] + l * D, (bf16*)(ws + W_IN), r, scr, lane); continue; } r -= I_IN;
                if (r < I_DN) { conv_mat_item<0>(ka->in[3] + (size_t)l * DFF * D, D, DFF, DFF, D, D, nullptr, (bf16*)(ws + W_DN1), r, scr, lane); continue; } r -= I_DN;
                if (r < I_DN) { conv_mat_item<0>(ka->in[37] + (size_t)l * DFF * D, D, DFF, DFF, D, D, nullptr, (bf16*)(ws + W_DN2), r, scr, lane); continue; } r -= I_DN;
                if (r < I_OUT) { conv_mat_item<0>(ka->in[34] + (size_t)l * D * D, D, D, D, D, D, nullptr, (bf16*)(ws + W_OUT), r, scr, lane); continue; } r -= I_OUT;
                if (r < I_BS5) { conv_mat_item<0>(ka->in[31] + (size_t)l * 1024 * D, D, 1024, 1024, D, D, nullptr, (bf16*)(ws + W_BS5), r, scr, lane); continue; } r -= I_BS5;
                if (r < I_BAT) { conv_mat_item<0>(ka->in[32] + (size_t)l * 512 * D, D, 512, 512, D, D, nullptr, (bf16*)(ws + W_BAT), r, scr, lane); continue; } r -= I_BAT;
                if (r < I_BRW) { conv_mat_item<0>(ka->in[33] + (size_t)l * 1024 * D, D, 1024, 1024, D, D, nullptr, (bf16*)(ws + W_BRW), r, scr, lane); continue; } r -= I_BRW;
                if (r < I_GLU) { conv_mat_item<0>(ka->in[14] + (size_t)l * 1024 * 1024, 1024, 1024, 1024, 1024, 1024, nullptr, (bf16*)(ws + W_GLU), r, scr, lane); continue; } r -= I_GLU;
                if (r < I_L) { conv_mat_item<0>(ka->in[19] + (size_t)l * 96 * RW, RW, 96, 256, RW, RW, nullptr, (bf16*)(ws + W_W2), r, scr, lane); continue; } r -= I_L;
                if (r < I_L) { conv_mat_item<0>(ka->in[21] + (size_t)l * 96 * RW, RW, 96, 256, RW, RW, nullptr, (bf16*)(ws + W_A2), r, scr, lane); continue; } r -= I_L;
                if (r < I_L) { conv_mat_item<0>(ka->in[22] + (size_t)l * 256 * RW, RW, 256, 256, RW, RW, nullptr, (bf16*)(ws + W_G2), r, scr, lane); continue; } r -= I_L;
                if (r < I_V1) { conv_mat_item<0>(ka->in[29] + (size_t)lv * RW * 64, 64, RW, RW, 64, 256, nullptr, (bf16*)(ws + W_V1), r, scr, lane); continue; } r -= I_V1;
                conv_mat_item<0>(ka->in[30] + (size_t)lv * 64 * RW, RW, 64, 256, RW, RW, nullptr, (bf16*)(ws + W_V2), r, scr, lane);
            }
        }
        SEAM(pb + 0);
        if (EN(1) && IN(pb + 1)) {
            PH_LOCALS
            pg8::Gemm g{P_XB, (const bf16*)(ws + W_UP1), M, NUP, D, D, D}; pg8::StaticOrder S; S.init(M, NUP, G, bid);
            EpiSwiGLU E{P_HID, P_SS + (size_t)(3 * l + 0) * M * 32};
            pg8::gemm_phase<EpiSwiGLU, pg8::StaticOrder, true, true>(lds + RING_OFF, g, S, E, tid);
        }
        SEAM(pb + 1);
        if (EN(2) && IN(pb + 2)) {
            PH_LOCALS
            pg8::Gemm g{P_HID, (const bf16*)(ws + W_DN1), M, D, DFF, DFF, DFF}; pg8::StaticOrder S; S.init(M, D, G, bid);
            EpiResid E{l == 0 ? ka->in[0] : P_X, P_X, P_XB, P_SS + (size_t)(3 * l + 1) * M * 32, 0.5f};
            pg8::gemm_phase<EpiResid, pg8::StaticOrder, true, true>(lds + RING_OFF, g, S, E, tid);
        }
        SEAM(pb + 2);
        if (EN(3) && IN(pb + 3)) {
            PH_LOCALS
            pg8::Gemm g{P_XB, (const bf16*)(ws + W_IN), M, DINP, D, D, D}; pg8::StaticOrder S; S.init(M, DINP, G, bid);
            EpiProj E{P_PROJ, P_SS + (size_t)(3 * l + 1) * M * 32};
            pg8::gemm_phase<EpiProj, pg8::StaticOrder, true, true>(lds + RING_OFF, g, S, E, tid);
        }
        SEAM(pb + 3);
        if (EN(4) && IN(pb + 4)) {
            PH_LOCALS
            const float* mu = ka->in[17] + (size_t)l * RWP;
            bf16* PROJ = P_PROJ; bf16* LORA = P_LORA;
            for (size_t idx = gtid; idx < (size_t)M * RWP; idx += NT) {
                const int m = (int)(idx / RWP), c = (int)(idx % RWP), t = m % T;
                const float pc = bf2f(PROJ[(size_t)m * DINP + RW_OFF + c]);
                const float pp = t > 0 ? bf2f(PROJ[(size_t)(m - 1) * DINP + RW_OFF + c]) : 0.f;
                const float p = pc + (pp - pc) * mu[c];
                if (c < 1024) P_RP[(size_t)m * RW + c] = p;
                else if (c < 2048) P_KP[(size_t)m * RW + c - 1024] = p;
                else if (c < 3072) { P_VP[(size_t)m * RW + c - 2048] = p; P_AV[(size_t)m * RW + c - 2048] = (bf16)f2bf(p); if (l == 0) P_VFIRST[(size_t)m * RW + c - 2048] = p; }
                else if (c < 3168) LORA[(size_t)m * 768 + c - 3072] = (bf16)f2bf(tanhf(p));
                else if (c < 3264) LORA[(size_t)m * 768 + 256 + c - 3168] = (bf16)f2bf(p);
                else LORA[(size_t)m * 768 + 512 + c - 3264] = (bf16)f2bf(sigmoidf_(p));
            }
            for (size_t idx = gtid; idx < (size_t)M * 320; idx += NT) {
                const int m = (int)(idx / 320), c = (int)(idx % 320);
                LORA[(size_t)m * 768 + (c < 160 ? 96 + c : 352 + (c - 160))] = 0;
            }
            const float* qg = ka->in[15] + l * 64; const float* kg = ka->in[16] + l * 64;
            for (int it = gw; it < M * 48; it += NGW) {
                const int m = it / 48, hh = it % 48, isk = hh >= 24, head = isk ? hh - 24 : hh;
                const float v = bf2f(PROJ[(size_t)m * DINP + (isk ? K_OFF : Q_OFF) + head * 64 + lane]);
                const float ssq = wave_sum(v * v, lane);
                const float o = v * rsqrtf(ssq * (1.0f / 64) + RMS_EPS) * (isk ? kg[lane] : qg[lane]);
                (isk ? P_KN : P_QN)[(size_t)m * AW + head * 64 + lane] = (bf16)f2bf(o);
            }
        }
        SEAM(pb + 4);
        if (EN(5) && IN(pb + 5)) {
            PH_LOCALS
            const bf16* PROJ = P_PROJ; bf16* Z = P_Z;
            LAS float* BUs = (LAS float*)(lds + wave * 12800);
            LAS unsigned* Ss = (LAS unsigned*)(lds + wave * 12800 + 8448);
            LAS float* Ex = (LAS float*)(lds + 8 * 12800);
            const int g4 = lane >> 4, i16 = lane & 15;
            for (int item = bid; item < 256; item += G) {
                const int b = item >> 6, g = item & 63;
                const float dt = expf(ka->in[12][l * 64 + g]);
                float ab_re, ab_im;
                { const float lam_re = fminf(ka->in[6][(l * 64 + g) * 64 + lane], -1e-4f), lam_im = ka->in[7][(l * 64 + g) * 64 + lane];
                  const float mag = expf(lam_re * dt); ab_re = mag * cosf(lam_im * dt); ab_im = mag * sinf(lam_im * dt); }
                pg8::bf16x8 Abb[8];
#pragma unroll
                for (int mt = 0; mt < 4; ++mt) {
                    const int pp = 16 * mt + i16;
                    const float lam_re = fminf(ka->in[6][(l * 64 + g) * 64 + pp], -1e-4f), lam_im = ka->in[7][(l * 64 + g) * 64 + pp];
                    const float mag = expf(lam_re * dt), are = mag * cosf(lam_im * dt), aim = mag * sinf(lam_im * dt);
                    const float den = lam_re * lam_re + lam_im * lam_im, nre = are - 1.0f;
                    const float cr = (nre * lam_re + aim * lam_im) / den, ci = (aim * lam_re - nre * lam_im) / den;
                    v4u wr_ = {0u, 0u, 0u, 0u}, wi_ = {0u, 0u, 0u, 0u};
                    if (g4 < 2) {
                        const float* bre = ka->in[8] + ((size_t)(l * 64 + g) * 64 + pp) * 16 + 8 * g4; const float* bim = ka->in[9] + ((size_t)(l * 64 + g) * 64 + pp) * 16 + 8 * g4;
                        const f32x4 r0 = *(const f32x4*)bre, r1 = *(const f32x4*)(bre + 4), m0_ = *(const f32x4*)bim, m1_ = *(const f32x4*)(bim + 4);
                        const f32x4 xr0 = cr * r0 - ci * m0_, xr1 = cr * r1 - ci * m1_, xi0 = cr * m0_ + ci * r0, xi1 = cr * m1_ + ci * r1;
                        wr_.x = cvt_pk_bf16(xr0[0], xr0[1]); wr_.y = cvt_pk_bf16(xr0[2], xr0[3]); wr_.z = cvt_pk_bf16(xr1[0], xr1[1]); wr_.w = cvt_pk_bf16(xr1[2], xr1[3]);
                        wi_.x = cvt_pk_bf16(xi0[0], xi0[1]); wi_.y = cvt_pk_bf16(xi0[2], xi0[3]); wi_.z = cvt_pk_bf16(xi1[0], xi1[1]); wi_.w = cvt_pk_bf16(xi1[2], xi1[3]);
                    }
                    Abb[mt] = __builtin_bit_cast(pg8::bf16x8, wr_); Abb[4 + mt] = __builtin_bit_cast(pg8::bf16x8, wi_);
                }
                pg8::bf16x8 Cop[4];
#pragma unroll
                for (int kb = 0; kb < 4; ++kb) {
                    const float* cre = ka->in[10] + ((size_t)(l * 64 + g) * 16 + i16) * 64 + 16 * kb + 4 * g4; const float* cim = ka->in[11] + ((size_t)(l * 64 + g) * 16 + i16) * 64 + 16 * kb + 4 * g4;
                    const f32x4 r = *(const f32x4*)cre, m = *(const f32x4*)cim;
                    v4u w; w.x = cvt_pk_bf16(r[0], -m[0]); w.y = cvt_pk_bf16(r[1], -m[1]); w.z = cvt_pk_bf16(r[2], -m[2]); w.w = cvt_pk_bf16(r[3], -m[3]);
                    Cop[kb] = __builtin_bit_cast(pg8::bf16x8, w);
                }
                const size_t tok0 = (size_t)b * T + wave * 256;
                float s_re = 0.f, s_im = 0.f;
#pragma unroll 1
                for (int pass = 0; pass < 2; ++pass) {
#pragma unroll 1
                    for (int st = 0; st < 16; ++st) {
                        const size_t rowt = tok0 + st * 16 + i16;
                        v4u uw = {0u, 0u, 0u, 0u};
                        if (g4 < 2) uw = *(const v4u*)(PROJ + rowt * DINP + U_OFF + g * 16 + 8 * g4);
                        const pg8::bf16x8 Uop = __builtin_bit_cast(pg8::bf16x8, uw);
#pragma unroll
                        for (int mt = 0; mt < 8; ++mt) { f32x4 d = {0.f, 0.f, 0.f, 0.f}; d = __builtin_amdgcn_mfma_f32_16x16x32_bf16(Abb[mt], Uop, d, 0, 0, 0);
                            *(LAS f32x4*)(BUs + i16 * 132 + 16 * mt + 4 * g4) = d; }
                        asm volatile("s_waitcnt lgkmcnt(0)" ::: "memory");
#pragma unroll
                        for (int tt = 0; tt < 16; ++tt) {
                            const float bur = BUs[tt * 132 + lane], bui = BUs[tt * 132 + 64 + lane];
                            const float nr = ab_re * s_re - ab_im * s_im + bur, ni = ab_re * s_im + ab_im * s_re + bui; s_re = nr; s_im = ni;
                            if (pass == 1) Ss[tt * 68 + lane] = cvt_pk_bf16(s_re, s_im);
                        }
                        asm volatile("s_waitcnt lgkmcnt(0)" ::: "memory");
                        if (pass == 1) {
                            f32x4 y = {0.f, 0.f, 0.f, 0.f};
#pragma unroll
                            for (int kb = 0; kb < 4; ++kb) { const pg8::bf16x8 Sop = *(const LAS pg8::bf16x8*)((const LAS unsigned char*)Ss + i16 * 272 + 64 * kb + 16 * g4);
                                y = __builtin_amdgcn_mfma_f32_16x16x32_bf16(Cop[kb], Sop, y, 0, 0, 0); }
                            const v2u uq = *(const v2u*)(PROJ + rowt * DINP + U_OFF + g * 16 + 4 * g4);
                            const f32x4 dsk = *(const f32x4*)(ka->in[13] + l * 1024 + g * 16 + 4 * g4);
                            const float uu[4] = {bflo(uq.x), bfhi(uq.x), bflo(uq.y), bfhi(uq.y)}; float zz[4];
#pragma unroll
                            for (int i = 0; i < 4; ++i) { const float yy = y[i] + dsk[i] * uu[i]; const float a = 0.7978845608028654f * (yy + 0.044715f * yy * yy * yy);
                                const float th = 1.0f - 2.0f / (1.0f + __expf(2.0f * a)); zz[i] = 0.5f * yy * (1.0f + th); }
                            v2u zo; zo.x = cvt_pk_bf16(zz[0], zz[1]); zo.y = cvt_pk_bf16(zz[2], zz[3]);
                            *(v2u*)(Z + rowt * 1024 + g * 16 + 4 * g4) = zo;
                            asm volatile("s_waitcnt lgkmcnt(0)" ::: "memory");
                        }
                    }
                    if (pass == 0) {
                        Ex[(wave * 64 + lane) * 2] = s_re; Ex[(wave * 64 + lane) * 2 + 1] = s_im;
                        float pr = ab_re, pi = ab_im;
#pragma unroll
                        for (int q = 0; q < 8; ++q) { const float t_ = pr * pr - pi * pi; pi = 2.0f * pr * pi; pr = t_; }
                        __syncthreads();
                        float cr_ = 0.f, ci_ = 0.f;
                        for (int w2 = 0; w2 < wave; ++w2) { const float er = Ex[(w2 * 64 + lane) * 2], ei = Ex[(w2 * 64 + lane) * 2 + 1];
                            const float nr = pr * cr_ - pi * ci_ + er, ni = pr * ci_ + pi * cr_ + ei; cr_ = nr; ci_ = ni; }
                        s_re = cr_; s_im = ci_;
                    }
                }
                __syncthreads();
            }
        }
        if (EN(5) && IN(pb + 5)) {
            PH_LOCALS
            const bf16* PROJ = P_PROJ; const bf16* QN = P_QN; const bf16* KN = P_KN; bf16* YATT = P_YATT;
            LAS float* Ol = (LAS float*)lds;
            LAS float* Dl = (LAS float*)(lds + 256 * 68 * 4);
            LAS unsigned char* Vs = lds + 256 * 68 * 4 + 1024 + wave * 5120;
            const int g4 = lane >> 4, i16 = lane & 15;
            float mq = fabsf(ka->in[15][l * 64 + lane]), mk = fabsf(ka->in[16][l * 64 + lane]);
#pragma unroll
            for (int o = 32; o >= 1; o >>= 1) { mq = fmaxf(mq, shx(mq, o, lane)); mk = fmaxf(mk, shx(mk, o, lane)); }
            const float Mref = 8.5f * mq * mk;
            for (int item = bid; item < 256; item += G) {
                const int b = item >> 6, hh = (item >> 3) & 7, t0 = (item & 7) * 256;
                for (int gi = 0; gi < 3; ++gi) {
                    const int sh = 2 * gi, head = gi * 8 + hh, nts = 16 >> sh, mmax = (T >> sh) - 1;
                    const float slope_d = exp2f(-8.0f * (float)(head + 1) / 24.0f) * (float)(1 << sh);
                    for (int ti = 0; ti < 2; ++ti) {
                        const int tau = wave * 2 + ti, c = tau / nts, mt = tau % nts, m0 = (t0 >> sh) + 16 * mt;
                        const size_t rowq = (size_t)b * T + (size_t)(((m0 + i16) << sh) + c);
                        const pg8::bf16x8 qf0 = *(const pg8::bf16x8*)(QN + rowq * AW + head * 64 + 8 * g4), qf1 = *(const pg8::bf16x8*)(QN + rowq * AW + head * 64 + 32 + 8 * g4);
                        f32x4 O0 = {0.f, 0.f, 0.f, 0.f}, O1 = O0, O2 = O0, O3 = O0; float den = 0.f;
                        for (int kp = 0; kp < 5; ++kp) {
#pragma unroll
                            for (int r = 0; r < 4; ++r) { const int ci = lane + 64 * r, key = ci >> 3, ch = ci & 7; int mk_ = m0 - 128 + 32 * kp + key; mk_ = mk_ < 0 ? 0 : (mk_ > mmax ? mmax : mk_);
                                const size_t rowk = (size_t)b * T + (size_t)((mk_ << sh) + c);
                                const v4u vv = *(const v4u*)(PROJ + rowk * DINP + V_OFF + head * 64 + ch * 8); *(LAS v4u*)(Vs + key * 160 + ch * 16) = vv; }
                            float pv[8];
#pragma unroll
                            for (int hf = 0; hf < 2; ++hf) {
                                const int kt = 2 * kp + hf; int mkl = m0 - 128 + 16 * kt + i16; mkl = mkl < 0 ? 0 : (mkl > mmax ? mmax : mkl);
                                const size_t rowk = (size_t)b * T + (size_t)((mkl << sh) + c);
                                const pg8::bf16x8 kf0 = *(const pg8::bf16x8*)(KN + rowk * AW + head * 64 + 8 * g4), kf1 = *(const pg8::bf16x8*)(KN + rowk * AW + head * 64 + 32 + 8 * g4);
                                f32x4 sc = {0.f, 0.f, 0.f, 0.f};
                                sc = __builtin_amdgcn_mfma_f32_16x16x32_bf16(kf0, qf0, sc, 0, 0, 0); sc = __builtin_amdgcn_mfma_f32_16x16x32_bf16(kf1, qf1, sc, 0, 0, 0);
#pragma unroll
                                for (int i = 0; i < 4; ++i) { const int n = 4 * g4 + i, diff = i16 - n + 128 - 16 * kt, mkn = m0 - 128 + 16 * kt + n;
                                    const bool valid = diff >= 0 && diff <= 128 && mkn >= 0;
                                    const float p = valid ? __expf(sc[i] * 0.125f - slope_d * (float)diff - Mref) : 0.f; den += p; pv[hf * 4 + i] = p; }
                            }
                            v4u bw; bw.x = cvt_pk_bf16(pv[0], pv[1]); bw.y = cvt_pk_bf16(pv[2], pv[3]); bw.z = cvt_pk_bf16(pv[4], pv[5]); bw.w = cvt_pk_bf16(pv[6], pv[7]);
                            const pg8::bf16x8 Bp = __builtin_bit_cast(pg8::bf16x8, bw);
                            asm volatile("s_waitcnt lgkmcnt(0)" ::: "memory");
                            const unsigned va = (unsigned)(size_t)(Vs + (4 * g4 + (i16 >> 2)) * 160 + 8 * (i16 & 3));
                            v2u l0, l1, l2, l3, h0, h1, h2, h3;
                            asm volatile("ds_read_b64_tr_b16 %0, %8\n\tds_read_b64_tr_b16 %1, %8 offset:32\n\tds_read_b64_tr_b16 %2, %8 offset:64\n\tds_read_b64_tr_b16 %3, %8 offset:96\n\t"
                                         "ds_read_b64_tr_b16 %4, %8 offset:2560\n\tds_read_b64_tr_b16 %5, %8 offset:2592\n\tds_read_b64_tr_b16 %6, %8 offset:2624\n\tds_read_b64_tr_b16 %7, %8 offset:2656\n\ts_waitcnt lgkmcnt(0)"
                                         : "=&v"(l0), "=&v"(l1), "=&v"(l2), "=&v"(l3), "=&v"(h0), "=&v"(h1), "=&v"(h2), "=&v"(h3) : "v"(va) : "memory");
                            { v4u a; a.x = l0.x; a.y = l0.y; a.z = h0.x; a.w = h0.y; O0 = __builtin_amdgcn_mfma_f32_16x16x32_bf16(__builtin_bit_cast(pg8::bf16x8, a), Bp, O0, 0, 0, 0); }
                            { v4u a; a.x = l1.x; a.y = l1.y; a.z = h1.x; a.w = h1.y; O1 = __builtin_amdgcn_mfma_f32_16x16x32_bf16(__builtin_bit_cast(pg8::bf16x8, a), Bp, O1, 0, 0, 0); }
                            { v4u a; a.x = l2.x; a.y = l2.y; a.z = h2.x; a.w = h2.y; O2 = __builtin_amdgcn_mfma_f32_16x16x32_bf16(__builtin_bit_cast(pg8::bf16x8, a), Bp, O2, 0, 0, 0); }
                            { v4u a; a.x = l3.x; a.y = l3.y; a.z = h3.x; a.w = h3.y; O3 = __builtin_amdgcn_mfma_f32_16x16x32_bf16(__builtin_bit_cast(pg8::bf16x8, a), Bp, O3, 0, 0, 0); }
                        }
                        den += shx(den, 16, lane); den += shx(den, 32, lane);
                        const int x = ((16 * mt + i16) << sh) + c;
                        LAS f32x4* op = (LAS f32x4*)(Ol + x * 68 + 4 * g4);
                        if (gi == 0) { op[0] = O0; op[4] = O1; op[8] = O2; op[12] = O3; if (g4 == 0) Dl[x] = den; }
                        else { op[0] = op[0] + O0; op[4] = op[4] + O1; op[8] = op[8] + O2; op[12] = op[12] + O3; if (g4 == 0) Dl[x] = Dl[x] + den; }
                    }
                    __syncthreads();
                }
                { const int x = tid >> 1, hf = tid & 1; const float rd = 1.0f / Dl[x]; const LAS f32x4* op = (const LAS f32x4*)(Ol + x * 68 + 32 * hf);
                  bf16* yo = YATT + ((size_t)b * T + t0 + x) * 512 + hh * 64 + 32 * hf;
#pragma unroll
                  for (int q = 0; q < 4; ++q) { const f32x4 a = op[2 * q] * rd, c2 = op[2 * q + 1] * rd;
                      v4u w; w.x = cvt_pk_bf16(a[0], a[1]); w.y = cvt_pk_bf16(a[2], a[3]); w.z = cvt_pk_bf16(c2[0], c2[1]); w.w = cvt_pk_bf16(c2[2], c2[3]); *(v4u*)(yo + 8 * q) = w; } }
                __syncthreads();
            }
        }
        SEAM(pb + 5);
        if (EN(6) && IN(pb + 6)) {
            { PH_LOCALS
              pg8::Gemm g{P_LORA, (const bf16*)(ws + W_W2), M, RW, 256, 768, 256}; pg8::StaticOrder S; S.init(M, RW, G, bid);
              EpiF<FDecay> E{FDecay{ka->in[18] + l * RW, P_DECAY}}; pg8::gemm_phase<EpiF<FDecay>, pg8::StaticOrder, true, true>(lds + RING_OFF, g, S, E, tid); }
            { PH_LOCALS
              pg8::Gemm g{P_LORA + 256, (const bf16*)(ws + W_A2), M, RW, 256, 768, 256}; pg8::StaticOrder S; S.init(M, RW, G, (bid + G / 2) % G);
              EpiF<FASig> E{FASig{ka->in[20] + l * RW, P_ASIG}}; pg8::gemm_phase<EpiF<FASig>, pg8::StaticOrder, true, true>(lds + RING_OFF, g, S, E, tid); }
            { PH_LOCALS
              pg8::Gemm g{P_LORA + 512, (const bf16*)(ws + W_G2), M, RW, 256, 768, 256}; pg8::StaticOrder S; S.init(M, RW, G, bid);
              EpiF<FStoreF32> E{FStoreF32{P_GG, RW}}; pg8::gemm_phase<EpiF<FStoreF32>, pg8::StaticOrder, true, true>(lds + RING_OFF, g, S, E, tid); }
            if (l > 0) { PH_LOCALS
              pg8::Gemm g{P_AV, (const bf16*)(ws + W_V1), M, 256, RW, RW, RW}; pg8::StaticOrder S; S.init(M, 256, G, (bid + G / 2) % G);
              EpiF<FStoreBf16> E{FStoreBf16{P_V1O, 256}}; pg8::gemm_phase<EpiF<FStoreBf16>, pg8::StaticOrder, true, true>(lds + RING_OFF, g, S, E, tid); }
        }
        SEAM(pb + 6);
        if (EN(7) && IN(pb + 7)) {
            if (l > 0) { PH_LOCALS
              pg8::Gemm g{P_V1O, (const bf16*)(ws + W_V2), M, RW, 256, 256, 256}; pg8::StaticOrder S; S.init(M, RW, G, bid);
              EpiF<FVres> E{FVres{ka->in[28] + (size_t)(l - 1) * RW, P_VP, P_VFIRST}}; pg8::gemm_phase<EpiF<FVres>, pg8::StaticOrder, true, true>(lds + RING_OFF, g, S, E, tid); }
            { PH_LOCALS
              pg8::Gemm g{P_Z, (const bf16*)(ws + W_GLU), M, 1024, 1024, 1024, 1024}; pg8::StaticOrder S; S.init(M, 1024, G, (bid + G / 2) % G);
              EpiF<FGlu> E{FGlu{P_Z, P_YS5}}; pg8::gemm_phase<EpiF<FGlu>, pg8::StaticOrder, true, true>(lds + RING_OFF, g, S, E, tid); }
        }
        SEAM(pb + 7);
        if (EN(9) && IN(pb + 9)) {
            PH_LOCALS
            constexpr int TC = 32, NC = T / TC, BUFB = 5 * TC * 64 * 4 + TC * 16 * 4;
            const float* DECAY = P_DECAY; const float* ASIG = P_ASIG; const float* KP = P_KP; const float* RP = P_RP; const float* VP = P_VP; float* YRAW = P_YRAW;
            for (int item = bid; item < 256; item += G) {
                const int bh = item >> 2, i0 = (item & 3) * 16, b = bh >> 4, h = bh & 15;
                const size_t rowbase = (size_t)b * T * RW + h * 64;
                if (wave >= 4) {
                    const int lw = wave - 4, j = lane;
                    const float kkc = ka->in[23][l * RW + h * 64 + j], kac = ka->in[24][l * RW + h * 64 + j];
                    float dw[8], da[8], dk[8], dr[8], dv[2];
#define RW_ISSUE(c) do { _Pragma("unroll") for (int s = 0; s < 8; ++s) { const size_t p = rowbase + (size_t)((c) * TC + lw * 8 + s) * RW + j; dw[s] = DECAY[p]; da[s] = ASIG[p]; dk[s] = KP[p]; dr[s] = RP[p]; } \
                        _Pragma("unroll") for (int s = 0; s < 2; ++s) dv[s] = VP[rowbase + (size_t)((c) * TC + lw * 8 + s * 4 + (lane >> 4)) * RW + i0 + (lane & 15)]; } while (0)
#define RW_FILL(c) do { LAS float* bb = (LAS float*)(lds + ((c) & 1) * BUFB); \
                        _Pragma("unroll") for (int s = 0; s < 8; ++s) { const int tt = lw * 8 + s; float kk = dk[s] * kkc; const float n2 = wave_sum(kk * kk, lane); kk *= rsqrtf(fmaxf(n2, 1e-24f)); \
                            bb[0 * TC * 64 + tt * 64 + j] = dw[s]; bb[1 * TC * 64 + tt * 64 + j] = kk; bb[2 * TC * 64 + tt * 64 + j] = kk * da[s]; \
                            bb[3 * TC * 64 + tt * 64 + j] = dk[s] * (1.0f + (da[s] - 1.0f) * kac); bb[4 * TC * 64 + tt * 64 + j] = dr[s]; } \
                        _Pragma("unroll") for (int s = 0; s < 2; ++s) bb[5 * TC * 64 + (lw * 8 + s * 4 + (lane >> 4)) * 16 + (lane & 15)] = dv[s]; } while (0)
                    RW_ISSUE(0); RW_FILL(0); RW_ISSUE(1);
                    LDS_WAIT(); __builtin_amdgcn_s_barrier();
                    for (int c = 0; c < NC; ++c) {
                        if (c + 1 < NC) { RW_FILL(c + 1); if (c + 2 < NC) RW_ISSUE(c + 2); }
                        LDS_WAIT(); __builtin_amdgcn_s_barrier();
                    }
#undef RW_ISSUE
#undef RW_FILL
                } else {
                    const int row = lane >> 4, jq = lane & 15, irow = wave * 4 + row;
                    float S0 = 0.f, S1 = 0.f, S2 = 0.f, S3 = 0.f;
                    float* yp = YRAW + rowbase + i0 + irow;
                    __builtin_amdgcn_s_barrier();
                    for (int c = 0; c < NC; ++c) {
                        const LAS float* bb = (const LAS float*)(lds + (c & 1) * BUFB);
#pragma unroll 8
                        for (int tt = 0; tt < TC; ++tt) {
                            const f32x4 w4 = *(const LAS f32x4*)(bb + 0 * TC * 64 + tt * 64 + 4 * jq), k4 = *(const LAS f32x4*)(bb + 1 * TC * 64 + tt * 64 + 4 * jq),
                                        b4 = *(const LAS f32x4*)(bb + 2 * TC * 64 + tt * 64 + 4 * jq), f4 = *(const LAS f32x4*)(bb + 3 * TC * 64 + tt * 64 + 4 * jq),
                                        r4 = *(const LAS f32x4*)(bb + 4 * TC * 64 + tt * 64 + 4 * jq);
                            const float vi = bb[5 * TC * 64 + tt * 16 + irow];
                            const float sa = -row16_sum((S0 * k4.x + S1 * k4.y) + (S2 * k4.z + S3 * k4.w));
                            S0 = S0 * w4.x + (sa * b4.x + vi * f4.x); S1 = S1 * w4.y + (sa * b4.y + vi * f4.y);
                            S2 = S2 * w4.z + (sa * b4.z + vi * f4.z); S3 = S3 * w4.w + (sa * b4.w + vi * f4.w);
                            const float y = row16_sum((S0 * r4.x + S1 * r4.y) + (S2 * r4.z + S3 * r4.w));
                            if (jq == 0) yp[(size_t)(c * TC + tt) * RW] = y;
                        }
                        __builtin_amdgcn_s_barrier();
                    }
                }
                __syncthreads();
            }
        }
        SEAM(pb + 9);
        if (EN(10) && IN(pb + 10)) {
            PH_LOCALS
            const float* lnw = ka->in[26] + l * RW; const float* lnb = ka->in[27] + l * RW; const float* r_k = ka->in[25] + l * RW;
            const float* k_a = ka->in[24] + l * RW; const float* ASIG = P_ASIG;
            const float* YRAW = P_YRAW; const float* RP = P_RP; const float* KP = P_KP; const float* VP = P_VP; const float* GG = P_GG; bf16* YRWKV = P_YRWKV;
            for (int it = gw; it < M * 16; it += NGW) {
                const size_t p = (size_t)it * 64 + lane; const int c = (it & 15) * 64 + lane;
                const float y = YRAW[p]; const float mean = wave_sum(y, lane) * (1.0f / 64); const float d = y - mean; const float var = wave_sum(d * d, lane) * (1.0f / 64);
                float yn = d * rsqrtf(var + 64e-5f) * lnw[c] + lnb[c];
                const float kfin = KP[p] * (1.0f + (ASIG[p] - 1.0f) * k_a[c]);
                const float rk = wave_sum(RP[p] * kfin * r_k[c], lane);
                yn += rk * VP[p];
                YRWKV[p] = (bf16)f2bf(yn * GG[p]);
            }
        }
        SEAM(pb + 10);
        if (EN(11) && IN(pb + 11)) {
            { PH_LOCALS
              pg8::Gemm g{P_YS5, (const bf16*)(ws + W_BS5), M, D, 1024, 1024, 1024}; pg8::StaticOrder S; S.init(M, D, G, bid);
              EpiF<FBranch<0>> E{FBranch<0>{P_PROJ, GATE_OFF, P_MERGED, P_MERGEDB}}; pg8::gemm_phase<EpiF<FBranch<0>>, pg8::StaticOrder, true, true>(lds + RING_OFF, g, S, E, tid); }
            VM_WAIT(); __syncthreads();
            { PH_LOCALS
              pg8::Gemm g{P_YATT, (const bf16*)(ws + W_BAT), M, D, 512, 512, 512}; pg8::StaticOrder S; S.init(M, D, G, bid);
              EpiF<FBranch<1>> E{FBranch<1>{P_PROJ, GATE_OFF + D, P_MERGED, P_MERGEDB}}; pg8::gemm_phase<EpiF<FBranch<1>>, pg8::StaticOrder, true, true>(lds + RING_OFF, g, S, E, tid); }
            VM_WAIT(); __syncthreads();
            { PH_LOCALS
              pg8::Gemm g{P_YRWKV, (const bf16*)(ws + W_BRW), M, D, 1024, 1024, 1024}; pg8::StaticOrder S; S.init(M, D, G, bid);
              EpiF<FBranch<2>> E{FBranch<2>{P_PROJ, GATE_OFF + 2 * D, P_MERGED, P_MERGEDB}}; pg8::gemm_phase<EpiF<FBranch<2>>, pg8::StaticOrder, true, true>(lds + RING_OFF, g, S, E, tid); }
        }
        SEAM(pb + 11);
        if (EN(12) && IN(pb + 12)) {
            PH_LOCALS
            pg8::Gemm g{P_MERGEDB, (const bf16*)(ws + W_OUT), M, D, D, D, D}; pg8::StaticOrder S; S.init(M, D, G, bid);
            EpiResid E{P_X, P_X, P_XB, P_SS + (size_t)(3 * l + 2) * M * 32, 1.0f};
            pg8::gemm_phase<EpiResid, pg8::StaticOrder, true, true>(lds + RING_OFF, g, S, E, tid);
        }
        SEAM(pb + 12);
        if (EN(13) && IN(pb + 13)) {
            PH_LOCALS
            pg8::Gemm g{P_XB, (const bf16*)(ws + W_UP2), M, NUP, D, D, D}; pg8::StaticOrder S; S.init(M, NUP, G, bid);
            EpiSwiGLU E{P_HID, P_SS + (size_t)(3 * l + 2) * M * 32};
            pg8::gemm_phase<EpiSwiGLU, pg8::StaticOrder, true, true>(lds + RING_OFF, g, S, E, tid);
        }
        SEAM(pb + 13);
        if (EN(14) && IN(pb + 14)) {
            PH_LOCALS
            pg8::Gemm g{P_HID, (const bf16*)(ws + W_DN2), M, D, DFF, DFF, DFF}; pg8::StaticOrder S; S.init(M, D, G, bid);
            EpiResid E{P_X, l == DEPTH - 1 ? ka->out : P_X, P_XB, P_SS + (size_t)(3 * l + 3) * M * 32, 0.5f};
            pg8::gemm_phase<EpiResid, pg8::StaticOrder, true, true>(lds + RING_OFF, g, S, E, tid);
        }
        SEAM(pb + 14);
    }
#undef IN
#undef SEAM
}

extern "C" void kernel_launch(void* const* d_in, const int* in_sizes, int n_in, void* d_out, int out_size, void* d_ws, size_t ws_size, hipStream_t stream) {
    static int grid = 0;
    if (grid == 0) {
        if (n_in != 38 || in_sizes[0] != M * D || out_size != M * D || ws_size < WS_END) {
            fprintf(stderr, "kernel_launch: unexpected shapes/workspace (n_in %d, in0 %d, out %d, ws %zu, need %zu); nothing launched\n", n_in, n_in > 0 ? in_sizes[0] : -1, out_size, ws_size, (size_t)WS_END); grid = -1; return; }
        int dev = 0, cus = 0, per_cu = 0;
        if (hipGetDevice(&dev) != hipSuccess || hipDeviceGetAttribute(&cus, hipDeviceAttributeMultiprocessorCount, dev) != hipSuccess) { grid = -1; return; }
        if (hipFuncSetAttribute((const void*)mk_fwd, hipFuncAttributeMaxDynamicSharedMemorySize, LDS_BYTES) != hipSuccess) { fprintf(stderr, "kernel_launch: hipFuncSetAttribute failed\n"); grid = -1; return; }
        if (hipOccupancyMaxActiveBlocksPerMultiprocessor(&per_cu, (const void*)mk_fwd, NWAVES * 64, LDS_BYTES) != hipSuccess || per_cu < 1)
            fprintf(stderr, "kernel_launch: note: occupancy query reports %d workgroups per CU\n", per_cu);
        (void)hipGetLastError();
        grid = cus;
    }
    if (grid < 0) return;
    if (hipMemsetAsync((char*)d_ws + WS_CTL, 0, CTL_ZERO_BYTES, stream) != hipSuccess) { fprintf(stderr, "kernel_launch: memset failed\n"); return; }
#ifdef DBG_ZERO_WS
    (void)hipMemsetAsync((char*)d_ws + CTL_ZERO_BYTES, 0, WS_END - CTL_ZERO_BYTES, stream);
#endif
    Args a{};
    for (int i = 0; i < 38; ++i) a.in[i] = (const float*)d_in[i];
    a.out = (float*)d_out; a.ws = (unsigned char*)d_ws; a.pad = 0;
#if MK_ONE_LAUNCH
    a.ph_lo = 0; a.ph_hi = NPHASES; a.use_bar = 1;
    hipLaunchKernelGGL(mk_fwd, dim3(grid), dim3(NWAVES * 64), LDS_BYTES, stream, a);
#else
    for (int ph = 0; ph < NPHASES; ++ph) {
        a.ph_lo = ph; a.ph_hi = ph + 1; a.use_bar = 0;
        hipLaunchKernelGGL(mk_fwd, dim3(grid), dim3(NWAVES * 64), LDS_BYTES, stream, a);
    }
#endif
    const hipError_t le = hipPeekAtLastError();
    if (le != hipSuccess) fprintf(stderr, "kernel_launch: launch failed: %s\n", hipGetErrorName(le));
}
```

```cpp
#include <hip/hip_runtime.h>
#include <cstdio>
#include <cstdint>

#ifndef PROBE_A
#define PROBE_A -1
#endif
#ifndef PROBE_B
#define PROBE_B -1
#endif
#define PROBE_ON (PROBE_A >= 0 || PROBE_B >= 0)
#ifndef MK_ONE_LAUNCH
#define MK_ONE_LAUNCH 1
#endif

namespace pg8 {
#define PG8_LAS __attribute__((address_space(3)))
typedef unsigned short bf16_t;
typedef short bf16x8 __attribute__((ext_vector_type(8)));
typedef float f32x4 __attribute__((ext_vector_type(4)));
typedef unsigned u32x4 __attribute__((ext_vector_type(4)));
constexpr int BM = 256, BK = 64, HALF = 128, HTB = HALF * BK * 2, STAGE_BYTES = 8 * HTB, NXCD = 8, WGM = 8;

__host__ __device__ __forceinline__ int lds_byte(int r, int c) { const int st = (r >> 4) * 2 + (c >> 5), rr = r & 15, cc = c & 31, ob = rr * 64 + cc * 2; return st * 1024 + (ob ^ (((ob >> 9) & 1) << 5)); }
__host__ __device__ __forceinline__ void stage_rc(int b, int& R, int& C) { const int st = b / 1024, sb = b % 1024, swz = sb ^ (((sb >> 9) & 1) << 5); R = (st >> 1) * 16 + swz / 64; C = (st & 1) * 32 + (swz % 64) / 2; }
__host__ __device__ __forceinline__ int perm32(int rho) { const int n = rho >> 4, i = rho & 15; return 8 * (i >> 2) + 4 * n + (i & 3); }

struct Unit { int pm, pn, seg; };
struct Gemm { const bf16_t* A; const bf16_t* Bt; int M, N, K, lda, ldb; };

struct StaticOrder {
    int nM, nN, nwg, G, c;
    __host__ __device__ void init(int M, int N, int G_, int c_) { nM = M / BM; nN = N / BM; nwg = nM * nN; G = G_; c = c_; }
    __host__ __device__ bool next(int i, Unit& u) const {
        const long L = (long)i * G + c; if (L >= nwg) return false;
        int wgid = (int)L; { const int q = nwg / NXCD, r = nwg % NXCD, xcd = wgid % NXCD, off = wgid / NXCD; wgid = (xcd < r ? xcd * (q + 1) : r * (q + 1) + (xcd - r) * q) + off; }
        const int nig = WGM * nN, gid = wgid / nig, fm = gid * WGM, gsz = (nM - fm) < WGM ? (nM - fm) : WGM;
        u.pm = fm + ((wgid % nig) % gsz); u.pn = (wgid % nig) / gsz; u.seg = 0; return true;
    }
    __device__ __forceinline__ void a_ready(const Unit&) const {}
    __device__ __forceinline__ void done(const Unit&) const {}
    __device__ __forceinline__ const char* a_base(const Gemm& g, const Unit& u, size_t tstepA) const { return (const char*)g.A + (size_t)u.pm * tstepA; }
    __device__ __forceinline__ const char* b_base(const Gemm& g, const Unit& u, size_t tstepB) const { return (const char*)g.Bt + (size_t)u.pn * tstepB; }
    __device__ __forceinline__ int ktiles(const Gemm& g, const Unit&) const { return g.K / BK; }
};
struct Seg3Order : StaticOrder {
    const bf16_t *A0, *B0; long dA1, dA2, dB1, dB2; int K0, K1, K2;
    __host__ __device__ bool next(int i, Unit& u) const { const bool ok = StaticOrder::next(i / 3, u); u.seg = i % 3; return ok; }
    __device__ __forceinline__ const char* a_base(const Gemm&, const Unit& u, size_t tstepA) const { long d1 = dA1, d2 = dA2; asm volatile("" : "+s"(d1), "+s"(d2)); const long d = u.seg == 1 ? d1 : (u.seg == 2 ? d2 : 0); return (const char*)A0 + d + (size_t)u.pm * tstepA; }
    __device__ __forceinline__ const char* b_base(const Gemm&, const Unit& u, size_t tstepB) const { long d1 = dB1, d2 = dB2; asm volatile("" : "+s"(d1), "+s"(d2)); const long d = u.seg == 1 ? d1 : (u.seg == 2 ? d2 : 0); return (const char*)B0 + d + (size_t)u.pn * tstepB; }
    __device__ __forceinline__ int ktiles(const Gemm&, const Unit& u) const { int k0 = K0, k1 = K1, k2 = K2; asm volatile("" : "+s"(k0), "+s"(k1), "+s"(k2)); return (u.seg == 1 ? k1 : (u.seg == 2 ? k2 : k0)) / BK; }
};

__device__ __forceinline__ unsigned cvt_pk_bf16(float lo, float hi) { unsigned r; asm volatile("v_cvt_pk_bf16_f32 %0, %1, %2" : "=v"(r) : "v"(lo), "v"(hi)); return r; }

template <class Epi, class Sched, bool ALIGN_EPI = false, bool SP2 = false>
__device__ __forceinline__ void gemm_phase(PG8_LAS unsigned char* lds, const Gemm g, const Sched& S, const Epi& E, int tid_) {
    asm volatile("" : "+v"(tid_));
    const int tid = tid_, wid = __builtin_amdgcn_readfirstlane(tid >> 6), lane = tid & 63, wr = wid >> 2, wc = wid & 3, fr = lane & 15, fq = lane >> 4;
    unsigned voffA[2], voffB[2];
#pragma unroll
    for (int i = 0; i < 2; ++i) { int R, C; stage_rc(tid * 16 + i * 8192, R, C); const int Rb = Epi::PERM ? ((R & ~31) + perm32(R & 31)) : R;
        voffA[i] = (unsigned)(R * g.lda + C) * 2u; voffB[i] = (unsigned)(Rb * g.ldb + C) * 2u; }
    const size_t kstep = (size_t)(BK * 2);
    const size_t hstepA = (size_t)HALF * g.lda * 2, hstepB = (size_t)HALF * g.ldb * 2;
    const size_t tstepA = 2 * hstepA, tstepB = 2 * hstepB;
    const unsigned ldsw = (unsigned)wid * 1024u;
    const int aoff = lds_byte(wr * 64 + fr, fq * 8), boff = lds_byte(wc * 32 + fr, fq * 8);
#define PG8_SA(b, h) (((b) * 2 + (h)) * HTB)
#define PG8_SB(b, h) ((4 + (b) * 2 + (h)) * HTB)
#define PG8_STAGE(bufoff, gbase, voff) do { _Pragma("unroll") for (int _i = 0; _i < 2; ++_i) \
        __builtin_amdgcn_global_load_lds((const unsigned*)((const char*)(gbase) + (voff)[_i]), (PG8_LAS unsigned*)(lds + (bufoff) + ldsw + _i * 8192), 16, 0, 0); } while (0)
#define PG8_LDA(dst, b, h) do { _Pragma("unroll") for (int m = 0; m < 4; ++m) _Pragma("unroll") for (int k = 0; k < 2; ++k) dst[m][k] = *(const PG8_LAS bf16x8*)(lds + PG8_SA(b, h) + aoff + m * 2048 + k * 1024); } while (0)
#define PG8_LDB(dst, b, h) do { _Pragma("unroll") for (int n = 0; n < 2; ++n) _Pragma("unroll") for (int k = 0; k < 2; ++k) dst[n][k] = *(const PG8_LAS bf16x8*)(lds + PG8_SB(b, h) + boff + n * 2048 + k * 1024); } while (0)
#define PG8_MMA(ai, bj, At, Bt) do { __builtin_amdgcn_s_setprio(1); _Pragma("unroll") for (int m = 0; m < 4; ++m) _Pragma("unroll") for (int n = 0; n < 2; ++n) _Pragma("unroll") for (int k = 0; k < 2; ++k) \
        acc[ai][bj][m][n] = __builtin_amdgcn_mfma_f32_16x16x32_bf16(Bt[n][k], At[m][k], acc[ai][bj][m][n], 0, 0, 0); __builtin_amdgcn_s_setprio(0); } while (0)
#define PG8_WAIT_V(n) asm volatile("s_waitcnt vmcnt(" #n ")" ::: "memory")
#define PG8_WAIT_L(n) asm volatile("s_waitcnt lgkmcnt(" #n ")" ::: "memory")
#define PG8_BAR __builtin_amdgcn_s_barrier()
#define PG8_SCHED __builtin_amdgcn_sched_barrier(0)
    Unit cur, nxt; int ui = 0;
    if (!S.next(0, cur)) return;
    f32x4 acc[2][2][4][2];
#pragma unroll
    for (int a = 0; a < 2; ++a)
#pragma unroll
        for (int b = 0; b < 2; ++b)
#pragma unroll
            for (int m = 0; m < 4; ++m)
#pragma unroll
                for (int n = 0; n < 2; ++n) acc[a][b][m][n] = (f32x4){0.f, 0.f, 0.f, 0.f};
    bf16x8 At[4][2], B0[2][2], B1[2][2];
    const char* cA = S.a_base(g, cur, tstepA); const char* cB = S.b_base(g, cur, tstepB);
    S.a_ready(cur);
    if constexpr (SP2) {
        PG8_STAGE(PG8_SB(0, 0), cB, voffB); PG8_STAGE(PG8_SB(0, 1), cB + hstepB, voffB); PG8_STAGE(PG8_SA(0, 0), cA, voffA); PG8_STAGE(PG8_SA(0, 1), cA + hstepA, voffA);
        if (wr == 1) PG8_BAR;
        PG8_WAIT_V(2); PG8_BAR;
        PG8_STAGE(PG8_SB(1, 0), cB + kstep, voffB); PG8_STAGE(PG8_SA(1, 0), cA + kstep, voffA); PG8_STAGE(PG8_SB(1, 1), cB + hstepB + kstep, voffB);
        PG8_WAIT_V(6); PG8_BAR;
    } else {
        PG8_STAGE(PG8_SB(0, 0), cB, voffB); PG8_STAGE(PG8_SA(0, 0), cA, voffA); PG8_STAGE(PG8_SB(0, 1), cB + hstepB, voffB); PG8_STAGE(PG8_SA(0, 1), cA + hstepA, voffA);
        if (wr == 1) PG8_BAR;
        PG8_WAIT_V(4); PG8_BAR;
        PG8_STAGE(PG8_SB(1, 0), cB + kstep, voffB); PG8_STAGE(PG8_SA(1, 0), cA + kstep, voffA); PG8_STAGE(PG8_SB(1, 1), cB + hstepB + kstep, voffB);
        PG8_WAIT_V(6); PG8_BAR;
    }
    for (;;) {
        const bool has_next = S.next(ui + 1, nxt);
        const char* nA = has_next ? S.a_base(g, nxt, tstepA) : cA; const char* nB = has_next ? S.b_base(g, nxt, tstepB) : cB;
        const int nt = S.ktiles(g, cur);
        for (int t = 0; t < nt; t += 2) {
            const bool last = (t == nt - 2);
            const char* a1 = cA + (size_t)(t + 1) * kstep;
            const char* a2 = last ? nA : cA + (size_t)(t + 2) * kstep; const char* b2 = last ? nB : cB + (size_t)(t + 2) * kstep;
            const char* a3 = a2 + kstep; const char* b3 = b2 + kstep;
            if (last && has_next) S.a_ready(nxt);
            if constexpr (SP2) {
            PG8_LDB(B0, 0, 0); PG8_LDB(B1, 0, 1); PG8_SCHED; PG8_LDA(At, 0, 0); PG8_STAGE(PG8_SA(1, 1), a1 + hstepA, voffA);
            PG8_WAIT_V(8); PG8_WAIT_L(0); PG8_BAR; PG8_MMA(0, 0, At, B0); PG8_MMA(0, 1, At, B1); PG8_BAR; PG8_SCHED;
            PG8_LDA(At, 0, 1); PG8_STAGE(PG8_SB(0, 0), b2, voffB); PG8_STAGE(PG8_SB(0, 1), b2 + hstepB, voffB); PG8_STAGE(PG8_SA(0, 0), a2, voffA);
            PG8_WAIT_V(8); PG8_WAIT_L(0); PG8_BAR; PG8_MMA(1, 0, At, B0); PG8_MMA(1, 1, At, B1); PG8_BAR; PG8_SCHED;
            PG8_LDB(B0, 1, 0); PG8_LDB(B1, 1, 1); PG8_SCHED; PG8_LDA(At, 1, 0); PG8_STAGE(PG8_SA(0, 1), a2 + hstepA, voffA);
            PG8_WAIT_V(8); PG8_WAIT_L(0); PG8_BAR; PG8_MMA(0, 0, At, B0); PG8_MMA(0, 1, At, B1); PG8_BAR; PG8_SCHED;
            PG8_LDA(At, 1, 1); PG8_STAGE(PG8_SB(1, 0), b3, voffB); PG8_STAGE(PG8_SB(1, 1), b3 + hstepB, voffB); PG8_STAGE(PG8_SA(1, 0), a3, voffA);
            PG8_WAIT_V(8); PG8_WAIT_L(0); PG8_BAR; PG8_MMA(1, 0, At, B0); PG8_MMA(1, 1, At, B1); PG8_BAR; PG8_SCHED;
            } else {
            PG8_LDB(B0, 0, 0); PG8_SCHED; PG8_LDA(At, 0, 0); PG8_STAGE(PG8_SA(1, 1), a1 + hstepA, voffA);
            PG8_WAIT_L(8); PG8_BAR; PG8_WAIT_L(0); PG8_MMA(0, 0, At, B0); PG8_BAR; PG8_SCHED;
            PG8_LDB(B1, 0, 1); PG8_STAGE(PG8_SB(0, 0), b2, voffB);
            PG8_BAR; PG8_WAIT_L(0); PG8_MMA(0, 1, At, B1); PG8_BAR;
            PG8_LDA(At, 0, 1); PG8_STAGE(PG8_SA(0, 0), a2, voffA);
            PG8_BAR; PG8_WAIT_L(0); PG8_MMA(1, 0, At, B0); PG8_BAR; PG8_SCHED;
            PG8_STAGE(PG8_SB(0, 1), b2 + hstepB, voffB);
            PG8_WAIT_V(6); PG8_BAR; PG8_MMA(1, 1, At, B1); PG8_BAR;
            PG8_LDB(B0, 1, 0); PG8_SCHED; PG8_LDA(At, 1, 0); PG8_STAGE(PG8_SA(0, 1), a2 + hstepA, voffA);
            PG8_WAIT_L(8); PG8_BAR; PG8_WAIT_L(0); PG8_MMA(0, 0, At, B0); PG8_BAR; PG8_SCHED;
            PG8_LDB(B1, 1, 1); PG8_STAGE(PG8_SB(1, 0), b3, voffB);
            PG8_BAR; PG8_WAIT_L(0); PG8_MMA(0, 1, At, B1); PG8_BAR;
            PG8_LDA(At, 1, 1); PG8_STAGE(PG8_SA(1, 0), a3, voffA);
            PG8_BAR; PG8_WAIT_L(0); PG8_MMA(1, 0, At, B0); PG8_BAR; PG8_SCHED;
            PG8_STAGE(PG8_SB(1, 1), b3 + hstepB, voffB);
            PG8_WAIT_V(6); PG8_BAR; PG8_MMA(1, 1, At, B1); PG8_BAR;
            }
        }
        if constexpr (ALIGN_EPI) { if (wr == 0) PG8_BAR; }
        E(acc, cur, wr, wc, fr, fq); S.done(cur);
        if (!has_next) break;
        if (!(Epi::KEEP && E.keep(cur))) {
#pragma unroll
        for (int a = 0; a < 2; ++a)
#pragma unroll
            for (int b = 0; b < 2; ++b)
#pragma unroll
                for (int m = 0; m < 4; ++m)
#pragma unroll
                    for (int n = 0; n < 2; ++n) acc[a][b][m][n] = (f32x4){0.f, 0.f, 0.f, 0.f};
        }
        cur = nxt; cA = nA; cB = nB; ++ui;
        if constexpr (ALIGN_EPI) { if (wr == 1) PG8_BAR; }
    }
    PG8_WAIT_V(0);
    if constexpr (!ALIGN_EPI) { if (wr == 0) PG8_BAR; }
    PG8_BAR;
#undef PG8_SA
#undef PG8_SB
#undef PG8_STAGE
#undef PG8_LDA
#undef PG8_LDB
#undef PG8_MMA
#undef PG8_WAIT_V
#undef PG8_WAIT_L
#undef PG8_BAR
#undef PG8_SCHED
}
}

constexpr int NWAVES = 8;
constexpr int M = 8192, T = 2048, D = 2048, DFF = 5504, NUP = 2 * DFF, DIN = 15296, DINP = 15360, DEPTH = 4;
constexpr int U_OFF = 0, Q_OFF = 1024, K_OFF = 2560, V_OFF = 4096, RW_OFF = 5632, GATE_OFF = 9152;
constexpr int RWP = 3520, RW = 1024, AW = 1536;
constexpr float RMS_EPS = 1e-6f;
constexpr int NPH = 15;
constexpr int NPHASES = 1 + DEPTH * NPH;

constexpr size_t MiB = 1u << 20;
constexpr size_t WS_CTL = 0, CTL_ZERO_BYTES = 1 * MiB;
constexpr int CW_BAR = 4096;
constexpr size_t SS_OFF = 256 * 1024;
constexpr size_t WS_X = 1 * MiB;
constexpr size_t WS_XB = WS_X + 64 * MiB;
constexpr size_t WS_HID = WS_XB + 32 * MiB;
constexpr size_t WS_PROJ = WS_HID + 86 * MiB;
constexpr size_t WS_W = WS_PROJ + 240 * MiB;
constexpr size_t W_UP1 = WS_W, W_DN1 = W_UP1 + 43 * MiB, W_IN = W_DN1 + 22 * MiB, W_GLU = W_IN + 60 * MiB, W_W2 = W_GLU + 2 * MiB, W_A2 = W_W2 + MiB / 2,
                 W_G2 = W_A2 + MiB / 2, W_V1 = W_G2 + MiB / 2, W_V2 = W_V1 + MiB / 2, W_BS5 = W_V2 + MiB / 2, W_BAT = W_BS5 + 4 * MiB, W_BRW = W_BAT + 2 * MiB,
                 W_OUT = W_BRW + 4 * MiB, W_UP2 = W_OUT + 8 * MiB, W_DN2 = W_UP2 + 43 * MiB, W_BAT2 = W_DN2 + 22 * MiB, WS_WEND = W_BAT2 + 4 * MiB;
constexpr size_t WS_RP = WS_WEND, WS_KP = WS_RP + 32 * MiB, WS_VP = WS_KP + 32 * MiB, WS_DECAY = WS_VP + 32 * MiB, WS_ASIG = WS_DECAY + 32 * MiB, WS_G = WS_ASIG + 32 * MiB,
                 WS_KK = WS_G + 32 * MiB, WS_VFIRST = WS_KK + 32 * MiB, WS_YRAW = WS_VFIRST + 32 * MiB;
constexpr size_t WS_LORA = WS_YRAW + 32 * MiB;
constexpr size_t WS_AV = WS_LORA + 12 * MiB;
constexpr size_t WS_V1O = WS_AV + 16 * MiB;
constexpr size_t WS_QN = WS_V1O + 4 * MiB, WS_KN = WS_QN + 24 * MiB;
constexpr size_t WS_Z = WS_KN + 24 * MiB, WS_YS5 = WS_Z + 16 * MiB, WS_YATT = WS_YS5 + 16 * MiB, WS_YRWKV = WS_YATT + 8 * MiB;
constexpr size_t WS_MERGED = WS_YRWKV + 16 * MiB, WS_MERGEDB = WS_MERGED + 64 * MiB;
constexpr size_t WS_SBUF = WS_MERGEDB + 32 * MiB;
constexpr size_t WS_SSP = WS_SBUF + 256 * MiB;
constexpr size_t WS_END = WS_SSP + 16 * MiB;

constexpr int RING_OFF = 0, RING_BYTES = 131072, LDSCTL_OFF = 143360, LDS_BYTES = 147456;

#define GAS __attribute__((address_space(1)))
#define LAS __attribute__((address_space(3)))
typedef unsigned short bf16;
typedef unsigned v4u __attribute__((ext_vector_type(4)));
typedef unsigned v2u __attribute__((ext_vector_type(2)));
typedef float f32x4 __attribute__((ext_vector_type(4)));
typedef float f32x2 __attribute__((ext_vector_type(2)));
typedef short v4s_ __attribute__((ext_vector_type(4)));
#define LDS_WAIT() asm volatile("s_waitcnt lgkmcnt(0)" ::: "memory")
#define VM_WAIT() asm volatile("s_waitcnt vmcnt(0)" ::: "memory")
__device__ __forceinline__ unsigned f2bf(float f) { unsigned u = __builtin_bit_cast(unsigned, f); return (u + 0x7fffu + ((u >> 16) & 1u)) >> 16; }
__device__ __forceinline__ unsigned pk2(float lo, float hi) { return f2bf(lo) | (f2bf(hi) << 16); }
typedef __bf16 bf16n2 __attribute__((ext_vector_type(2)));
__device__ __forceinline__ unsigned cvt_nat(float lo, float hi) { const f32x2 v = {lo, hi}; return __builtin_bit_cast(unsigned, __builtin_convertvector(v, bf16n2)); }
__device__ __forceinline__ float bf2f(unsigned short b) { return __builtin_bit_cast(float, (unsigned)b << 16); }
__device__ __forceinline__ float bflo(unsigned w) { return __builtin_bit_cast(float, w << 16); }
__device__ __forceinline__ float bfhi(unsigned w) { return __builtin_bit_cast(float, w & 0xffff0000u); }
__device__ __forceinline__ float shx(float v, int o, int lane) { return __builtin_bit_cast(float, __builtin_amdgcn_ds_bpermute((lane ^ o) << 2, __builtin_bit_cast(int, v))); }
__device__ __forceinline__ float wave_sum(float v, int lane) {
#pragma unroll
    for (int o = 32; o >= 1; o >>= 1) v += shx(v, o, lane);
    return v;
}
__device__ __forceinline__ float row16_sum(float v) {
    v += __builtin_bit_cast(float, __builtin_amdgcn_update_dpp(0, __builtin_bit_cast(int, v), 0x128, 0xf, 0xf, false));
    v += __builtin_bit_cast(float, __builtin_amdgcn_update_dpp(0, __builtin_bit_cast(int, v), 0x124, 0xf, 0xf, false));
    v += __builtin_bit_cast(float, __builtin_amdgcn_update_dpp(0, __builtin_bit_cast(int, v), 0x122, 0xf, 0xf, false));
    v += __builtin_bit_cast(float, __builtin_amdgcn_update_dpp(0, __builtin_bit_cast(int, v), 0x121, 0xf, 0xf, false));
    return v;
}
__device__ __forceinline__ float sigmoidf_(float x) { return 1.0f / (1.0f + __expf(-x)); }

#define XB_TMO      128
#define XB_XCNT(j)  (256  + 64 * (j))
#define XB_XSUB(j)  (1280 + 64 * (j))
#define XB_XGEN(j)  (2304 + 64 * (j))
#define XB_TOP      3328
#define XB_TOPGEN   3392
#define XCD_BAR_WORDS 3456
#define XB_SPIN_CAP (1u << 18)
__device__ __forceinline__ unsigned xb_ld(unsigned* p)              { return __hip_atomic_load(p, __ATOMIC_RELAXED, __HIP_MEMORY_SCOPE_AGENT); }
__device__ __forceinline__ unsigned xb_add(unsigned* p, unsigned v) { return __hip_atomic_fetch_add(p, v, __ATOMIC_RELAXED, __HIP_MEMORY_SCOPE_AGENT); }
__device__ __forceinline__ unsigned xb_xcc_id() { return (unsigned)__builtin_amdgcn_s_getreg((3 << 11) | 20) & 0xFu; }
#define XB_SPIN(cond, bar) do { unsigned _sp = 0; while (cond) { __builtin_amdgcn_s_sleep(1); \
    if ((++_sp & 255u) == 0u) { if (xb_ld(&(bar)[XB_TMO])) break; if (_sp > XB_SPIN_CAP) { atomicAdd(&(bar)[XB_TMO], 1u); break; } } } } while (0)
struct XcdBarrier { unsigned* bar; unsigned x; volatile LAS unsigned* st; };
__device__ __forceinline__ XcdBarrier xcd_barrier_post(unsigned* bar, volatile LAS unsigned* st) {
    XcdBarrier b; b.bar = bar; b.x = xb_xcc_id(); b.st = st;
    if (threadIdx.x == 0) (void)xb_add(&bar[XB_XCNT(b.x)], 1u);
    return b;
}
__device__ __forceinline__ void xcd_barrier_complete(unsigned* bar, unsigned x, unsigned& nloc, unsigned& nx) {
    const unsigned G = gridDim.x * gridDim.y * gridDim.z;
    unsigned sum, cnt, mine, sp = 0u;
    for (;;) {
        sum = 0u; cnt = 0u; mine = 0u;
#pragma unroll
        for (unsigned j = 0; j < 16; ++j) { const unsigned c = xb_ld(&bar[XB_XCNT(j)]); sum += c; cnt += (c > 0u) ? 1u : 0u; mine = (j == x) ? c : mine; }
        if (sum == G) break;
        __builtin_amdgcn_s_sleep(1);
        if ((++sp & 255u) == 0u) { if (xb_ld(&bar[XB_TMO])) break; if (sp > XB_SPIN_CAP) { atomicAdd(&bar[XB_TMO], 1u); break; } }
    }
    nloc = mine > 0u ? mine : 1u; nx = cnt > 0u ? cnt : 1u;
}
__device__ __forceinline__ void xcd_barrier(const XcdBarrier& b) {
    asm volatile("s_waitcnt vmcnt(0)" ::: "memory");
    __syncthreads();
    if (threadIdx.x == 0) {
        unsigned* bar = b.bar;
        __builtin_amdgcn_s_waitcnt(0);
        unsigned nloc = b.st[0], nx = b.st[1];
        if (nloc == 0u) { xcd_barrier_complete(bar, b.x, nloc, nx); b.st[0] = nloc; b.st[1] = nx; }
        const unsigned old = xb_add(&bar[XB_XSUB(b.x)], 1u);
        const unsigned gen = old / nloc;
        if (old + 1u == (gen + 1u) * nloc) {
            __builtin_amdgcn_fence(__ATOMIC_RELEASE, "agent");
            asm volatile("s_waitcnt vmcnt(0)" ::: "memory");
            const unsigned og = xb_add(&bar[XB_TOP], 1u);
            const unsigned tg = og / nx;
            if (og + 1u == (tg + 1u) * nx) {
#pragma unroll
                for (unsigned j = 0; j < 16; ++j) (void)xb_add(&bar[XB_XGEN(j)], 1u);
            }
        }
        XB_SPIN(xb_ld(&bar[XB_XGEN(b.x)]) == gen, bar);
        __builtin_amdgcn_fence(__ATOMIC_ACQUIRE, "agent");
        asm volatile("s_waitcnt vmcnt(0)" ::: "memory");
    }
    __syncthreads();
}

using pg8::Unit; using pg8::cvt_pk_bf16;
__device__ __forceinline__ int fresh_lane() { int l; asm volatile("v_mbcnt_lo_u32_b32 %0, -1, 0\n\tv_mbcnt_hi_u32_b32 %0, -1, %0" : "=v"(l)); return l; }
typedef const f32x4 (&AccRef)[2][2][4][2];

__device__ __forceinline__ float row_rstd(const float* ssp, int row) {
    const f32x4* p = (const f32x4*)(ssp + (size_t)row * 32); float s = 0.f;
#pragma unroll
    for (int j = 0; j < 8; ++j) { const f32x4 v = p[j]; s += (v.x + v.y) + (v.z + v.w); }
    return rsqrtf(s * (1.0f / D) + RMS_EPS);
}
__device__ __forceinline__ void rows_rstd(const float* ssp, int row0, int fq, int ln, float (&rs)[8]) {
    f32x4 a[8], b[8];
#pragma unroll
    for (int q = 0; q < 8; ++q) { const f32x4* p = (const f32x4*)(ssp + (size_t)(row0 + (q >> 2) * 128 + (q & 3) * 16) * 32 + 8 * fq); a[q] = p[0]; b[q] = p[1]; }
#pragma unroll
    for (int q = 0; q < 8; ++q) { float s = ((a[q].x + a[q].y) + (a[q].z + a[q].w)) + ((b[q].x + b[q].y) + (b[q].z + b[q].w));
        s += shx(s, 16, ln); s += shx(s, 32, ln); rs[q] = rsqrtf(s * (1.0f / D) + RMS_EPS); }
}
__device__ __forceinline__ void store16_wt(__amdgpu_buffer_rsrc_t rsrc, unsigned byte_off, v4u v) { __builtin_amdgcn_raw_buffer_store_b128(v, rsrc, byte_off, 0, 16); }
struct EpiSwiGLU {
    static constexpr bool PERM = true, KEEP = false;
    __device__ __forceinline__ bool keep(const Unit&) const { return false; }
    bf16* H; const float* ss;
    __device__ __forceinline__ void operator()(AccRef acc, const Unit& u, int wr, int wc, int, int) const {
        const int ln_ = fresh_lane(), fr = ln_ & 15, fq = ln_ >> 4;
        const int row0 = u.pm * 256 + wr * 64 + fr, col0 = u.pn * 128 + wc * 32 + 8 * fq;
        const __amdgpu_buffer_rsrc_t rsrc = __builtin_amdgcn_make_buffer_rsrc((void*)H, 0, (int)((size_t)M * DFF * 2), 0x00020000);
        float rs[8]; rows_rstd(ss, row0, fq, ln_, rs);
#pragma unroll
        for (int ai = 0; ai < 2; ++ai)
#pragma unroll
            for (int m = 0; m < 4; ++m) {
                const int row = row0 + ai * 128 + m * 16;
                const float r = rs[ai * 4 + m];
                float h[8];
#pragma unroll
                for (int n = 0; n < 2; ++n)
#pragma unroll
                    for (int j = 0; j < 4; ++j) { const float a = acc[ai][0][m][n][j] * r, b = acc[ai][1][m][n][j] * r; h[4 * n + j] = a * __builtin_amdgcn_rcpf(1.0f + __expf(-a)) * b; }
                v4u w; w.x = cvt_pk_bf16(h[0], h[1]); w.y = cvt_pk_bf16(h[2], h[3]); w.z = cvt_pk_bf16(h[4], h[5]); w.w = cvt_pk_bf16(h[6], h[7]);
                store16_wt(rsrc, (unsigned)(((size_t)row * DFF + col0) * 2), w);
            }
    }
};
struct EpiResid {
    static constexpr bool PERM = true, KEEP = false;
    __device__ __forceinline__ bool keep(const Unit&) const { return false; }
    const float* xin32;
    float* xout32;
    bf16* xb; bf16* xl; float* ss; float alpha; float pscale, pspike;
    __device__ __forceinline__ void operator()(AccRef acc, const Unit& u, int wr, int wc, int, int) const {
        const int ln_ = fresh_lane(), fr = ln_ & 15, fq = ln_ >> 4;
        const int row0 = u.pm * 256 + wr * 64 + fr, col0 = u.pn * 256 + wc * 32 + 8 * fq;
#pragma unroll
        for (int ai = 0; ai < 2; ++ai)
#pragma unroll
            for (int m = 0; m < 4; ++m) {
                const int row = row0 + ai * 128 + m * 16; float s = 0.f;
#pragma unroll
                for (int bj = 0; bj < 2; ++bj) {
                    const size_t p = (size_t)row * D + col0 + bj * 128;
                    f32x4 x0, x1;
                    if (xin32) { x0 = *(const f32x4*)(xin32 + p); x1 = *(const f32x4*)(xin32 + p + 4); }
                    else { const v4u h = *(const v4u*)(xb + p), lo = *(const v4u*)(xl + p);
                        x0 = (f32x4){bflo(h.x) + bflo(lo.x), bfhi(h.x) + bfhi(lo.x), bflo(h.y) + bflo(lo.y), bfhi(h.y) + bfhi(lo.y)};
                        x1 = (f32x4){bflo(h.z) + bflo(lo.z), bfhi(h.z) + bfhi(lo.z), bflo(h.w) + bflo(lo.w), bfhi(h.w) + bfhi(lo.w)}; }
                    x0 = x0 + alpha * acc[ai][bj][m][0]; x1 = x1 + alpha * acc[ai][bj][m][1];
                    if (PROBE_ON) { x0 = x0 * pscale; x1 = x1 * pscale; if (p == 0) x0[0] += pspike; }
                    if (xout32) { *(f32x4*)(xout32 + p) = x0; *(f32x4*)(xout32 + p + 4) = x1; }
                    else {
                        v4u w; w.x = cvt_pk_bf16(x0[0], x0[1]); w.y = cvt_pk_bf16(x0[2], x0[3]); w.z = cvt_pk_bf16(x1[0], x1[1]); w.w = cvt_pk_bf16(x1[2], x1[3]);
                        *(v4u*)(xb + p) = w;
                        const f32x4 r0 = {x0[0] - bflo(w.x), x0[1] - bfhi(w.x), x0[2] - bflo(w.y), x0[3] - bfhi(w.y)}, r1 = {x1[0] - bflo(w.z), x1[1] - bfhi(w.z), x1[2] - bflo(w.w), x1[3] - bfhi(w.w)};
                        v4u q; q.x = cvt_pk_bf16(r0[0], r0[1]); q.y = cvt_pk_bf16(r0[2], r0[3]); q.z = cvt_pk_bf16(r1[0], r1[1]); q.w = cvt_pk_bf16(r1[2], r1[3]);
                        *(v4u*)(xl + p) = q;
                    }
                    s += (x0[0] * x0[0] + x0[1] * x0[1]) + (x0[2] * x0[2] + x0[3] * x0[3]) + (x1[0] * x1[0] + x1[1] * x1[1]) + (x1[2] * x1[2] + x1[3] * x1[3]);
                }
                s += shx(s, 16, ln_); s += shx(s, 32, ln_);
                if (fq == 0) ss[(size_t)row * 32 + u.pn * 4 + wc] = s;
                if (m == 3) asm volatile("" ::: "memory");
            }
    }
};
struct EpiProj {
    static constexpr bool PERM = true, KEEP = false;
    __device__ __forceinline__ bool keep(const Unit&) const { return false; }
    bf16* O; const float* ss;
    __device__ __forceinline__ void operator()(AccRef acc, const Unit& u, int wr, int wc, int, int) const {
        const int ln_ = fresh_lane(), fr = ln_ & 15, fq = ln_ >> 4;
        const int row0 = u.pm * 256 + wr * 64 + fr, col0 = u.pn * 256 + wc * 32 + 8 * fq;
        const __amdgpu_buffer_rsrc_t rsrc = __builtin_amdgcn_make_buffer_rsrc((void*)O, 0, (int)((size_t)M * DINP * 2), 0x00020000);
        float rs[8]; rows_rstd(ss, row0, fq, ln_, rs);
#pragma unroll
        for (int ai = 0; ai < 2; ++ai)
#pragma unroll
            for (int m = 0; m < 4; ++m) {
                const int row = row0 + ai * 128 + m * 16;
                const float r = rs[ai * 4 + m];
#pragma unroll
                for (int bj = 0; bj < 2; ++bj) {
                    const f32x4 v0 = acc[ai][bj][m][0] * r, v1 = acc[ai][bj][m][1] * r;
                    v4u w; w.x = cvt_pk_bf16(v0[0], v0[1]); w.y = cvt_pk_bf16(v0[2], v0[3]); w.z = cvt_pk_bf16(v1[0], v1[1]); w.w = cvt_pk_bf16(v1[2], v1[3]);
                    store16_wt(rsrc, (unsigned)(((size_t)row * DINP + col0 + bj * 128) * 2), w);
                }
            }
    }
};
typedef f32x4 (&AccMut)[2][2][4][2];
struct EpiBranch3 {
    static constexpr bool PERM = true, KEEP = true;
    const bf16* PROJ; bf16* MGB;
    __device__ __forceinline__ bool keep(const Unit& u) const { return u.seg < 2; }
    __device__ __forceinline__ void operator()(AccMut acc, const Unit& u, int wr, int wc, int, int) const {
        const int ln_ = fresh_lane(), fr = ln_ & 15, fq = ln_ >> 4;
        const int row0 = u.pm * 256 + wr * 64 + fr, col0 = u.pn * 256 + wc * 32 + 8 * fq;
#pragma unroll
        for (int ai = 0; ai < 2; ++ai)
#pragma unroll
            for (int m = 0; m < 4; ++m) {
#pragma unroll
                for (int bj = 0; bj < 2; ++bj) {
                    const int row = row0 + ai * 128 + m * 16, col = col0 + bj * 128;
                    const bf16* gp = PROJ + (size_t)row * DINP + GATE_OFF + col;
                    float sc[8];
                    if (u.seg < 2) {
                        const v4u ga = *(const v4u*)(gp + u.seg * D), gb = *(const v4u*)(gp + (u.seg + 1) * D);
                        const float la[8] = {bflo(ga.x), bfhi(ga.x), bflo(ga.y), bfhi(ga.y), bflo(ga.z), bfhi(ga.z), bflo(ga.w), bfhi(ga.w)};
                        const float lb[8] = {bflo(gb.x), bfhi(gb.x), bflo(gb.y), bfhi(gb.y), bflo(gb.z), bfhi(gb.z), bflo(gb.w), bfhi(gb.w)};
#pragma unroll
                        for (int j = 0; j < 8; ++j) { const float ea = __expf(-fminf(fmaxf(la[j], -30.f), 30.f)), eb = __expf(-fminf(fmaxf(lb[j], -30.f), 30.f)); sc[j] = (1.0f + eb) * __builtin_amdgcn_rcpf(1.0f + ea); }
                    } else {
                        const v4u ga = *(const v4u*)(gp + 2 * D);
                        const float la[8] = {bflo(ga.x), bfhi(ga.x), bflo(ga.y), bfhi(ga.y), bflo(ga.z), bfhi(ga.z), bflo(ga.w), bfhi(ga.w)};
#pragma unroll
                        for (int j = 0; j < 8; ++j) sc[j] = sigmoidf_(la[j]);
                    }
                    f32x4 x0 = acc[ai][bj][m][0], x1 = acc[ai][bj][m][1];
                    x0 = (f32x4){x0[0] * sc[0], x0[1] * sc[1], x0[2] * sc[2], x0[3] * sc[3]}; x1 = (f32x4){x1[0] * sc[4], x1[1] * sc[5], x1[2] * sc[6], x1[3] * sc[7]};
                    if (u.seg < 2) { acc[ai][bj][m][0] = x0; acc[ai][bj][m][1] = x1; }
                    else { v4u w; w.x = cvt_pk_bf16(x0[0], x0[1]); w.y = cvt_pk_bf16(x0[2], x0[3]); w.z = cvt_pk_bf16(x1[0], x1[1]); w.w = cvt_pk_bf16(x1[2], x1[3]); *(v4u*)(MGB + (size_t)row * D + col) = w; }
                }
                if (m & 1) asm volatile("" ::: "memory");
            }
    }
};
template <class F> struct EpiF {
    static constexpr bool PERM = true, KEEP = false;
    __device__ __forceinline__ bool keep(const Unit&) const { return false; }
    F f;
    __device__ __forceinline__ void operator()(AccRef acc, const Unit& u, int wr, int wc, int, int) const {
        const int ln_ = fresh_lane(), fr = ln_ & 15, fq = ln_ >> 4;
        const int row0 = u.pm * 256 + wr * 64 + fr, col0 = u.pn * 256 + wc * 32 + 8 * fq;
#pragma unroll
        for (int ai = 0; ai < 2; ++ai)
#pragma unroll
            for (int m = 0; m < 4; ++m)
            {
#pragma unroll
                for (int bj = 0; bj < 2; ++bj) f(row0 + ai * 128 + m * 16, col0 + bj * 128, acc[ai][bj][m][0], acc[ai][bj][m][1]);
                if (m & 1) asm volatile("" ::: "memory");
            }
    }
};
struct FDecay { const float* w0; float* out;
    __device__ __forceinline__ void operator()(int row, int col, f32x4 v0, f32x4 v1) const {
        float o[8];
#pragma unroll
        for (int j = 0; j < 8; ++j) { const float x = w0[col + j] + (j < 4 ? v0[j & 3] : v1[j & 3]); o[j] = __expf(-0.6065306597126334f * sigmoidf_(x)); }
        float* p = out + (size_t)row * RW + col; *(f32x4*)p = (f32x4){o[0], o[1], o[2], o[3]}; *(f32x4*)(p + 4) = (f32x4){o[4], o[5], o[6], o[7]}; } };
struct FASig { const float* a0; bf16* out;
    __device__ __forceinline__ void operator()(int row, int col, f32x4 v0, f32x4 v1) const {
        float o[8];
#pragma unroll
        for (int j = 0; j < 8; ++j) o[j] = sigmoidf_(a0[col + j] + (j < 4 ? v0[j & 3] : v1[j & 3]));
        v4u w; w.x = cvt_pk_bf16(o[0], o[1]); w.y = cvt_pk_bf16(o[2], o[3]); w.z = cvt_pk_bf16(o[4], o[5]); w.w = cvt_pk_bf16(o[6], o[7]);
        *(v4u*)(out + (size_t)row * RW + col) = w; } };
struct FStoreF32 { float* out; int ld;
    __device__ __forceinline__ void operator()(int row, int col, f32x4 v0, f32x4 v1) const { float* p = out + (size_t)row * ld + col; *(f32x4*)p = v0; *(f32x4*)(p + 4) = v1; } };
struct FStoreBf16 { bf16* out; int ld;
    __device__ __forceinline__ void operator()(int row, int col, f32x4 v0, f32x4 v1) const {
        v4u w; w.x = cvt_pk_bf16(v0[0], v0[1]); w.y = cvt_pk_bf16(v0[2], v0[3]); w.z = cvt_pk_bf16(v1[0], v1[1]); w.w = cvt_pk_bf16(v1[2], v1[3]);
        *(v4u*)(out + (size_t)row * ld + col) = w; } };
struct FVres { const float* v0p; bf16* VP; const bf16* VF;
    __device__ __forceinline__ void operator()(int row, int col, f32x4 a0, f32x4 a1) const {
        const size_t p = (size_t)row * RW + col;
        const v4u xv = *(const v4u*)(VP + p), fv = *(const v4u*)(VF + p);
        const float x[8] = {bflo(xv.x), bfhi(xv.x), bflo(xv.y), bfhi(xv.y), bflo(xv.z), bfhi(xv.z), bflo(xv.w), bfhi(xv.w)};
        const float f[8] = {bflo(fv.x), bfhi(fv.x), bflo(fv.y), bfhi(fv.y), bflo(fv.z), bfhi(fv.z), bflo(fv.w), bfhi(fv.w)};
        float o[8];
#pragma unroll
        for (int j = 0; j < 8; ++j) o[j] = x[j] + (f[j] - x[j]) * sigmoidf_(v0p[col + j] + (j < 4 ? a0[j & 3] : a1[j & 3]));
        v4u w; w.x = cvt_pk_bf16(o[0], o[1]); w.y = cvt_pk_bf16(o[2], o[3]); w.z = cvt_pk_bf16(o[4], o[5]); w.w = cvt_pk_bf16(o[6], o[7]);
        *(v4u*)(VP + p) = w; } };
struct FGlu { const bf16* Z; bf16* Y;
    __device__ __forceinline__ void operator()(int row, int col, f32x4 a0, f32x4 a1) const {
        const size_t p = (size_t)row * 1024 + col; const v4u z = *(const v4u*)(Z + p);
        const float z0 = bflo(z.x), z1 = bfhi(z.x), z2 = bflo(z.y), z3 = bfhi(z.y), z4 = bflo(z.z), z5 = bfhi(z.z), z6 = bflo(z.w), z7 = bfhi(z.w);
        v4u w; w.x = cvt_pk_bf16(z0 * sigmoidf_(a0[0]), z1 * sigmoidf_(a0[1])); w.y = cvt_pk_bf16(z2 * sigmoidf_(a0[2]), z3 * sigmoidf_(a0[3]));
        w.z = cvt_pk_bf16(z4 * sigmoidf_(a1[0]), z5 * sigmoidf_(a1[1])); w.w = cvt_pk_bf16(z6 * sigmoidf_(a1[2]), z7 * sigmoidf_(a1[3]));
        *(v4u*)(Y + p) = w; } };
template <int MODE> struct FBranch { const bf16* PROJ; int goff; float* MG; bf16* MGB;
    __device__ __forceinline__ void operator()(int row, int col, f32x4 a0, f32x4 a1) const {
        const v4u gq = *(const v4u*)(PROJ + (size_t)row * DINP + goff + col);
        const float g0 = sigmoidf_(bflo(gq.x)), g1 = sigmoidf_(bfhi(gq.x)), g2 = sigmoidf_(bflo(gq.y)), g3 = sigmoidf_(bfhi(gq.y)), g4 = sigmoidf_(bflo(gq.z)), g5 = sigmoidf_(bfhi(gq.z)), g6 = sigmoidf_(bflo(gq.w)), g7 = sigmoidf_(bfhi(gq.w));
        const size_t p = (size_t)row * D + col;
        f32x4 x0 = (f32x4){g0 * a0[0], g1 * a0[1], g2 * a0[2], g3 * a0[3]}, x1 = (f32x4){g4 * a1[0], g5 * a1[1], g6 * a1[2], g7 * a1[3]};
        if (MODE != 0) { x0 = x0 + *(const f32x4*)(MG + p); x1 = x1 + *(const f32x4*)(MG + p + 4); }
        if (MODE != 2) { *(f32x4*)(MG + p) = x0; *(f32x4*)(MG + p + 4) = x1; }
        else { v4u w; w.x = cvt_pk_bf16(x0[0], x0[1]); w.y = cvt_pk_bf16(x0[2], x0[3]); w.z = cvt_pk_bf16(x1[0], x1[1]); w.w = cvt_pk_bf16(x1[2], x1[3]); *(v4u*)(MGB + p) = w; } } };

__device__ __forceinline__ void norm_frag(v4u r0, v4u r1, const float (&g16)[16], int lane, pg8::bf16x8& f0, pg8::bf16x8& f1) {
    float x[16] = {bflo(r0.x), bfhi(r0.x), bflo(r0.y), bfhi(r0.y), bflo(r0.z), bfhi(r0.z), bflo(r0.w), bfhi(r0.w), bflo(r1.x), bfhi(r1.x), bflo(r1.y), bfhi(r1.y), bflo(r1.z), bfhi(r1.z), bflo(r1.w), bfhi(r1.w)};
    float ss = 0.f;
#pragma unroll
    for (int j = 0; j < 16; ++j) ss += x[j] * x[j];
    ss += shx(ss, 16, lane); ss += shx(ss, 32, lane);
    const float r = rsqrtf(ss * (1.0f / 64) + RMS_EPS);
#pragma unroll
    for (int j = 0; j < 16; ++j) x[j] = x[j] * r * g16[j];
    v4u a, b; a.x = pg8::cvt_pk_bf16(x[0], x[1]); a.y = pg8::cvt_pk_bf16(x[2], x[3]); a.z = pg8::cvt_pk_bf16(x[4], x[5]); a.w = pg8::cvt_pk_bf16(x[6], x[7]);
    b.x = pg8::cvt_pk_bf16(x[8], x[9]); b.y = pg8::cvt_pk_bf16(x[10], x[11]); b.z = pg8::cvt_pk_bf16(x[12], x[13]); b.w = pg8::cvt_pk_bf16(x[14], x[15]);
    f0 = __builtin_bit_cast(pg8::bf16x8, a); f1 = __builtin_bit_cast(pg8::bf16x8, b);
}
struct ConvItem { const float* W; const float* ks; bf16* dst; int ldw, Ksrc, srcc, ldd, drow0, k0, ncols; };
template <int MAP> __device__ __forceinline__ ConvItem conv_mk(const float* W, int ldw, int Ksrc, int Kdst, int Nsrc, int Ndst, const float* ks, bf16* dst, int item, int ldd = 0) {
    const int nblk = Ndst / 64, kb = item / nblk, nb = item % nblk, n0 = 64 * nb;
    int srcc;
    if (MAP == 0) srcc = (n0 < Nsrc) ? n0 : -1;
    else { const int tile = n0 >> 8, within = n0 & 255, bj = within >> 7, c = within & 127; srcc = bj * DFF + tile * 128 + c; }
    ConvItem ci; ci.W = W; ci.ks = ks; ci.dst = dst; ci.ldw = ldw; ci.Ksrc = Ksrc; ci.srcc = srcc; ci.ldd = ldd ? ldd : Kdst; ci.drow0 = n0; ci.k0 = 64 * kb; ci.ncols = (MAP == 0) ? Nsrc : 2 * DFF; return ci;
}
__device__ __forceinline__ void conv_load(const ConvItem& ci, int lane, float (&v)[64]) {
    const bool okc = ci.srcc >= 0 && (ci.srcc + lane) < ci.ncols;
    const float* base = ci.W + (okc ? ci.srcc + lane : 0);
    const int kmax = ci.Ksrc - 1;
#pragma unroll
    for (int i = 0; i < 64; ++i) { const int k = ci.k0 + i, kk = k < kmax ? k : kmax; v[i] = __builtin_nontemporal_load(base + (size_t)kk * ci.ldw); }
#pragma unroll
    for (int i = 0; i < 64; ++i) v[i] = (okc && (ci.k0 + i) < ci.Ksrc) ? v[i] : 0.f;
}
__device__ __forceinline__ void conv_store(const ConvItem& ci, LAS float* scr, int lane, const float (&v)[64]) {
    const int c = lane & 7;
    const __amdgpu_buffer_rsrc_t rs_d = __builtin_amdgcn_make_buffer_rsrc((void*)ci.dst, 0, 0x7fffffff, 0x00020000);
    f32x4 s0 = {1.f, 1.f, 1.f, 1.f}, s1 = s0;
    if (ci.ks) { const int kb = ci.k0 + 8 * c < ci.Ksrc - 8 ? ci.k0 + 8 * c : ci.Ksrc - 8; s0 = *(const f32x4*)(ci.ks + kb); s1 = *(const f32x4*)(ci.ks + kb + 4); }
#pragma unroll
    for (int i = 0; i < 64; ++i) scr[i * 65 + lane] = v[i];
    LDS_WAIT(); asm volatile("" ::: "memory");
#pragma unroll
    for (int j = 0; j < 8; ++j) { const int n = (lane >> 3) + 8 * j; const LAS float* s = scr + (8 * c) * 65 + n;
        v4u o; o.x = cvt_pk_bf16(s[0 * 65] * s0[0], s[1 * 65] * s0[1]); o.y = cvt_pk_bf16(s[2 * 65] * s0[2], s[3 * 65] * s0[3]); o.z = cvt_pk_bf16(s[4 * 65] * s1[0], s[5 * 65] * s1[1]); o.w = cvt_pk_bf16(s[6 * 65] * s1[2], s[7 * 65] * s1[3]);
        __builtin_amdgcn_raw_buffer_store_b128(o, rs_d, (unsigned)(((ci.drow0 + n) * ci.ldd + ci.k0 + 8 * c) * 2), 0, 16); }
    LDS_WAIT(); asm volatile("" ::: "memory");
}

__device__ __forceinline__ bool in_range(int lo, int hi, int k) { asm volatile("" : "+s"(k)); return lo <= k && k < hi; }
struct Args { const float* in[38]; float* out; unsigned char* ws; int ph_lo, ph_hi, use_bar, pad; };
typedef const Args __attribute__((address_space(4)))* KArgs;

__global__ void __launch_bounds__(NWAVES * 64, 2) mk_fwd(Args args) {
    extern __shared__ __attribute__((aligned(16))) unsigned char lds_raw[];
    LAS unsigned char* lds = (LAS unsigned char*)lds_raw;
    for (int u = threadIdx.x; u < (LDS_BYTES - LDSCTL_OFF) / 4; u += NWAVES * 64) ((LAS unsigned*)(lds + LDSCTL_OFF))[u] = 0u;
    __syncthreads();
    XcdBarrier bar; bar.bar = (unsigned*)(args.ws + WS_CTL) + CW_BAR; bar.x = 0; bar.st = nullptr;
    if (args.use_bar) bar = xcd_barrier_post((unsigned*)(args.ws + WS_CTL) + CW_BAR, (volatile LAS unsigned*)(lds + LDSCTL_OFF + 64));

    const int lo = args.ph_lo, hi = args.ph_hi, use_bar = args.use_bar;
    const int wave0 = __builtin_amdgcn_readfirstlane((int)threadIdx.x >> 6);
#ifndef PHMASK
#define PHMASK 0xFFFF
#endif
#define EN(p) ((PHMASK >> (p)) & 1)
#define IN(k) in_range(lo, hi, (k))
#define SEAM(k) do { if (IN(k) && IN((k) + 1)) { if (use_bar) { XcdBarrier b_ = bar; asm volatile("" : "+s"(b_.bar), "+s"(b_.x)); xcd_barrier(b_); } } } while (0)
#define DBG_ACC ((unsigned*)(args.ws + WS_CTL + 128 * 1024))
#define STAMP(k) do { if (PROBE_ON && wave0 == 0 && blockIdx.x == 0) { if (fresh_lane() == 0) { unsigned* a_ = DBG_ACC; const unsigned now_ = (unsigned)__builtin_amdgcn_s_memrealtime(); \
        const int ty_ = (k) == 0 ? 15 : ((k) - 1) % NPH; a_[ty_] += now_ - a_[32]; a_[32] = now_; } } } while (0)
#define PH_LOCALS \
    int lane; asm volatile("v_mbcnt_lo_u32_b32 %0, -1, 0\n\tv_mbcnt_hi_u32_b32 %0, -1, %0" : "=v"(lane)); int wave = wave0; asm volatile("" : "+s"(wave)); const int tid = wave * 64 + lane; \
    int G = gridDim.x, bid = blockIdx.x; asm volatile("" : "+s"(G), "+s"(bid)); \
    KArgs ka = (KArgs)__builtin_amdgcn_kernarg_segment_ptr(); asm volatile("" : "+s"(ka)); \
    unsigned char* ws = ka->ws; \
    const int gw = bid * NWAVES + wave, NGW = G * NWAVES; const size_t gtid = (size_t)bid * (NWAVES * 64) + tid, NT = (size_t)G * (NWAVES * 64); \
    (void)lane; (void)gw; (void)NGW; (void)gtid; (void)NT;
#define P_XL ((bf16*)(ws + WS_X))
#define P_XB ((bf16*)(ws + WS_XB))
#define P_HID ((bf16*)(ws + WS_HID))
#define P_PROJ ((bf16*)(ws + WS_PROJ))
#define P_SS ((float*)(ws + WS_SSP))
#define P_RP ((bf16*)(ws + WS_RP))
#define P_KP ((bf16*)(ws + WS_KP))
#define P_VP ((bf16*)(ws + WS_VP))
#define P_DECAY ((float*)(ws + WS_DECAY))
#define P_ASIG ((bf16*)(ws + WS_ASIG))
#define P_GG ((bf16*)(ws + WS_G))
#define P_KK ((bf16*)(ws + WS_KK))
#define P_VFIRST ((bf16*)(ws + WS_VFIRST))
#define P_YRAW ((bf16*)(ws + WS_YRAW))
#define P_LORA ((bf16*)(ws + WS_LORA))
#define P_AV ((bf16*)(ws + WS_VP))
#define P_V1O ((bf16*)(ws + WS_V1O))
#define P_QN ((bf16*)(ws + WS_QN))
#define P_KN ((bf16*)(ws + WS_KN))
#define P_Z ((bf16*)(ws + WS_Z))
#define P_YS5 ((bf16*)(ws + WS_YS5))
#define P_YATT ((bf16*)(ws + WS_MERGED))
#define P_YRWKV ((bf16*)(ws + WS_YRWKV))
#define P_MERGED ((float*)(ws + WS_MERGED))
#define P_MERGEDB ((bf16*)(ws + WS_MERGEDB))
#define P_SBUF ((f32x2*)(ws + WS_SBUF))

    if (PROBE_ON && wave0 == 0 && blockIdx.x == 0) { if (fresh_lane() == 0) DBG_ACC[32] = (unsigned)__builtin_amdgcn_s_memrealtime(); }
    if (IN(0)) {
        PH_LOCALS
        const float* x = ka->in[0];
        for (int m = gw; m < M; m += NGW) {
            const f32x4* xr = (const f32x4*)(x + (size_t)m * D) + lane; float s = 0.f;
            v2u* o = (v2u*)(P_XB + (size_t)m * D) + lane;
#pragma unroll
            for (int j = 0; j < 8; ++j) { const f32x4 v = xr[64 * j]; s += (v.x * v.x + v.y * v.y) + (v.z * v.z + v.w * v.w); v2u w; w.x = pk2(v.x, v.y); w.y = pk2(v.z, v.w); o[64 * j] = w; }
            s = wave_sum(s, lane);
            if (lane < 32) P_SS[(size_t)m * 32 + lane] = lane == 0 ? s : 0.f;
        }
    }
    STAMP(0);

    for (int l = 0; l < DEPTH; ++l) {
        const int pb = 1 + l * NPH;
        if (hi <= pb || lo >= pb + NPH) continue;
        if (EN(0) && IN(pb + 0)) {
            PH_LOCALS
            LAS float* scr = (LAS float*)(lds + RING_OFF + wave * 16640);   static_assert(8 * 16640 <= LDSCTL_OFF, "converter scratch below the LDS control words");
            constexpr int I_UP = (D / 64) * (NUP / 64), I_DN = (DFF / 64) * (D / 64), I_IN = (D / 64) * (DINP / 64), I_GLU = 16 * 16, I_L = 4 * 16, I_V1 = 16 * 4, I_V2 = 4 * 16,
                          I_BS5 = 16 * 32, I_BAT = 8 * 32, I_BRW = 16 * 32, I_OUT = 32 * 32;
            constexpr int NITEMS = 2 * I_UP + 2 * I_DN + I_IN + I_GLU + 3 * I_L + I_V1 + I_V2 + I_BS5 + I_BAT + I_BRW + I_OUT;
            const int lv = l > 0 ? l - 1 : 0;
#define CONV_DESC(dst_, it_) do { int r = (it_); \
                if (r < I_UP) { dst_ = conv_mk<1>(ka->in[2] + (size_t)l * D * NUP, NUP, D, D, NUP, NUP, ka->in[1] + l * D, (bf16*)(ws + W_UP1), r); break; } r -= I_UP; \
                if (r < I_UP) { dst_ = conv_mk<1>(ka->in[36] + (size_t)l * D * NUP, NUP, D, D, NUP, NUP, ka->in[35] + l * D, (bf16*)(ws + W_UP2), r); break; } r -= I_UP; \
                if (r < I_IN) { dst_ = conv_mk<0>(ka->in[5] + (size_t)l * D * DIN, DIN, D, D, DIN, DINP, ka->in[4] + l * D, (bf16*)(ws + W_IN), r); break; } r -= I_IN; \
                if (r < I_DN) { dst_ = conv_mk<0>(ka->in[3] + (size_t)l * DFF * D, D, DFF, DFF, D, D, nullptr, (bf16*)(ws + W_DN1), r); break; } r -= I_DN; \
                if (r < I_DN) { dst_ = conv_mk<0>(ka->in[37] + (size_t)l * DFF * D, D, DFF, DFF, D, D, nullptr, (bf16*)(ws + W_DN2), r); break; } r -= I_DN; \
                if (r < I_OUT) { dst_ = conv_mk<0>(ka->in[34] + (size_t)l * D * D, D, D, D, D, D, nullptr, (bf16*)(ws + W_OUT), r); break; } r -= I_OUT; \
                if (r < I_BS5) { dst_ = conv_mk<0>(ka->in[31] + (size_t)l * 1024 * D, D, 1024, 1024, D, D, nullptr, (bf16*)(ws + W_BS5), r); break; } r -= I_BS5; \
                if (r < I_BAT) { dst_ = conv_mk<0>(ka->in[32] + (size_t)l * 512 * D, D, 512, 512, D, D, nullptr, (bf16*)(ws + W_BAT2), r, 1024); break; } r -= I_BAT; \
                if (r < I_BRW) { dst_ = conv_mk<0>(ka->in[33] + (size_t)l * 1024 * D, D, 1024, 1024, D, D, nullptr, (bf16*)(ws + W_BRW), r); break; } r -= I_BRW; \
                if (r < I_GLU) { dst_ = conv_mk<0>(ka->in[14] + (size_t)l * 1024 * 1024, 1024, 1024, 1024, 1024, 1024, nullptr, (bf16*)(ws + W_GLU), r); break; } r -= I_GLU; \
                if (r < I_L) { dst_ = conv_mk<0>(ka->in[19] + (size_t)l * 96 * RW, RW, 96, 256, RW, RW, nullptr, (bf16*)(ws + W_W2), r); break; } r -= I_L; \
                if (r < I_L) { dst_ = conv_mk<0>(ka->in[21] + (size_t)l * 96 * RW, RW, 96, 256, RW, RW, nullptr, (bf16*)(ws + W_A2), r); break; } r -= I_L; \
                if (r < I_L) { dst_ = conv_mk<0>(ka->in[22] + (size_t)l * 256 * RW, RW, 256, 256, RW, RW, nullptr, (bf16*)(ws + W_G2), r); break; } r -= I_L; \
                if (r < I_V1) { dst_ = conv_mk<0>(ka->in[29] + (size_t)lv * RW * 64, 64, RW, RW, 64, 256, nullptr, (bf16*)(ws + W_V1), r); break; } r -= I_V1; \
                dst_ = conv_mk<0>(ka->in[30] + (size_t)lv * 64 * RW, RW, 64, 256, RW, RW, nullptr, (bf16*)(ws + W_V2), r); } while (0)
            for (int it = gw; it < NITEMS; it += NGW) {
                ConvItem ca; CONV_DESC(ca, it);
                float va[64];
                conv_load(ca, lane, va);
                conv_store(ca, scr, lane, va);
            }
#undef CONV_DESC
        }
        SEAM(pb + 0); STAMP(pb + 0);
        if (EN(1) && IN(pb + 1)) {
            PH_LOCALS
            pg8::Gemm g{P_XB, (const bf16*)(ws + W_UP1), M, NUP, D, D, D}; pg8::StaticOrder S; S.init(M, NUP, G, bid);
            EpiSwiGLU E{P_HID, P_SS + (size_t)(3 * l + 0) * M * 32};
            pg8::gemm_phase<EpiSwiGLU, pg8::StaticOrder, true, true>(lds + RING_OFF, g, S, E, tid);
        }
        SEAM(pb + 1); STAMP(pb + 1);
        if (EN(2) && IN(pb + 2)) {
            PH_LOCALS
            pg8::Gemm g{P_HID, (const bf16*)(ws + W_DN1), M, D, DFF, DFF, DFF}; pg8::StaticOrder S; S.init(M, D, G, bid);
            EpiResid E{l == 0 ? ka->in[0] : nullptr, nullptr, P_XB, P_XL, P_SS + (size_t)(3 * l + 1) * M * 32, 0.5f, 1.0f, 0.0f};
            pg8::gemm_phase<EpiResid, pg8::StaticOrder, true, true>(lds + RING_OFF, g, S, E, tid);
        }
        SEAM(pb + 2); STAMP(pb + 2);
        if (EN(3) && IN(pb + 3)) {
            PH_LOCALS
            pg8::Gemm g{P_XB, (const bf16*)(ws + W_IN), M, DINP, D, D, D}; pg8::StaticOrder S; S.init(M, DINP, G, bid);
            EpiProj E{P_PROJ, P_SS + (size_t)(3 * l + 1) * M * 32};
            pg8::gemm_phase<EpiProj, pg8::StaticOrder, true, true>(lds + RING_OFF, g, S, E, tid);
        }
        SEAM(pb + 3); STAMP(pb + 3);
        if (EN(4) && IN(pb + 4)) {
            PH_LOCALS
            const float* mu = ka->in[17] + (size_t)l * RWP;
            const bf16* PROJ = P_PROJ; bf16* LORA = P_LORA; bf16* RPp = P_RP; bf16* KPp = P_KP; bf16* VPp = P_VP; bf16* VFp = P_VFIRST; bf16* KKp = P_KK;
#pragma unroll 1
            for (int ch = lane; ch < RWP / 8; ch += 64) {
                const int c = ch * 8;
                const f32x4 m0 = *(const f32x4*)(mu + c), m1 = *(const f32x4*)(mu + c + 4);
                f32x4 q0 = {0.f, 0.f, 0.f, 0.f}, q1 = q0;
                if (c >= 1024 && c < 2048) { q0 = *(const f32x4*)(ka->in[23] + l * RW + c - 1024); q1 = *(const f32x4*)(ka->in[23] + l * RW + c - 1024 + 4); }
#pragma unroll 1
                for (int m = gw; m < M; m += NGW) {
                    const bool has_prev = (m % T) != 0;
                    const bf16* prow = PROJ + (size_t)m * DINP;
                    const v4u pc = *(const v4u*)(prow + RW_OFF + c);
                    v4u pp = {0u, 0u, 0u, 0u}; if (has_prev) pp = *(const v4u*)(prow - DINP + RW_OFF + c);
                    float p[8];
                    { const float c0 = bflo(pc.x), c1 = bfhi(pc.x), c2 = bflo(pc.y), c3 = bfhi(pc.y), c4 = bflo(pc.z), c5 = bfhi(pc.z), c6 = bflo(pc.w), c7 = bfhi(pc.w);
                      p[0] = c0 + (bflo(pp.x) - c0) * m0[0]; p[1] = c1 + (bfhi(pp.x) - c1) * m0[1]; p[2] = c2 + (bflo(pp.y) - c2) * m0[2]; p[3] = c3 + (bfhi(pp.y) - c3) * m0[3];
                      p[4] = c4 + (bflo(pp.z) - c4) * m1[0]; p[5] = c5 + (bfhi(pp.z) - c5) * m1[1]; p[6] = c6 + (bflo(pp.w) - c6) * m1[2]; p[7] = c7 + (bfhi(pp.w) - c7) * m1[3]; }
                    if (c >= 1024 && c < 2048) {
                        float kk[8] = {p[0] * q0[0], p[1] * q0[1], p[2] * q0[2], p[3] * q0[3], p[4] * q1[0], p[5] * q1[1], p[6] * q1[2], p[7] * q1[3]};
                        float ssq = (kk[0] * kk[0] + kk[1] * kk[1]) + (kk[2] * kk[2] + kk[3] * kk[3]) + (kk[4] * kk[4] + kk[5] * kk[5]) + (kk[6] * kk[6] + kk[7] * kk[7]);
                        ssq += shx(ssq, 1, lane); ssq += shx(ssq, 2, lane); ssq += shx(ssq, 4, lane);
                        const float rn = rsqrtf(fmaxf(ssq, 1e-24f));
                        v4u w; w.x = cvt_pk_bf16(kk[0] * rn, kk[1] * rn); w.y = cvt_pk_bf16(kk[2] * rn, kk[3] * rn); w.z = cvt_pk_bf16(kk[4] * rn, kk[5] * rn); w.w = cvt_pk_bf16(kk[6] * rn, kk[7] * rn);
                        *(v4u*)(KKp + (size_t)m * RW + (c - 1024)) = w;
                    }
                    if (c < 3072) {
                        bf16* dst = (c < 1024 ? RPp : (c < 2048 ? KPp : VPp)) + (size_t)m * RW + (c & 1023);
                        v4u w; w.x = cvt_pk_bf16(p[0], p[1]); w.y = cvt_pk_bf16(p[2], p[3]); w.z = cvt_pk_bf16(p[4], p[5]); w.w = cvt_pk_bf16(p[6], p[7]);
                        *(v4u*)dst = w;
                        if (c >= 2048 && l == 0) *(v4u*)(VFp + (size_t)m * RW + (c & 1023)) = w;
                    } else {
                        int dcol;
                        if (c < 3168) { dcol = c - 3072;
#pragma unroll
                            for (int j = 0; j < 8; ++j) p[j] = 1.0f - 2.0f / (1.0f + __expf(2.0f * p[j])); }
                        else if (c < 3264) dcol = 256 + c - 3168;
                        else { dcol = 512 + c - 3264;
#pragma unroll
                            for (int j = 0; j < 8; ++j) p[j] = sigmoidf_(p[j]); }
                        v4u w; w.x = cvt_pk_bf16(p[0], p[1]); w.y = cvt_pk_bf16(p[2], p[3]); w.z = cvt_pk_bf16(p[4], p[5]); w.w = cvt_pk_bf16(p[6], p[7]);
                        *(v4u*)(LORA + (size_t)m * 768 + dcol) = w;
                    }
                }
            }
#pragma unroll 1
            for (int m = gw; m < M; m += NGW)
                if (lane < 40) { const unsigned z0 = (unsigned)lane >> 8; const v4u z = {z0, z0, z0, z0};     *(v4u*)(LORA + (size_t)m * 768 + (lane < 20 ? 96 + 8 * lane : 352 + 8 * (lane - 20))) = z; }
        }
        if (EN(4) && IN(pb + 4)) {
            PH_LOCALS
            const bf16* PROJ = P_PROJ; bf16* Z = P_Z;
            LAS float* BUs = (LAS float*)(lds + wave * 12800);
            LAS unsigned* Ss = (LAS unsigned*)(lds + wave * 12800 + 8448);
            LAS float* Ex = (LAS float*)(lds + 8 * 12800);
            const int g4 = lane >> 4, i16 = lane & 15;
            for (int item = bid; item < 256; item += G) {
                const int b = item >> 6, g = item & 63;
                const float dt = expf(ka->in[12][l * 64 + g]);
                float ab_re, ab_im;
                { const float lam_re = fminf(ka->in[6][(l * 64 + g) * 64 + lane], -1e-4f), lam_im = ka->in[7][(l * 64 + g) * 64 + lane];
                  const float mag = expf(lam_re * dt); ab_re = mag * cosf(lam_im * dt); ab_im = mag * sinf(lam_im * dt); }
                pg8::bf16x8 Abb[8];
#pragma unroll
                for (int mt = 0; mt < 4; ++mt) {
                    const int pp = 16 * mt + i16;
                    const float lam_re = fminf(ka->in[6][(l * 64 + g) * 64 + pp], -1e-4f), lam_im = ka->in[7][(l * 64 + g) * 64 + pp];
                    const float mag = expf(lam_re * dt), are = mag * cosf(lam_im * dt), aim = mag * sinf(lam_im * dt);
                    const float den = lam_re * lam_re + lam_im * lam_im, nre = are - 1.0f;
                    const float cr = (nre * lam_re + aim * lam_im) / den, ci = (aim * lam_re - nre * lam_im) / den;
                    v4u wr_ = {0u, 0u, 0u, 0u}, wi_ = {0u, 0u, 0u, 0u};
                    if (g4 < 2) {
                        const float* bre = ka->in[8] + ((size_t)(l * 64 + g) * 64 + pp) * 16 + 8 * g4; const float* bim = ka->in[9] + ((size_t)(l * 64 + g) * 64 + pp) * 16 + 8 * g4;
                        const f32x4 r0 = *(const f32x4*)bre, r1 = *(const f32x4*)(bre + 4), m0_ = *(const f32x4*)bim, m1_ = *(const f32x4*)(bim + 4);
                        const f32x4 xr0 = cr * r0 - ci * m0_, xr1 = cr * r1 - ci * m1_, xi0 = cr * m0_ + ci * r0, xi1 = cr * m1_ + ci * r1;
                        wr_.x = cvt_pk_bf16(xr0[0], xr0[1]); wr_.y = cvt_pk_bf16(xr0[2], xr0[3]); wr_.z = cvt_pk_bf16(xr1[0], xr1[1]); wr_.w = cvt_pk_bf16(xr1[2], xr1[3]);
                        wi_.x = cvt_pk_bf16(xi0[0], xi0[1]); wi_.y = cvt_pk_bf16(xi0[2], xi0[3]); wi_.z = cvt_pk_bf16(xi1[0], xi1[1]); wi_.w = cvt_pk_bf16(xi1[2], xi1[3]);
                    }
                    Abb[mt] = __builtin_bit_cast(pg8::bf16x8, wr_); Abb[4 + mt] = __builtin_bit_cast(pg8::bf16x8, wi_);
                }
                pg8::bf16x8 Cop[4];
#pragma unroll
                for (int kb = 0; kb < 4; ++kb) {
                    const float* cre = ka->in[10] + ((size_t)(l * 64 + g) * 16 + i16) * 64 + 16 * kb + 4 * g4; const float* cim = ka->in[11] + ((size_t)(l * 64 + g) * 16 + i16) * 64 + 16 * kb + 4 * g4;
                    const f32x4 r = *(const f32x4*)cre, m = *(const f32x4*)cim;
                    v4u w; w.x = cvt_pk_bf16(r[0], -m[0]); w.y = cvt_pk_bf16(r[1], -m[1]); w.z = cvt_pk_bf16(r[2], -m[2]); w.w = cvt_pk_bf16(r[3], -m[3]);
                    Cop[kb] = __builtin_bit_cast(pg8::bf16x8, w);
                }
                const size_t tok0 = (size_t)b * T + wave * 256;
                float s_re = 0.f, s_im = 0.f;
#pragma unroll 1
                for (int pass = 0; pass < 2; ++pass) {
                    v4u uwn = *(const v4u*)(PROJ + (tok0 + i16) * DINP + U_OFF + g * 16 + 8 * (g4 & 1));
#pragma unroll 1
                    for (int st = 0; st < 16; ++st) {
                        const size_t rowt = tok0 + st * 16 + i16;
                        v4u uw = uwn; if (g4 >= 2) { uw.x = 0u; uw.y = 0u; uw.z = 0u; uw.w = 0u; }
                        { const int stn = st < 15 ? st + 1 : 15; uwn = *(const v4u*)(PROJ + (tok0 + stn * 16 + i16) * DINP + U_OFF + g * 16 + 8 * (g4 & 1)); }
                        const v2u uq = *(const v2u*)(PROJ + rowt * DINP + U_OFF + g * 16 + 4 * g4);
                        const pg8::bf16x8 Uop = __builtin_bit_cast(pg8::bf16x8, uw);
#pragma unroll
                        for (int mt = 0; mt < 8; ++mt) { f32x4 d = {0.f, 0.f, 0.f, 0.f}; d = __builtin_amdgcn_mfma_f32_16x16x32_bf16(Abb[mt], Uop, d, 0, 0, 0);
                            *(LAS f32x4*)(BUs + i16 * 132 + 16 * mt + 4 * g4) = d; }
                        asm volatile("s_waitcnt lgkmcnt(0)" ::: "memory");
#pragma unroll
                        for (int tt = 0; tt < 16; ++tt) {
                            const float bur = BUs[tt * 132 + lane], bui = BUs[tt * 132 + 64 + lane];
                            const float nr = ab_re * s_re - ab_im * s_im + bur, ni = ab_re * s_im + ab_im * s_re + bui; s_re = nr; s_im = ni;
                            if (pass == 1) Ss[tt * 68 + lane] = cvt_pk_bf16(s_re, s_im);
                        }
                        asm volatile("s_waitcnt lgkmcnt(0)" ::: "memory");
                        if (pass == 1) {
                            f32x4 y = {0.f, 0.f, 0.f, 0.f};
#pragma unroll
                            for (int kb = 0; kb < 4; ++kb) { const pg8::bf16x8 Sop = *(const LAS pg8::bf16x8*)((const LAS unsigned char*)Ss + i16 * 272 + 64 * kb + 16 * g4);
                                y = __builtin_amdgcn_mfma_f32_16x16x32_bf16(Cop[kb], Sop, y, 0, 0, 0); }
                            const f32x4 dsk = *(const f32x4*)(ka->in[13] + l * 1024 + g * 16 + 4 * g4);
                            const float uu[4] = {bflo(uq.x), bfhi(uq.x), bflo(uq.y), bfhi(uq.y)}; float zz[4];
#pragma unroll
                            for (int i = 0; i < 4; ++i) { const float yy = y[i] + dsk[i] * uu[i]; const float a = 0.7978845608028654f * (yy + 0.044715f * yy * yy * yy);
                                const float th = 1.0f - 2.0f / (1.0f + __expf(2.0f * a)); zz[i] = 0.5f * yy * (1.0f + th); }
                            v2u zo; zo.x = cvt_pk_bf16(zz[0], zz[1]); zo.y = cvt_pk_bf16(zz[2], zz[3]);
                            *(v2u*)(Z + rowt * 1024 + g * 16 + 4 * g4) = zo;
                            asm volatile("s_waitcnt lgkmcnt(0)" ::: "memory");
                        }
                    }
                    if (pass == 0) {
                        Ex[(wave * 64 + lane) * 2] = s_re; Ex[(wave * 64 + lane) * 2 + 1] = s_im;
                        float pr = ab_re, pi = ab_im;
#pragma unroll
                        for (int q = 0; q < 8; ++q) { const float t_ = pr * pr - pi * pi; pi = 2.0f * pr * pi; pr = t_; }
                        __syncthreads();
                        float cr_ = 0.f, ci_ = 0.f;
                        for (int w2 = 0; w2 < wave; ++w2) { const float er = Ex[(w2 * 64 + lane) * 2], ei = Ex[(w2 * 64 + lane) * 2 + 1];
                            const float nr = pr * cr_ - pi * ci_ + er, ni = pr * ci_ + pi * cr_ + ei; cr_ = nr; ci_ = ni; }
                        s_re = cr_; s_im = ci_;
                    }
                }
                __syncthreads();
            }
        }
        if (EN(4) && IN(pb + 4)) {
            PH_LOCALS
            const bf16* PROJ = P_PROJ; bf16* YATT = P_YATT;
            LAS float* Ol = (LAS float*)lds;
            LAS float* Dl = (LAS float*)(lds + 256 * 68 * 4);
            LAS unsigned char* Vs = lds + 256 * 68 * 4 + 1024 + wave * 5120;
            const int g4 = lane >> 4, i16 = lane & 15;
            float mq = fabsf(ka->in[15][l * 64 + lane]), mk = fabsf(ka->in[16][l * 64 + lane]);
#pragma unroll
            for (int o = 32; o >= 1; o >>= 1) { mq = fmaxf(mq, shx(mq, o, lane)); mk = fmaxf(mk, shx(mk, o, lane)); }
            float gq16[16], gk16[16];
#pragma unroll
            for (int j = 0; j < 8; ++j) { gq16[j] = ka->in[15][l * 64 + 8 * g4 + j]; gq16[8 + j] = ka->in[15][l * 64 + 32 + 8 * g4 + j]; gk16[j] = ka->in[16][l * 64 + 8 * g4 + j]; gk16[8 + j] = ka->in[16][l * 64 + 32 + 8 * g4 + j]; }
            const float Mref = 8.5f * mq * mk;
            for (int item = bid; item < 256; item += G) {
                const int b = item >> 6, hh = (item >> 3) & 7, t0 = (item & 7) * 256;
                for (int gi = 0; gi < 3; ++gi) {
                    const int sh = 2 * gi, head = gi * 8 + hh, nts = 16 >> sh, mmax = (T >> sh) - 1;
                    const float slope_d = exp2f(-8.0f * (float)(head + 1) / 24.0f) * (float)(1 << sh);
                    for (int ti = 0; ti < 2; ++ti) {
                        const int tau = wave * 2 + ti, c = tau / nts, mt = tau % nts, m0 = (t0 >> sh) + 16 * mt;
                        const size_t rowq = (size_t)b * T + (size_t)(((m0 + i16) << sh) + c);
                        pg8::bf16x8 qf0, qf1;
                        norm_frag(*(const v4u*)(PROJ + rowq * DINP + Q_OFF + head * 64 + 8 * g4), *(const v4u*)(PROJ + rowq * DINP + Q_OFF + head * 64 + 32 + 8 * g4), gq16, lane, qf0, qf1);
                        f32x4 O0 = {0.f, 0.f, 0.f, 0.f}, O1 = O0, O2 = O0, O3 = O0; float den = 0.f;
                        v4u kfr[2][2]; v4u vrow[4];
#define ATT_LOAD(kp_, KF_, VR_) do { _Pragma("unroll") for (int hf_ = 0; hf_ < 2; ++hf_) { int mkl_ = m0 - 128 + 16 * (2 * (kp_) + hf_) + i16; mkl_ = mkl_ < 0 ? 0 : (mkl_ > mmax ? mmax : mkl_); \
                                const size_t rk_ = (size_t)b * T + (size_t)((mkl_ << sh) + c); KF_[hf_][0] = *(const v4u*)(PROJ + rk_ * DINP + K_OFF + head * 64 + 8 * g4); KF_[hf_][1] = *(const v4u*)(PROJ + rk_ * DINP + K_OFF + head * 64 + 32 + 8 * g4); } \
                            _Pragma("unroll") for (int r_ = 0; r_ < 4; ++r_) { const int ci_ = lane + 64 * r_, key_ = ci_ >> 3, ch_ = ci_ & 7; int mk_ = m0 - 128 + 32 * (kp_) + key_; mk_ = mk_ < 0 ? 0 : (mk_ > mmax ? mmax : mk_); \
                                const size_t rk_ = (size_t)b * T + (size_t)((mk_ << sh) + c); VR_[r_] = *(const v4u*)(PROJ + rk_ * DINP + V_OFF + head * 64 + ch_ * 8); } } while (0)
                        ATT_LOAD(0, kfr, vrow);
#pragma unroll
                        for (int kp = 0; kp < 5; ++kp) {
                            v4u kfn[2][2]; v4u vrn[4];
                            if (kp < 4) ATT_LOAD(kp + 1, kfn, vrn);
#pragma unroll
                            for (int r = 0; r < 4; ++r) { const int ci = lane + 64 * r, key = ci >> 3, ch = ci & 7; *(LAS v4u*)(Vs + key * 160 + ch * 16) = vrow[r]; }
                            float pv[8];
#pragma unroll
                            for (int hf = 0; hf < 2; ++hf) {
                                const int kt = 2 * kp + hf;
                                if (kt == 9) { pv[4] = 0.f; pv[5] = 0.f; pv[6] = 0.f; pv[7] = 0.f; continue; }
                                f32x4 sc = {0.f, 0.f, 0.f, 0.f};
                                pg8::bf16x8 kn0, kn1; norm_frag(kfr[hf][0], kfr[hf][1], gk16, lane, kn0, kn1);
                                sc = __builtin_amdgcn_mfma_f32_16x16x32_bf16(kn0, qf0, sc, 0, 0, 0); sc = __builtin_amdgcn_mfma_f32_16x16x32_bf16(kn1, qf1, sc, 0, 0, 0);
#pragma unroll
                                for (int i = 0; i < 4; ++i) { const int n = 4 * g4 + i, diff = i16 - n + 128 - 16 * kt, mkn = m0 - 128 + 16 * kt + n;
                                    const bool valid = diff >= 0 && diff <= 128 && mkn >= 0;
                                    const float p = valid ? __expf(sc[i] * 0.125f - slope_d * (float)diff - Mref) : 0.f; den += p; pv[hf * 4 + i] = p; }
                            }
                            v4u bw; bw.x = cvt_pk_bf16(pv[0], pv[1]); bw.y = cvt_pk_bf16(pv[2], pv[3]); bw.z = cvt_pk_bf16(pv[4], pv[5]); bw.w = cvt_pk_bf16(pv[6], pv[7]);
                            const pg8::bf16x8 Bp = __builtin_bit_cast(pg8::bf16x8, bw);
                            asm volatile("s_waitcnt lgkmcnt(0)" ::: "memory");
                            const unsigned va = (unsigned)(size_t)(Vs + (4 * g4 + (i16 >> 2)) * 160 + 8 * (i16 & 3));
                            v2u l0, l1, l2, l3, h0, h1, h2, h3;
                            asm volatile("ds_read_b64_tr_b16 %0, %8\n\tds_read_b64_tr_b16 %1, %8 offset:32\n\tds_read_b64_tr_b16 %2, %8 offset:64\n\tds_read_b64_tr_b16 %3, %8 offset:96\n\t"
                                         "ds_read_b64_tr_b16 %4, %8 offset:2560\n\tds_read_b64_tr_b16 %5, %8 offset:2592\n\tds_read_b64_tr_b16 %6, %8 offset:2624\n\tds_read_b64_tr_b16 %7, %8 offset:2656\n\ts_waitcnt lgkmcnt(0)"
                                         : "=&v"(l0), "=&v"(l1), "=&v"(l2), "=&v"(l3), "=&v"(h0), "=&v"(h1), "=&v"(h2), "=&v"(h3) : "v"(va) : "memory");
                            { v4u a; a.x = l0.x; a.y = l0.y; a.z = h0.x; a.w = h0.y; O0 = __builtin_amdgcn_mfma_f32_16x16x32_bf16(__builtin_bit_cast(pg8::bf16x8, a), Bp, O0, 0, 0, 0); }
                            { v4u a; a.x = l1.x; a.y = l1.y; a.z = h1.x; a.w = h1.y; O1 = __builtin_amdgcn_mfma_f32_16x16x32_bf16(__builtin_bit_cast(pg8::bf16x8, a), Bp, O1, 0, 0, 0); }
                            { v4u a; a.x = l2.x; a.y = l2.y; a.z = h2.x; a.w = h2.y; O2 = __builtin_amdgcn_mfma_f32_16x16x32_bf16(__builtin_bit_cast(pg8::bf16x8, a), Bp, O2, 0, 0, 0); }
                            { v4u a; a.x = l3.x; a.y = l3.y; a.z = h3.x; a.w = h3.y; O3 = __builtin_amdgcn_mfma_f32_16x16x32_bf16(__builtin_bit_cast(pg8::bf16x8, a), Bp, O3, 0, 0, 0); }
                            if (kp < 4) {
#pragma unroll
                                for (int hf = 0; hf < 2; ++hf) { kfr[hf][0] = kfn[hf][0]; kfr[hf][1] = kfn[hf][1]; }
#pragma unroll
                                for (int r = 0; r < 4; ++r) vrow[r] = vrn[r];
                            }
                        }
#undef ATT_LOAD
                        den += shx(den, 16, lane); den += shx(den, 32, lane);
                        const int x = ((16 * mt + i16) << sh) + c;
                        LAS f32x4* op = (LAS f32x4*)(Ol + x * 68 + 4 * g4);
                        if (gi == 0) { op[0] = O0; op[4] = O1; op[8] = O2; op[12] = O3; if (g4 == 0) Dl[x] = den; }
                        else { op[0] = op[0] + O0; op[4] = op[4] + O1; op[8] = op[8] + O2; op[12] = op[12] + O3; if (g4 == 0) Dl[x] = Dl[x] + den; }
                    }
                    __syncthreads();
                }
                { const int x = tid >> 1, hf = tid & 1; const float rd = 1.0f / Dl[x]; const LAS f32x4* op = (const LAS f32x4*)(Ol + x * 68 + 32 * hf);
                  bf16* yo = YATT + ((size_t)b * T + t0 + x) * 1024 + hh * 64 + 32 * hf;
#pragma unroll
                  for (int q = 0; q < 4; ++q) { const f32x4 a = op[2 * q] * rd, c2 = op[2 * q + 1] * rd;
                      v4u w; w.x = cvt_pk_bf16(a[0], a[1]); w.y = cvt_pk_bf16(a[2], a[3]); w.z = cvt_pk_bf16(c2[0], c2[1]); w.w = cvt_pk_bf16(c2[2], c2[3]); *(v4u*)(yo + 8 * q) = w; } }
                __syncthreads();
            }
        }
        SEAM(pb + 4); STAMP(pb + 4);
        STAMP(pb + 5);
        if (EN(6) && IN(pb + 6)) {
            { PH_LOCALS
              pg8::Gemm g{P_LORA, (const bf16*)(ws + W_W2), M, RW, 256, 768, 256}; pg8::StaticOrder S; S.init(M, RW, G, l > 0 && G == 256 ? (bid >= 32 && bid < 160 ? bid - 32 : 1 << 20) : bid);
              EpiF<FDecay> E{FDecay{ka->in[18] + l * RW, P_DECAY}}; pg8::gemm_phase<EpiF<FDecay>, pg8::StaticOrder, true, true>(lds + RING_OFF, g, S, E, tid); }
            { PH_LOCALS
              pg8::Gemm g{P_LORA + 256, (const bf16*)(ws + W_A2), M, RW, 256, 768, 256}; pg8::StaticOrder S; S.init(M, RW, G, l > 0 && G == 256 ? (bid >= 160 ? bid - 160 : (bid >= 32 && bid < 64 ? 96 + bid - 32 : 1 << 20)) : (bid + G / 2) % G);
              EpiF<FASig> E{FASig{ka->in[20] + l * RW, P_ASIG}}; pg8::gemm_phase<EpiF<FASig>, pg8::StaticOrder, true, true>(lds + RING_OFF, g, S, E, tid); }
            { PH_LOCALS
              pg8::Gemm g{P_LORA + 512, (const bf16*)(ws + W_G2), M, RW, 256, 768, 256}; pg8::StaticOrder S; S.init(M, RW, G, l > 0 && G == 256 ? (bid >= 64 && bid < 160 ? bid - 64 : (bid >= 160 && bid < 192 ? 96 + bid - 160 : 1 << 20)) : bid);
              EpiF<FStoreBf16> E{FStoreBf16{P_GG, RW}}; pg8::gemm_phase<EpiF<FStoreBf16>, pg8::StaticOrder, true, true>(lds + RING_OFF, g, S, E, tid); }
            if (l > 0) { PH_LOCALS
              pg8::Gemm g{P_AV, (const bf16*)(ws + W_V1), M, 256, RW, RW, RW}; pg8::StaticOrder S; S.init(M, 256, G, G == 256 ? bid : (bid + G / 2) % G);
              EpiF<FStoreBf16> E{FStoreBf16{P_V1O, 256}}; pg8::gemm_phase<EpiF<FStoreBf16>, pg8::StaticOrder, true, true>(lds + RING_OFF, g, S, E, tid); }
        }
        SEAM(pb + 6); STAMP(pb + 6);
        if (EN(7) && IN(pb + 7)) {
            if (l > 0) { PH_LOCALS
              pg8::Gemm g{P_V1O, (const bf16*)(ws + W_V2), M, RW, 256, 256, 256}; pg8::StaticOrder S; S.init(M, RW, G, bid);
              EpiF<FVres> E{FVres{ka->in[28] + (size_t)(l - 1) * RW, P_VP, P_VFIRST}}; pg8::gemm_phase<EpiF<FVres>, pg8::StaticOrder, true, true>(lds + RING_OFF, g, S, E, tid); }
            { PH_LOCALS
              pg8::Gemm g{P_Z, (const bf16*)(ws + W_GLU), M, 1024, 1024, 1024, 1024}; pg8::StaticOrder S; S.init(M, 1024, G, (bid + G / 2) % G);
              EpiF<FGlu> E{FGlu{P_Z, P_YS5}}; pg8::gemm_phase<EpiF<FGlu>, pg8::StaticOrder, true, true>(lds + RING_OFF, g, S, E, tid); }
        }
        STAMP(pb + 7);
        if (EN(8) && IN(pb + 8)) {
            PH_LOCALS
            const float* DECAY = P_DECAY; const bf16* ASIG = P_ASIG; const bf16* KP = P_KP; const bf16* RP = P_RP; const bf16* VP = P_VP; const bf16* KKs = P_KK;
            unsigned char* REC = ws + WS_SBUF;
            const __amdgpu_buffer_rsrc_t rs_w = __builtin_amdgcn_make_buffer_rsrc((void*)DECAY, 0, (int)((size_t)M * RW * 4), 0x00020000), rs_a = __builtin_amdgcn_make_buffer_rsrc((void*)ASIG, 0, (int)((size_t)M * RW * 2), 0x00020000),
                rs_q = __builtin_amdgcn_make_buffer_rsrc((void*)KKs, 0, (int)((size_t)M * RW * 2), 0x00020000), rs_k = __builtin_amdgcn_make_buffer_rsrc((void*)KP, 0, (int)((size_t)M * RW * 2), 0x00020000),
                rs_r = __builtin_amdgcn_make_buffer_rsrc((void*)RP, 0, (int)((size_t)M * RW * 2), 0x00020000);
            LAS unsigned char* wl = lds + wave * 13824;
            const int c16 = lane & 15, g4 = lane >> 4;
            for (int it = gw; it < 8192; it += NGW) {
                const int h = it & 15, c = (it >> 4) & 127, b = it >> 11;
                int ln = lane; asm volatile("" : "+v"(ln));
                const size_t r0 = ((size_t)b * T + c * 16) * RW + h * 64;
                const float kac = (ka->in[24] + l * RW + h * 64)[ln];
                float at[16], rt[16]; unsigned bhp[8], khp[8];
                float Wc = 1.0f;
                {
                    float dw[16]; unsigned short da[16], dq[16], dk[16], dr[16];
#pragma unroll
                    for (int t = 0; t < 16; ++t) { const int r = (int)r0 + t * RW;
                        dw[t] = __builtin_bit_cast(float, __builtin_amdgcn_raw_buffer_load_b32(rs_w, ln * 4, r * 4, 0));
                        da[t] = __builtin_amdgcn_raw_buffer_load_b16(rs_a, ln * 2, r * 2, 0); dq[t] = __builtin_amdgcn_raw_buffer_load_b16(rs_q, ln * 2, r * 2, 0); dk[t] = __builtin_amdgcn_raw_buffer_load_b16(rs_k, ln * 2, r * 2, 0);
                        dr[t] = __builtin_amdgcn_raw_buffer_load_b16(rs_r, ln * 2, r * 2, 0); }
                    __builtin_amdgcn_sched_barrier(0);
#pragma unroll
                    for (int t = 0; t < 16; t += 2) {
                        float bh2[2], kh2[2];
#pragma unroll
                        for (int e = 0; e < 2; ++e) {
                            const float as_ = bf2f(da[t + e]), kk_ = bf2f(dq[t + e]), k_ = bf2f(dk[t + e]), r_ = bf2f(dr[t + e]);
                            const float Wp = Wc; Wc = Wc * dw[t + e]; const float inv = __builtin_amdgcn_rcpf(Wc);
                            at[t + e] = -(Wp * kk_); rt[t + e] = Wc * r_; bh2[e] = kk_ * as_ * inv; kh2[e] = k_ * (1.0f + (as_ - 1.0f) * kac) * inv;
                        }
                        bhp[t >> 1] = cvt_nat(bh2[0], bh2[1]); khp[t >> 1] = cvt_nat(kh2[0], kh2[1]);
                    }
                }
                const __amdgpu_buffer_rsrc_t rs_o = __builtin_amdgcn_make_buffer_rsrc((void*)(REC + (size_t)it * 12288), 0, 12288, 0x00020000);
                {
                    const bool sw = (ln & 8) != 0;
                    v4u lo, hi;
                    lo.x = bhp[0]; lo.y = bhp[1]; lo.z = bhp[2]; lo.w = bhp[3]; hi.x = bhp[4]; hi.y = bhp[5]; hi.z = bhp[6]; hi.w = bhp[7];
                    __builtin_amdgcn_raw_buffer_store_b128(sw ? hi : lo, rs_o, ln * 32 + 4096, 0, 0); __builtin_amdgcn_raw_buffer_store_b128(sw ? lo : hi, rs_o, ln * 32 + 4096 + 16, 0, 0);
                    lo.x = khp[0]; lo.y = khp[1]; lo.z = khp[2]; lo.w = khp[3]; hi.x = khp[4]; hi.y = khp[5]; hi.z = khp[6]; hi.w = khp[7];
                    __builtin_amdgcn_raw_buffer_store_b128(sw ? hi : lo, rs_o, ln * 32 + 6144, 0, 0); __builtin_amdgcn_raw_buffer_store_b128(sw ? lo : hi, rs_o, ln * 32 + 6144 + 16, 0, 0);
                }
                __builtin_amdgcn_raw_buffer_store_b32(__builtin_bit_cast(unsigned, Wc), rs_o, ln * 4, 11264, 0);
#pragma unroll
                for (int t = 0; t < 16; ++t) {
                    *(LAS bf16*)(wl + 0 + t * 144 + ln * 2) = (bf16)(cvt_nat(at[t], 0.f) & 0xffffu);
                    *(LAS bf16*)(wl + 2304 + t * 144 + ln * 2) = (bf16)((t & 1) ? (bhp[t >> 1] >> 16) : (bhp[t >> 1] & 0xffffu));
                    *(LAS bf16*)(wl + 4608 + t * 144 + ln * 2) = (bf16)((t & 1) ? (khp[t >> 1] >> 16) : (khp[t >> 1] & 0xffffu));
                    *(LAS bf16*)(wl + 6912 + t * 144 + ln * 2) = (bf16)(cvt_nat(rt[t], 0.f) & 0xffffu);
                }
                LDS_WAIT(); asm volatile("" ::: "memory");
                {
                    pg8::bf16x8 Aop[2], Bop[2], Kop[2], Rop[2];
#pragma unroll
                    for (int m = 0; m < 2; ++m) { const int o = c16 * 144 + 64 * m + 16 * g4;
                        Aop[m] = *(const LAS pg8::bf16x8*)(wl + 0 + o); Bop[m] = *(const LAS pg8::bf16x8*)(wl + 2304 + o); Kop[m] = *(const LAS pg8::bf16x8*)(wl + 4608 + o); Rop[m] = *(const LAS pg8::bf16x8*)(wl + 6912 + o); }
                    f32x4 nba = {0.f, 0.f, 0.f, 0.f}, nka = nba, nbr = nba, nkr = nba;
#pragma unroll
                    for (int m = 0; m < 2; ++m) {
                        nba = __builtin_amdgcn_mfma_f32_16x16x32_bf16(Aop[m], Bop[m], nba, 0, 0, 0); nka = __builtin_amdgcn_mfma_f32_16x16x32_bf16(Aop[m], Kop[m], nka, 0, 0, 0);
                        nbr = __builtin_amdgcn_mfma_f32_16x16x32_bf16(Rop[m], Bop[m], nbr, 0, 0, 0); nkr = __builtin_amdgcn_mfma_f32_16x16x32_bf16(Rop[m], Kop[m], nkr, 0, 0, 0);
                    }
#pragma unroll
                    for (int e = 0; e < 4; ++e) { const int t = 4 * g4 + e; const bool lt = c16 < t, le = c16 <= t; LAS float* np = (LAS float*)(wl + 9216) + t * 16 + c16;
                        np[0] = lt ? nba[e] : 0.f; np[256] = lt ? nka[e] : 0.f; np[512] = le ? nbr[e] : 0.f; np[768] = le ? nkr[e] : 0.f; }
                }
                LDS_WAIT(); asm volatile("" ::: "memory");
                float a2[16], a4[16];
                {
                    const LAS float* NB_ = (const LAS float*)(wl + 9216);
                    f32x4 nc[4], nn[4]; float rc = NB_[256 + c16], rn = 0.f;
#pragma unroll
                    for (int q = 0; q < 4; ++q) { nc[q] = (f32x4){0.f, 0.f, 0.f, 0.f}; nn[q] = nc[q]; }
#pragma unroll
                    for (int t = 0; t < 16; ++t) {
                        if (t < 15) { rn = NB_[256 + (t + 1) * 16 + c16];
#pragma unroll
                            for (int sq = 0; sq < (t + 4) / 4; ++sq) nn[sq] = *(const LAS f32x4*)(NB_ + (t + 1) * 16 + 4 * sq); }
                        float x1 = at[t], x2 = rc;
#pragma unroll
                        for (int sq = 0; sq < (t + 3) / 4; ++sq) {
#pragma unroll
                            for (int e = 0; e < 4; ++e) if (4 * sq + e < t) { x1 += nc[sq][e] * at[4 * sq + e]; x2 += nc[sq][e] * a2[4 * sq + e]; } }
                        asm volatile("" : "+v"(x1), "+v"(x2) :: "memory");
                        at[t] = x1; a2[t] = x2; rc = rn;
#pragma unroll
                        for (int q = 0; q < 4; ++q) nc[q] = nn[q];
                    }
                    rc = NB_[768 + c16]; nc[0] = *(const LAS f32x4*)(NB_ + 512);
#pragma unroll
                    for (int t = 0; t < 16; ++t) {
                        if (t < 15) { rn = NB_[768 + (t + 1) * 16 + c16];
#pragma unroll
                            for (int sq = 0; sq < (t + 5) / 4; ++sq) nn[sq] = *(const LAS f32x4*)(NB_ + 512 + (t + 1) * 16 + 4 * sq); }
                        float x3 = rt[t], x4 = rc;
#pragma unroll
                        for (int sq = 0; sq < (t + 4) / 4; ++sq) {
#pragma unroll
                            for (int e = 0; e < 4; ++e) if (4 * sq + e <= t) { x3 += nc[sq][e] * at[4 * sq + e]; x4 += nc[sq][e] * a2[4 * sq + e]; } }
                        asm volatile("" : "+v"(x3), "+v"(x4) :: "memory");
                        rt[t] = x3; a4[t] = x4; rc = rn;
#pragma unroll
                        for (int q = 0; q < 4; ++q) nc[q] = nn[q];
                    }
                }
                LDS_WAIT(); asm volatile("" ::: "memory");
#pragma unroll
                for (int t = 0; t < 16; ++t) { const int o = (((ln >> 3) ^ (t >> 1)) << 4) + (ln & 7) * 2;
                    __builtin_amdgcn_raw_buffer_store_b16((bf16)(cvt_nat(at[t], 0.f) & 0xffffu), rs_o, o, t * 128, 0); __builtin_amdgcn_raw_buffer_store_b16((bf16)(cvt_nat(rt[t], 0.f) & 0xffffu), rs_o, o, 2048 + t * 128, 0); }
                if (ln < 16) {
#pragma unroll
                    for (int t = 0; t < 16; ++t) { const int o = (((ln >> 2) ^ (((t >> 3) & 1) << 1)) << 3) + (ln & 3) * 2;
                        __builtin_amdgcn_raw_buffer_store_b16((bf16)(cvt_nat(a2[t], 0.f) & 0xffffu), rs_o, o, 10240 + t * 32, 0); __builtin_amdgcn_raw_buffer_store_b16((bf16)(cvt_nat(a4[t], 0.f) & 0xffffu), rs_o, o, 10752 + t * 32, 0); }
                }
            }
        }
        SEAM(pb + 8); STAMP(pb + 8);
        if (EN(9) && IN(pb + 9)) {
            PH_LOCALS
            constexpr int NB = 10, RECB = 12288, NCH = T / 16;   static_assert(NB * RECB <= LDSCTL_OFF, "chunk ring below the LDS control words");
            const unsigned char* REC = ws + WS_SBUF; bf16* YRAW = P_YRAW;
            for (int item = bid; item < 256; item += G) {
                const int bh = (item & 7) * 8 + (item >> 5), rg = (item >> 3) & 3, b = bh >> 4, h = bh & 15;
                const unsigned char* rbase = REC + ((size_t)b * NCH * 16 + h) * RECB;
                if (wave >= 2) {
                    const int lw = wave - 2;
                    const bool vw = lw == 4;
                    const unsigned char* sbase = vw ? (const unsigned char*)(P_VP + ((size_t)b * T + ((lane & 31) >> 1)) * RW + h * 64 + 16 * rg) + (lane & 1) * 16 : rbase + lw * 2048 + lane * 16;
                    const size_t cstride = vw ? (size_t)16 * RW * 2 : (size_t)16 * RECB; const int o1 = vw ? 0 : 1024;
#define RW_ISSUE(cc) do { const int cc_ = (cc); const int cs_ = cc_ < NCH ? cc_ : NCH - 1; const unsigned char* src_ = sbase + (size_t)cs_ * cstride; \
                        LAS unsigned char* dst_ = lds + (cc_ % NB) * RECB + lw * 2048; \
                        __builtin_amdgcn_global_load_lds((const unsigned*)src_, (LAS unsigned*)dst_, 16, 0, 0); __builtin_amdgcn_global_load_lds((const unsigned*)(src_ + o1), (LAS unsigned*)(dst_ + 1024), 16, 0, 0); } while (0)
#pragma unroll 1
                    for (int cc = 0; cc < NB - 2; ++cc) RW_ISSUE(cc);
#pragma unroll 1
                    for (int c = 0; c < NCH; ++c) {
                        asm volatile("s_waitcnt vmcnt(14)" ::: "memory");   static_assert(2 * (NB - 3) == 14, "counted wait");
                        __builtin_amdgcn_s_barrier();
                        RW_ISSUE(c + NB - 2);
                    }
                    asm volatile("s_waitcnt vmcnt(0)" ::: "memory");
#undef RW_ISSUE
                } else if (wave == 1) {
#pragma unroll 1
                    for (int c = 0; c < NCH; ++c) __builtin_amdgcn_s_barrier();
                } else {
                    const int c16 = lane & 15, g4 = lane >> 4, gs = g4 ^ (((c16 >> 3) & 1) << 1);
                    const int oA0 = c16 * 128 + (((0 + (g4 >> 1)) ^ (c16 >> 1)) << 4) + 8 * (g4 & 1), oA1 = c16 * 128 + (((2 + (g4 >> 1)) ^ (c16 >> 1)) << 4) + 8 * (g4 & 1);
                    const int oA2 = c16 * 128 + (((4 + (g4 >> 1)) ^ (c16 >> 1)) << 4) + 8 * (g4 & 1), oA3 = c16 * 128 + (((6 + (g4 >> 1)) ^ (c16 >> 1)) << 4) + 8 * (g4 & 1);
                    const int oBT = 4096 + c16 * 32 + gs * 8, oVT = 8192 + (4 * g4 + (c16 >> 2)) * 32 + 8 * (c16 & 3), oS2 = 10240 + c16 * 32 + gs * 8, oWL = 11264 + g4 * 16;
                    f32x4 acc0 = {0.f, 0.f, 0.f, 0.f}, acc1 = acc0, acc2 = acc0, acc3 = acc0;
                    bf16* const ybase = YRAW + ((size_t)b * T + 4 * g4) * RW + h * 64 + 16 * rg + c16;
                    struct Ops { v2u a1[4], a3[4], bt[4], kt[4], vt, a2, a4; f32x4 wl[4]; };
#define RW_LD(O_, c_) do { const LAS unsigned char* sb_ = lds + ((c_) % NB) * RECB; \
                        O_.a1[0] = *(const LAS v2u*)(sb_ + oA0); O_.a1[1] = *(const LAS v2u*)(sb_ + oA1); O_.a1[2] = *(const LAS v2u*)(sb_ + oA2); O_.a1[3] = *(const LAS v2u*)(sb_ + oA3); \
                        O_.a3[0] = *(const LAS v2u*)(sb_ + 2048 + oA0); O_.a3[1] = *(const LAS v2u*)(sb_ + 2048 + oA1); O_.a3[2] = *(const LAS v2u*)(sb_ + 2048 + oA2); O_.a3[3] = *(const LAS v2u*)(sb_ + 2048 + oA3); \
                        _Pragma("unroll") for (int jt_ = 0; jt_ < 4; ++jt_) { O_.bt[jt_] = *(const LAS v2u*)(sb_ + oBT + jt_ * 512); O_.kt[jt_] = *(const LAS v2u*)(sb_ + 2048 + oBT + jt_ * 512); O_.wl[jt_] = *(const LAS f32x4*)(sb_ + oWL + jt_ * 64); } \
                        O_.vt = __builtin_bit_cast(v2u, __builtin_amdgcn_ds_read_tr16_b64_v4i16((LAS v4s_*)(sb_ + oVT)));     O_.a2 = *(const LAS v2u*)(sb_ + oS2); O_.a4 = *(const LAS v2u*)(sb_ + 512 + oS2); } while (0)
#define RW_MK(x_, y_, z_, w_) __builtin_bit_cast(pg8::bf16x8, (v4u){(x_), (y_), (z_), (w_)})
#define RW_STEP(O_, c_) do { \
                        const pg8::bf16x8 s0_ = RW_MK(cvt_nat(acc0[0], acc0[1]), cvt_nat(acc0[2], acc0[3]), cvt_nat(acc1[0], acc1[1]), cvt_nat(acc1[2], acc1[3])); \
                        const pg8::bf16x8 s1_ = RW_MK(cvt_nat(acc2[0], acc2[1]), cvt_nat(acc2[2], acc2[3]), cvt_nat(acc3[0], acc3[1]), cvt_nat(acc3[2], acc3[3])); \
                        const pg8::bf16x8 vop_ = RW_MK(O_.vt.x, O_.vt.y, 0u, 0u); \
                        f32x4 u_ = {0.f, 0.f, 0.f, 0.f}, y_ = u_; \
                        u_ = __builtin_amdgcn_mfma_f32_16x16x32_bf16(RW_MK(O_.a1[0].x, O_.a1[0].y, O_.a1[1].x, O_.a1[1].y), s0_, u_, 0, 0, 0); \
                        u_ = __builtin_amdgcn_mfma_f32_16x16x32_bf16(RW_MK(O_.a1[2].x, O_.a1[2].y, O_.a1[3].x, O_.a1[3].y), s1_, u_, 0, 0, 0); \
                        u_ = __builtin_amdgcn_mfma_f32_16x16x32_bf16(RW_MK(O_.a2.x, O_.a2.y, 0u, 0u), vop_, u_, 0, 0, 0); \
                        y_ = __builtin_amdgcn_mfma_f32_16x16x32_bf16(RW_MK(O_.a3[0].x, O_.a3[0].y, O_.a3[1].x, O_.a3[1].y), s0_, y_, 0, 0, 0); \
                        y_ = __builtin_amdgcn_mfma_f32_16x16x32_bf16(RW_MK(O_.a3[2].x, O_.a3[2].y, O_.a3[3].x, O_.a3[3].y), s1_, y_, 0, 0, 0); \
                        y_ = __builtin_amdgcn_mfma_f32_16x16x32_bf16(RW_MK(O_.a4.x, O_.a4.y, 0u, 0u), vop_, y_, 0, 0, 0); \
                        const pg8::bf16x8 uv_ = RW_MK(cvt_nat(u_[0], u_[1]), cvt_nat(u_[2], u_[3]), O_.vt.x, O_.vt.y); \
                        acc0 = __builtin_amdgcn_mfma_f32_16x16x32_bf16(RW_MK(O_.bt[0].x, O_.bt[0].y, O_.kt[0].x, O_.kt[0].y), uv_, acc0, 0, 0, 0); \
                        acc1 = __builtin_amdgcn_mfma_f32_16x16x32_bf16(RW_MK(O_.bt[1].x, O_.bt[1].y, O_.kt[1].x, O_.kt[1].y), uv_, acc1, 0, 0, 0); \
                        acc2 = __builtin_amdgcn_mfma_f32_16x16x32_bf16(RW_MK(O_.bt[2].x, O_.bt[2].y, O_.kt[2].x, O_.kt[2].y), uv_, acc2, 0, 0, 0); \
                        acc3 = __builtin_amdgcn_mfma_f32_16x16x32_bf16(RW_MK(O_.bt[3].x, O_.bt[3].y, O_.kt[3].x, O_.kt[3].y), uv_, acc3, 0, 0, 0); \
                        acc0 *= O_.wl[0]; acc1 *= O_.wl[1]; acc2 *= O_.wl[2]; acc3 *= O_.wl[3]; \
                        bf16* yb_ = ybase + (size_t)(c_) * (16 * RW); \
                        _Pragma("unroll") for (int e_ = 0; e_ < 4; ++e_) yb_[e_ * RW] = (bf16)(cvt_nat(y_[e_], 0.f) & 0xffffu); } while (0)
                    Ops A, B;
                    asm volatile("" ::: "memory"); __builtin_amdgcn_s_barrier(); asm volatile("" ::: "memory");
                    RW_LD(A, 0);
#pragma unroll 1
                    for (int c = 0; c < NCH; c += 2) {
                        asm volatile("" ::: "memory"); __builtin_amdgcn_s_barrier(); asm volatile("" ::: "memory");
                        RW_LD(B, c + 1);
                        RW_STEP(A, c);
                        if (c + 2 < NCH) { asm volatile("" ::: "memory"); __builtin_amdgcn_s_barrier(); asm volatile("" ::: "memory"); RW_LD(A, c + 2); }
                        RW_STEP(B, c + 1);
                    }
#undef RW_LD
#undef RW_MK
#undef RW_STEP
                }
                __syncthreads();
            }
        }
        SEAM(pb + 9); STAMP(pb + 9);
        if (EN(10) && IN(pb + 10)) {
            PH_LOCALS
            const bf16* YRAW = P_YRAW; const bf16* RPp = P_RP; const bf16* KPp = P_KP; const bf16* VPp = P_VP; const bf16* GGp = P_GG; const bf16* ASIGp = P_ASIG; bf16* YRWKV = P_YRWKV;
            const int c = (gw & 3) * 256 + 4 * lane;
            const f32x4 lnw = *(const f32x4*)(ka->in[26] + l * RW + c), lnb = *(const f32x4*)(ka->in[27] + l * RW + c), rk4 = *(const f32x4*)(ka->in[25] + l * RW + c), ka4 = *(const f32x4*)(ka->in[24] + l * RW + c);
            static_assert((M * 4) % 4 == 0, "row quarters");
#pragma unroll 1
            for (int it0 = gw; it0 < M * 4; it0 += 4 * NGW) {
                v2u y4[4], r4[4], k4[4], a4_[4], v4[4], g4_[4];
#pragma unroll
                for (int u = 0; u < 4; ++u) { const int it = it0 + u * NGW; const size_t p = (size_t)(it < M * 4 ? it : it0) * 256 + 4 * lane;
                    y4[u] = *(const v2u*)(YRAW + p); r4[u] = *(const v2u*)(RPp + p); k4[u] = *(const v2u*)(KPp + p); a4_[u] = *(const v2u*)(ASIGp + p); v4[u] = *(const v2u*)(VPp + p); g4_[u] = *(const v2u*)(GGp + p); }
#pragma unroll
                for (int u = 0; u < 4; ++u) { const int it = it0 + u * NGW; if (it < M * 4) {
                    const size_t p = (size_t)it * 256 + 4 * lane;
                    const v2u y_ = y4[u], r_ = r4[u], k_ = k4[u], a_ = a4_[u], v_ = v4[u], g_ = g4_[u];
                    const f32x4 y = {bflo(y_.x), bfhi(y_.x), bflo(y_.y), bfhi(y_.y)};
                    const f32x4 r = {bflo(r_.x), bfhi(r_.x), bflo(r_.y), bfhi(r_.y)}, kp = {bflo(k_.x), bfhi(k_.x), bflo(k_.y), bfhi(k_.y)}, as = {bflo(a_.x), bfhi(a_.x), bflo(a_.y), bfhi(a_.y)},
                                v = {bflo(v_.x), bfhi(v_.x), bflo(v_.y), bfhi(v_.y)}, gg = {bflo(g_.x), bfhi(g_.x), bflo(g_.y), bfhi(g_.y)};
                    const float mean = row16_sum((y[0] + y[1]) + (y[2] + y[3])) * (1.0f / 64);
                    const f32x4 d = y - mean;
                    const float var = row16_sum((d[0] * d[0] + d[1] * d[1]) + (d[2] * d[2] + d[3] * d[3])) * (1.0f / 64);
                    const float rs = rsqrtf(var + 64e-5f);
                    const f32x4 kf = kp * (1.0f + (as - 1.0f) * ka4);
                    const f32x4 t = r * kf * rk4;
                    const float rk = row16_sum((t[0] + t[1]) + (t[2] + t[3]));
                    const f32x4 o = ((d * rs) * lnw + lnb + rk * v) * gg;
                    v2u w; w.x = cvt_pk_bf16(o[0], o[1]); w.y = cvt_pk_bf16(o[2], o[3]);
                    *(v2u*)(YRWKV + p) = w; } }
            }
        }
        SEAM(pb + 10); STAMP(pb + 10);
        if (EN(11) && IN(pb + 11)) {
            PH_LOCALS
            pg8::Gemm g{P_YS5, (const bf16*)(ws + W_BS5), M, D, 1024, 1024, 1024};
            pg8::Seg3Order S; S.init(M, D, G, bid);
            S.A0 = P_YS5; S.B0 = (const bf16*)(ws + W_BS5); S.dA1 = (long)WS_MERGED - (long)WS_YS5; S.dA2 = (long)WS_YRWKV - (long)WS_YS5; S.dB1 = (long)W_BAT2 - (long)W_BS5; S.dB2 = (long)W_BRW - (long)W_BS5;
            S.K0 = 1024; S.K1 = 512; S.K2 = 1024;
            EpiBranch3 E{P_PROJ, P_MERGEDB};
            pg8::gemm_phase<EpiBranch3, pg8::Seg3Order, true, true>(lds + RING_OFF, g, S, E, tid);
        }
        SEAM(pb + 11); STAMP(pb + 11);
        if (EN(12) && IN(pb + 12)) {
            PH_LOCALS
            pg8::Gemm g{P_MERGEDB, (const bf16*)(ws + W_OUT), M, D, D, D, D}; pg8::StaticOrder S; S.init(M, D, G, bid);
            EpiResid E{nullptr, nullptr, P_XB, P_XL, P_SS + (size_t)(3 * l + 2) * M * 32, 1.0f, 1.0f, 0.0f};
            pg8::gemm_phase<EpiResid, pg8::StaticOrder, true, true>(lds + RING_OFF, g, S, E, tid);
        }
        SEAM(pb + 12); STAMP(pb + 12);
        if (EN(13) && IN(pb + 13)) {
            PH_LOCALS
            pg8::Gemm g{P_XB, (const bf16*)(ws + W_UP2), M, NUP, D, D, D}; pg8::StaticOrder S; S.init(M, NUP, G, bid);
            EpiSwiGLU E{P_HID, P_SS + (size_t)(3 * l + 2) * M * 32};
            pg8::gemm_phase<EpiSwiGLU, pg8::StaticOrder, true, true>(lds + RING_OFF, g, S, E, tid);
        }
        SEAM(pb + 13); STAMP(pb + 13);
        if (EN(14) && IN(pb + 14)) {
            PH_LOCALS
            pg8::Gemm g{P_HID, (const bf16*)(ws + W_DN2), M, D, DFF, DFF, DFF}; pg8::StaticOrder S; S.init(M, D, G, bid);
            float psc = 1.0f, psp = 0.0f;
            if (PROBE_ON && l == DEPTH - 1) { const unsigned* a_ = (const unsigned*)(ws + WS_CTL + 128 * 1024); if (PROBE_A >= 0) psc = 1.0f + 1e-5f * (float)a_[PROBE_A >= 0 ? PROBE_A : 0]; if (PROBE_B >= 0) psp = 1e-4f * (float)a_[PROBE_B >= 0 ? PROBE_B : 0]; }
            EpiResid E{nullptr, l == DEPTH - 1 ? ka->out : nullptr, P_XB, P_XL, P_SS + (size_t)(3 * l + 3) * M * 32, 0.5f, psc, psp};
            pg8::gemm_phase<EpiResid, pg8::StaticOrder, true, true>(lds + RING_OFF, g, S, E, tid);
        }
        SEAM(pb + 14); STAMP(pb + 14);
    }
#undef IN
#undef SEAM
}

extern "C" void kernel_launch(void* const* d_in, const int* in_sizes, int n_in, void* d_out, int out_size, void* d_ws, size_t ws_size, hipStream_t stream) {
    static int grid = 0;
    if (grid == 0) {
        if (n_in != 38 || in_sizes[0] != M * D || out_size != M * D || ws_size < WS_END) {
            fprintf(stderr, "kernel_launch: unexpected shapes/workspace (n_in %d, in0 %d, out %d, ws %zu, need %zu); nothing launched\n", n_in, n_in > 0 ? in_sizes[0] : -1, out_size, ws_size, (size_t)WS_END); grid = -1; return; }
        int dev = 0, cus = 0, per_cu = 0;
        if (hipGetDevice(&dev) != hipSuccess || hipDeviceGetAttribute(&cus, hipDeviceAttributeMultiprocessorCount, dev) != hipSuccess) { grid = -1; return; }
        if (hipFuncSetAttribute((const void*)mk_fwd, hipFuncAttributeMaxDynamicSharedMemorySize, LDS_BYTES) != hipSuccess) { fprintf(stderr, "kernel_launch: hipFuncSetAttribute failed\n"); grid = -1; return; }
        if (hipOccupancyMaxActiveBlocksPerMultiprocessor(&per_cu, (const void*)mk_fwd, NWAVES * 64, LDS_BYTES) != hipSuccess || per_cu < 1)
            fprintf(stderr, "kernel_launch: note: occupancy query reports %d workgroups per CU\n", per_cu);
        (void)hipGetLastError();
        grid = cus;
    }
    if (grid < 0) return;
    if (hipMemsetAsync((char*)d_ws + WS_CTL, 0, CTL_ZERO_BYTES, stream) != hipSuccess) { fprintf(stderr, "kernel_launch: memset failed\n"); return; }
#ifdef DBG_ZERO_WS
    (void)hipMemsetAsync((char*)d_ws + CTL_ZERO_BYTES, 0, WS_END - CTL_ZERO_BYTES, stream);
#endif
    Args a{};
    for (int i = 0; i < 38; ++i) a.in[i] = (const float*)d_in[i];
    a.out = (float*)d_out; a.ws = (unsigned char*)d_ws; a.pad = 0;
#if MK_ONE_LAUNCH
    a.ph_lo = 0; a.ph_hi = NPHASES; a.use_bar = 1;
    hipLaunchKernelGGL(mk_fwd, dim3(grid), dim3(NWAVES * 64), LDS_BYTES, stream, a);
#else
    for (int ph = 0; ph < NPHASES; ++ph) {
        a.ph_lo = ph; a.ph_hi = ph + 1; a.use_bar = 0;
        hipLaunchKernelGGL(mk_fwd, dim3(grid), dim3(NWAVES * 64), LDS_BYTES, stream, a);
    }
#endif
    const hipError_t le = hipPeekAtLastError();
    if (le != hipSuccess) fprintf(stderr, "kernel_launch: launch failed: %s\n", hipGetErrorName(le));
}
```

```cpp
#include <hip/hip_runtime.h>
#include <cstdio>
#include <cstdint>

#ifndef PROBE_A
#define PROBE_A -1
#endif
#ifndef PROBE_B
#define PROBE_B -1
#endif
#define PROBE_ON (PROBE_A >= 0 || PROBE_B >= 0)
#ifndef MK_ONE_LAUNCH
#define MK_ONE_LAUNCH 1
#endif

namespace pg8 {
#define PG8_LAS __attribute__((address_space(3)))
typedef unsigned short bf16_t;
typedef short bf16x8 __attribute__((ext_vector_type(8)));
typedef float f32x4 __attribute__((ext_vector_type(4)));
typedef unsigned u32x4 __attribute__((ext_vector_type(4)));
constexpr int BM = 256, BK = 64, HALF = 128, HTB = HALF * BK * 2, STAGE_BYTES = 8 * HTB, NXCD = 8, WGM = 8;

__host__ __device__ __forceinline__ int lds_byte(int r, int c) { const int st = (r >> 4) * 2 + (c >> 5), rr = r & 15, cc = c & 31, ob = rr * 64 + cc * 2; return st * 1024 + (ob ^ (((ob >> 9) & 1) << 5)); }
__host__ __device__ __forceinline__ void stage_rc(int b, int& R, int& C) { const int st = b / 1024, sb = b % 1024, swz = sb ^ (((sb >> 9) & 1) << 5); R = (st >> 1) * 16 + swz / 64; C = (st & 1) * 32 + (swz % 64) / 2; }
__host__ __device__ __forceinline__ int perm32(int rho) { const int n = rho >> 4, i = rho & 15; return 8 * (i >> 2) + 4 * n + (i & 3); }

struct Unit { int pm, pn, seg; };
struct Gemm { const bf16_t* A; const bf16_t* Bt; int M, N, K, lda, ldb; };

struct StaticOrder {
    int nM, nN, nwg, G, c;
    __host__ __device__ void init(int M, int N, int G_, int c_) { nM = M / BM; nN = N / BM; nwg = nM * nN; G = G_; c = c_; }
    __host__ __device__ bool next(int i, Unit& u) const {
        const long L = (long)i * G + c; if (L >= nwg) return false;
        int wgid = (int)L; { const int q = nwg / NXCD, r = nwg % NXCD, xcd = wgid % NXCD, off = wgid / NXCD; wgid = (xcd < r ? xcd * (q + 1) : r * (q + 1) + (xcd - r) * q) + off; }
        const int nig = WGM * nN, gid = wgid / nig, fm = gid * WGM, gsz = (nM - fm) < WGM ? (nM - fm) : WGM;
        u.pm = fm + ((wgid % nig) % gsz); u.pn = (wgid % nig) / gsz; u.seg = 0; return true;
    }
    __device__ __forceinline__ void a_ready(const Unit&) const {}
    __device__ __forceinline__ void done(const Unit&) const {}
    __device__ __forceinline__ const char* a_base(const Gemm& g, const Unit& u, size_t tstepA) const { return (const char*)g.A + (size_t)u.pm * tstepA; }
    __device__ __forceinline__ const char* b_base(const Gemm& g, const Unit& u, size_t tstepB) const { return (const char*)g.Bt + (size_t)u.pn * tstepB; }
    __device__ __forceinline__ int ktiles(const Gemm& g, const Unit&) const { return g.K / BK; }
};
struct Seg3Order : StaticOrder {
    const bf16_t *A0, *B0; long dA1, dA2, dB1, dB2; int K0, K1, K2;
    __host__ __device__ bool next(int i, Unit& u) const { const bool ok = StaticOrder::next(i / 3, u); u.seg = i % 3; return ok; }
    __device__ __forceinline__ const char* a_base(const Gemm&, const Unit& u, size_t tstepA) const { long d1 = dA1, d2 = dA2; asm volatile("" : "+s"(d1), "+s"(d2)); const long d = u.seg == 1 ? d1 : (u.seg == 2 ? d2 : 0); return (const char*)A0 + d + (size_t)u.pm * tstepA; }
    __device__ __forceinline__ const char* b_base(const Gemm&, const Unit& u, size_t tstepB) const { long d1 = dB1, d2 = dB2; asm volatile("" : "+s"(d1), "+s"(d2)); const long d = u.seg == 1 ? d1 : (u.seg == 2 ? d2 : 0); return (const char*)B0 + d + (size_t)u.pn * tstepB; }
    __device__ __forceinline__ int ktiles(const Gemm&, const Unit& u) const { int k0 = K0, k1 = K1, k2 = K2; asm volatile("" : "+s"(k0), "+s"(k1), "+s"(k2)); return (u.seg == 1 ? k1 : (u.seg == 2 ? k2 : k0)) / BK; }
};

__device__ __forceinline__ unsigned cvt_pk_bf16(float lo, float hi) { unsigned r; asm volatile("v_cvt_pk_bf16_f32 %0, %1, %2" : "=v"(r) : "v"(lo), "v"(hi)); return r; }

template <class Epi, class Sched, bool ALIGN_EPI = false, bool SP2 = false>
__device__ __forceinline__ void gemm_phase(PG8_LAS unsigned char* lds, const Gemm g, const Sched& S, const Epi& E, int tid_) {
    asm volatile("" : "+v"(tid_));
    const int tid = tid_, wid = __builtin_amdgcn_readfirstlane(tid >> 6), lane = tid & 63, wr = wid >> 2, wc = wid & 3, fr = lane & 15, fq = lane >> 4;
    unsigned voffA[2], voffB[2];
#pragma unroll
    for (int i = 0; i < 2; ++i) { int R, C; stage_rc(tid * 16 + i * 8192, R, C); const int Rb = Epi::PERM ? ((R & ~31) + perm32(R & 31)) : R;
        voffA[i] = (unsigned)(R * g.lda + C) * 2u; voffB[i] = (unsigned)(Rb * g.ldb + C) * 2u; }
    const size_t kstep = (size_t)(BK * 2);
    const size_t hstepA = (size_t)HALF * g.lda * 2, hstepB = (size_t)HALF * g.ldb * 2;
    const size_t tstepA = 2 * hstepA, tstepB = 2 * hstepB;
    const unsigned ldsw = (unsigned)wid * 1024u;
    const int aoff = lds_byte(wr * 64 + fr, fq * 8), boff = lds_byte(wc * 32 + fr, fq * 8);
#define PG8_SA(b, h) (((b) * 2 + (h)) * HTB)
#define PG8_SB(b, h) ((4 + (b) * 2 + (h)) * HTB)
#define PG8_STAGE(bufoff, gbase, voff) do { _Pragma("unroll") for (int _i = 0; _i < 2; ++_i) \
        __builtin_amdgcn_global_load_lds((const unsigned*)((const char*)(gbase) + (voff)[_i]), (PG8_LAS unsigned*)(lds + (bufoff) + ldsw + _i * 8192), 16, 0, 0); } while (0)
#define PG8_LDA(dst, b, h) do { _Pragma("unroll") for (int m = 0; m < 4; ++m) _Pragma("unroll") for (int k = 0; k < 2; ++k) dst[m][k] = *(const PG8_LAS bf16x8*)(lds + PG8_SA(b, h) + aoff + m * 2048 + k * 1024); } while (0)
#define PG8_LDB(dst, b, h) do { _Pragma("unroll") for (int n = 0; n < 2; ++n) _Pragma("unroll") for (int k = 0; k < 2; ++k) dst[n][k] = *(const PG8_LAS bf16x8*)(lds + PG8_SB(b, h) + boff + n * 2048 + k * 1024); } while (0)
#define PG8_MMA(ai, bj, At, Bt) do { __builtin_amdgcn_s_setprio(1); _Pragma("unroll") for (int m = 0; m < 4; ++m) _Pragma("unroll") for (int n = 0; n < 2; ++n) _Pragma("unroll") for (int k = 0; k < 2; ++k) \
        acc[ai][bj][m][n] = __builtin_amdgcn_mfma_f32_16x16x32_bf16(Bt[n][k], At[m][k], acc[ai][bj][m][n], 0, 0, 0); __builtin_amdgcn_s_setprio(0); } while (0)
#define PG8_WAIT_V(n) asm volatile("s_waitcnt vmcnt(" #n ")" ::: "memory")
#define PG8_WAIT_L(n) asm volatile("s_waitcnt lgkmcnt(" #n ")" ::: "memory")
#define PG8_BAR __builtin_amdgcn_s_barrier()
#define PG8_SCHED __builtin_amdgcn_sched_barrier(0)
    Unit cur, nxt; int ui = 0;
    if (!S.next(0, cur)) return;
    f32x4 acc[2][2][4][2];
#pragma unroll
    for (int a = 0; a < 2; ++a)
#pragma unroll
        for (int b = 0; b < 2; ++b)
#pragma unroll
            for (int m = 0; m < 4; ++m)
#pragma unroll
                for (int n = 0; n < 2; ++n) acc[a][b][m][n] = (f32x4){0.f, 0.f, 0.f, 0.f};
    bf16x8 At[4][2], B0[2][2], B1[2][2];
    const char* cA = S.a_base(g, cur, tstepA); const char* cB = S.b_base(g, cur, tstepB);
    S.a_ready(cur);
    if constexpr (SP2) {
        PG8_STAGE(PG8_SB(0, 0), cB, voffB); PG8_STAGE(PG8_SB(0, 1), cB + hstepB, voffB); PG8_STAGE(PG8_SA(0, 0), cA, voffA); PG8_STAGE(PG8_SA(0, 1), cA + hstepA, voffA);
        if (wr == 1) PG8_BAR;
        PG8_WAIT_V(2); PG8_BAR;
        PG8_STAGE(PG8_SB(1, 0), cB + kstep, voffB); PG8_STAGE(PG8_SA(1, 0), cA + kstep, voffA); PG8_STAGE(PG8_SB(1, 1), cB + hstepB + kstep, voffB);
        PG8_WAIT_V(6); PG8_BAR;
    } else {
        PG8_STAGE(PG8_SB(0, 0), cB, voffB); PG8_STAGE(PG8_SA(0, 0), cA, voffA); PG8_STAGE(PG8_SB(0, 1), cB + hstepB, voffB); PG8_STAGE(PG8_SA(0, 1), cA + hstepA, voffA);
        if (wr == 1) PG8_BAR;
        PG8_WAIT_V(4); PG8_BAR;
        PG8_STAGE(PG8_SB(1, 0), cB + kstep, voffB); PG8_STAGE(PG8_SA(1, 0), cA + kstep, voffA); PG8_STAGE(PG8_SB(1, 1), cB + hstepB + kstep, voffB);
        PG8_WAIT_V(6); PG8_BAR;
    }
    for (;;) {
        const bool has_next = S.next(ui + 1, nxt);
        const char* nA = has_next ? S.a_base(g, nxt, tstepA) : cA; const char* nB = has_next ? S.b_base(g, nxt, tstepB) : cB;
        const int nt = S.ktiles(g, cur);
        for (int t = 0; t < nt; t += 2) {
            const bool last = (t == nt - 2);
            const char* a1 = cA + (size_t)(t + 1) * kstep;
            const char* a2 = last ? nA : cA + (size_t)(t + 2) * kstep; const char* b2 = last ? nB : cB + (size_t)(t + 2) * kstep;
            const char* a3 = a2 + kstep; const char* b3 = b2 + kstep;
            if (last && has_next) S.a_ready(nxt);
            if constexpr (SP2) {
            PG8_LDB(B0, 0, 0); PG8_LDB(B1, 0, 1); PG8_SCHED; PG8_LDA(At, 0, 0); PG8_STAGE(PG8_SA(1, 1), a1 + hstepA, voffA);
            PG8_WAIT_V(8); PG8_WAIT_L(0); PG8_BAR; PG8_MMA(0, 0, At, B0); PG8_MMA(0, 1, At, B1); PG8_BAR; PG8_SCHED;
            PG8_LDA(At, 0, 1); PG8_STAGE(PG8_SB(0, 0), b2, voffB); PG8_STAGE(PG8_SB(0, 1), b2 + hstepB, voffB); PG8_STAGE(PG8_SA(0, 0), a2, voffA);
            PG8_WAIT_V(8); PG8_WAIT_L(0); PG8_BAR; PG8_MMA(1, 0, At, B0); PG8_MMA(1, 1, At, B1); PG8_BAR; PG8_SCHED;
            PG8_LDB(B0, 1, 0); PG8_LDB(B1, 1, 1); PG8_SCHED; PG8_LDA(At, 1, 0); PG8_STAGE(PG8_SA(0, 1), a2 + hstepA, voffA);
            PG8_WAIT_V(8); PG8_WAIT_L(0); PG8_BAR; PG8_MMA(0, 0, At, B0); PG8_MMA(0, 1, At, B1); PG8_BAR; PG8_SCHED;
            PG8_LDA(At, 1, 1); PG8_STAGE(PG8_SB(1, 0), b3, voffB); PG8_STAGE(PG8_SB(1, 1), b3 + hstepB, voffB); PG8_STAGE(PG8_SA(1, 0), a3, voffA);
            PG8_WAIT_V(8); PG8_WAIT_L(0); PG8_BAR; PG8_MMA(1, 0, At, B0); PG8_MMA(1, 1, At, B1); PG8_BAR; PG8_SCHED;
            } else {
            PG8_LDB(B0, 0, 0); PG8_SCHED; PG8_LDA(At, 0, 0); PG8_STAGE(PG8_SA(1, 1), a1 + hstepA, voffA);
            PG8_WAIT_L(8); PG8_BAR; PG8_WAIT_L(0); PG8_MMA(0, 0, At, B0); PG8_BAR; PG8_SCHED;
            PG8_LDB(B1, 0, 1); PG8_STAGE(PG8_SB(0, 0), b2, voffB);
            PG8_BAR; PG8_WAIT_L(0); PG8_MMA(0, 1, At, B1); PG8_BAR;
            PG8_LDA(At, 0, 1); PG8_STAGE(PG8_SA(0, 0), a2, voffA);
            PG8_BAR; PG8_WAIT_L(0); PG8_MMA(1, 0, At, B0); PG8_BAR; PG8_SCHED;
            PG8_STAGE(PG8_SB(0, 1), b2 + hstepB, voffB);
            PG8_WAIT_V(6); PG8_BAR; PG8_MMA(1, 1, At, B1); PG8_BAR;
            PG8_LDB(B0, 1, 0); PG8_SCHED; PG8_LDA(At, 1, 0); PG8_STAGE(PG8_SA(0, 1), a2 + hstepA, voffA);
            PG8_WAIT_L(8); PG8_BAR; PG8_WAIT_L(0); PG8_MMA(0, 0, At, B0); PG8_BAR; PG8_SCHED;
            PG8_LDB(B1, 1, 1); PG8_STAGE(PG8_SB(1, 0), b3, voffB);
            PG8_BAR; PG8_WAIT_L(0); PG8_MMA(0, 1, At, B1); PG8_BAR;
            PG8_LDA(At, 1, 1); PG8_STAGE(PG8_SA(1, 0), a3, voffA);
            PG8_BAR; PG8_WAIT_L(0); PG8_MMA(1, 0, At, B0); PG8_BAR; PG8_SCHED;
            PG8_STAGE(PG8_SB(1, 1), b3 + hstepB, voffB);
            PG8_WAIT_V(6); PG8_BAR; PG8_MMA(1, 1, At, B1); PG8_BAR;
            }
        }
        if constexpr (ALIGN_EPI) { if (wr == 0) PG8_BAR; }
        E(acc, cur, wr, wc, fr, fq); S.done(cur);
        if (!has_next) break;
        if (!(Epi::KEEP && E.keep(cur))) {
#pragma unroll
        for (int a = 0; a < 2; ++a)
#pragma unroll
            for (int b = 0; b < 2; ++b)
#pragma unroll
                for (int m = 0; m < 4; ++m)
#pragma unroll
                    for (int n = 0; n < 2; ++n) acc[a][b][m][n] = (f32x4){0.f, 0.f, 0.f, 0.f};
        }
        cur = nxt; cA = nA; cB = nB; ++ui;
        if constexpr (ALIGN_EPI) { if (wr == 1) PG8_BAR; }
    }
    PG8_WAIT_V(0);
    if constexpr (!ALIGN_EPI) { if (wr == 0) PG8_BAR; }
    PG8_BAR;
#undef PG8_SA
#undef PG8_SB
#undef PG8_STAGE
#undef PG8_LDA
#undef PG8_LDB
#undef PG8_MMA
#undef PG8_WAIT_V
#undef PG8_WAIT_L
#undef PG8_BAR
#undef PG8_SCHED
}
}

constexpr int NWAVES = 8;
constexpr int M = 8192, T = 2048, D = 2048, DFF = 5504, NUP = 2 * DFF, DIN = 15296, DINP = 15360, DEPTH = 4;
constexpr int U_OFF = 0, Q_OFF = 1024, K_OFF = 2560, V_OFF = 4096, RW_OFF = 5632, GATE_OFF = 9152;
constexpr int RWP = 3520, RW = 1024, AW = 1536;
constexpr float RMS_EPS = 1e-6f;
constexpr int NPH = 15;
constexpr int NPHASES = 1 + DEPTH * NPH;

constexpr size_t MiB = 1u << 20;
constexpr size_t WS_CTL = 0, CTL_ZERO_BYTES = 1 * MiB;
constexpr int CW_BAR = 4096;
constexpr size_t SS_OFF = 256 * 1024;
constexpr size_t WS_X = 1 * MiB;
constexpr size_t WS_XB = WS_X + 64 * MiB;
constexpr size_t WS_HID = WS_XB + 32 * MiB;
constexpr size_t WS_PROJ = WS_HID + 86 * MiB;
constexpr size_t WS_W = WS_PROJ + 240 * MiB;
constexpr size_t W_UP1 = WS_W, W_DN1 = W_UP1 + 43 * MiB, W_IN = W_DN1 + 22 * MiB, W_GLU = W_IN + 60 * MiB, W_W2 = W_GLU + 2 * MiB, W_A2 = W_W2 + MiB / 2,
                 W_G2 = W_A2 + MiB / 2, W_V1 = W_G2 + MiB / 2, W_V2 = W_V1 + MiB / 2, W_BS5 = W_V2 + MiB / 2, W_BAT = W_BS5 + 4 * MiB, W_BRW = W_BAT + 2 * MiB,
                 W_OUT = W_BRW + 4 * MiB, W_UP2 = W_OUT + 8 * MiB, W_DN2 = W_UP2 + 43 * MiB, W_BAT2 = W_DN2 + 22 * MiB, WS_WEND = W_BAT2 + 4 * MiB;
constexpr size_t WS_RP = WS_WEND, WS_KP = WS_RP + 32 * MiB, WS_VP = WS_KP + 32 * MiB, WS_DECAY = WS_VP + 32 * MiB, WS_ASIG = WS_DECAY + 32 * MiB, WS_G = WS_ASIG + 32 * MiB,
                 WS_KK = WS_G + 32 * MiB, WS_VFIRST = WS_KK + 32 * MiB, WS_YRAW = WS_VFIRST + 32 * MiB;
constexpr size_t WS_LORA = WS_YRAW + 32 * MiB;
constexpr size_t WS_AV = WS_LORA + 12 * MiB;
constexpr size_t WS_V1O = WS_AV + 16 * MiB;
constexpr size_t WS_QN = WS_V1O + 4 * MiB, WS_KN = WS_QN + 24 * MiB;
constexpr size_t WS_Z = WS_KN + 24 * MiB, WS_YS5 = WS_Z + 16 * MiB, WS_YATT = WS_YS5 + 16 * MiB, WS_YRWKV = WS_YATT + 8 * MiB;
constexpr size_t WS_MERGED = WS_YRWKV + 16 * MiB, WS_MERGEDB = WS_MERGED + 64 * MiB;
constexpr size_t WS_SBUF = WS_MERGEDB + 32 * MiB;
constexpr size_t WS_SSP = WS_SBUF + 256 * MiB;
constexpr size_t WS_END = WS_SSP + 16 * MiB;

constexpr int RING_OFF = 0, RING_BYTES = 131072, LDSCTL_OFF = 143360, LDS_BYTES = 147456;

#define GAS __attribute__((address_space(1)))
#define LAS __attribute__((address_space(3)))
typedef unsigned short bf16;
typedef unsigned v4u __attribute__((ext_vector_type(4)));
typedef unsigned v2u __attribute__((ext_vector_type(2)));
typedef float f32x4 __attribute__((ext_vector_type(4)));
typedef float f32x2 __attribute__((ext_vector_type(2)));
typedef short v4s_ __attribute__((ext_vector_type(4)));
#define LDS_WAIT() asm volatile("s_waitcnt lgkmcnt(0)" ::: "memory")
#define VM_WAIT() asm volatile("s_waitcnt vmcnt(0)" ::: "memory")
__device__ __forceinline__ unsigned f2bf(float f) { unsigned u = __builtin_bit_cast(unsigned, f); return (u + 0x7fffu + ((u >> 16) & 1u)) >> 16; }
__device__ __forceinline__ unsigned pk2(float lo, float hi) { return f2bf(lo) | (f2bf(hi) << 16); }
typedef __bf16 bf16n2 __attribute__((ext_vector_type(2)));
__device__ __forceinline__ unsigned cvt_nat(float lo, float hi) { const f32x2 v = {lo, hi}; return __builtin_bit_cast(unsigned, __builtin_convertvector(v, bf16n2)); }
__device__ __forceinline__ float bf2f(unsigned short b) { return __builtin_bit_cast(float, (unsigned)b << 16); }
__device__ __forceinline__ float bflo(unsigned w) { return __builtin_bit_cast(float, w << 16); }
__device__ __forceinline__ float bfhi(unsigned w) { return __builtin_bit_cast(float, w & 0xffff0000u); }
__device__ __forceinline__ float shx(float v, int o, int lane) { return __builtin_bit_cast(float, __builtin_amdgcn_ds_bpermute((lane ^ o) << 2, __builtin_bit_cast(int, v))); }
__device__ __forceinline__ float wave_sum(float v, int lane) {
#pragma unroll
    for (int o = 32; o >= 1; o >>= 1) v += shx(v, o, lane);
    return v;
}
__device__ __forceinline__ float row16_sum(float v) {
    v += __builtin_bit_cast(float, __builtin_amdgcn_update_dpp(0, __builtin_bit_cast(int, v), 0x128, 0xf, 0xf, false));
    v += __builtin_bit_cast(float, __builtin_amdgcn_update_dpp(0, __builtin_bit_cast(int, v), 0x124, 0xf, 0xf, false));
    v += __builtin_bit_cast(float, __builtin_amdgcn_update_dpp(0, __builtin_bit_cast(int, v), 0x122, 0xf, 0xf, false));
    v += __builtin_bit_cast(float, __builtin_amdgcn_update_dpp(0, __builtin_bit_cast(int, v), 0x121, 0xf, 0xf, false));
    return v;
}
__device__ __forceinline__ float sigmoidf_(float x) { return 1.0f / (1.0f + __expf(-x)); }

#define XB_TMO      128
#define XB_XCNT(j)  (256  + 64 * (j))
#define XB_XSUB(j)  (1280 + 64 * (j))
#define XB_XGEN(j)  (2304 + 64 * (j))
#define XB_TOP      3328
#define XB_TOPGEN   3392
#define XCD_BAR_WORDS 3456
#define XB_SPIN_CAP (1u << 18)
__device__ __forceinline__ unsigned xb_ld(unsigned* p)              { return __hip_atomic_load(p, __ATOMIC_RELAXED, __HIP_MEMORY_SCOPE_AGENT); }
__device__ __forceinline__ unsigned xb_add(unsigned* p, unsigned v) { return __hip_atomic_fetch_add(p, v, __ATOMIC_RELAXED, __HIP_MEMORY_SCOPE_AGENT); }
__device__ __forceinline__ unsigned xb_xcc_id() { return (unsigned)__builtin_amdgcn_s_getreg((3 << 11) | 20) & 0xFu; }
#define XB_SPIN(cond, bar) do { unsigned _sp = 0; while (cond) { __builtin_amdgcn_s_sleep(1); \
    if ((++_sp & 255u) == 0u) { if (xb_ld(&(bar)[XB_TMO])) break; if (_sp > XB_SPIN_CAP) { atomicAdd(&(bar)[XB_TMO], 1u); break; } } } } while (0)
struct XcdBarrier { unsigned* bar; unsigned x; volatile LAS unsigned* st; };
__device__ __forceinline__ XcdBarrier xcd_barrier_post(unsigned* bar, volatile LAS unsigned* st) {
    XcdBarrier b; b.bar = bar; b.x = xb_xcc_id(); b.st = st;
    if (threadIdx.x == 0) (void)xb_add(&bar[XB_XCNT(b.x)], 1u);
    return b;
}
__device__ __forceinline__ void xcd_barrier_complete(unsigned* bar, unsigned x, unsigned& nloc, unsigned& nx) {
    const unsigned G = gridDim.x * gridDim.y * gridDim.z;
    unsigned sum, cnt, mine, sp = 0u;
    for (;;) {
        sum = 0u; cnt = 0u; mine = 0u;
#pragma unroll
        for (unsigned j = 0; j < 16; ++j) { const unsigned c = xb_ld(&bar[XB_XCNT(j)]); sum += c; cnt += (c > 0u) ? 1u : 0u; mine = (j == x) ? c : mine; }
        if (sum == G) break;
        __builtin_amdgcn_s_sleep(1);
        if ((++sp & 255u) == 0u) { if (xb_ld(&bar[XB_TMO])) break; if (sp > XB_SPIN_CAP) { atomicAdd(&bar[XB_TMO], 1u); break; } }
    }
    nloc = mine > 0u ? mine : 1u; nx = cnt > 0u ? cnt : 1u;
}
__device__ __forceinline__ void xcd_barrier(const XcdBarrier& b) {
    asm volatile("s_waitcnt vmcnt(0)" ::: "memory");
    __syncthreads();
    if (threadIdx.x == 0) {
        unsigned* bar = b.bar;
        __builtin_amdgcn_s_waitcnt(0);
        unsigned nloc = b.st[0], nx = b.st[1];
        if (nloc == 0u) { xcd_barrier_complete(bar, b.x, nloc, nx); b.st[0] = nloc; b.st[1] = nx; }
        const unsigned old = xb_add(&bar[XB_XSUB(b.x)], 1u);
        const unsigned gen = old / nloc;
        if (old + 1u == (gen + 1u) * nloc) {
            __builtin_amdgcn_fence(__ATOMIC_RELEASE, "agent");
            asm volatile("s_waitcnt vmcnt(0)" ::: "memory");
            const unsigned og = xb_add(&bar[XB_TOP], 1u);
            const unsigned tg = og / nx;
            if (og + 1u == (tg + 1u) * nx) {
#pragma unroll
                for (unsigned j = 0; j < 16; ++j) (void)xb_add(&bar[XB_XGEN(j)], 1u);
            }
        }
        XB_SPIN(xb_ld(&bar[XB_XGEN(b.x)]) == gen, bar);
        __builtin_amdgcn_fence(__ATOMIC_ACQUIRE, "agent");
        asm volatile("s_waitcnt vmcnt(0)" ::: "memory");
    }
    __syncthreads();
}

using pg8::Unit; using pg8::cvt_pk_bf16;
__device__ __forceinline__ int fresh_lane() { int l; asm volatile("v_mbcnt_lo_u32_b32 %0, -1, 0\n\tv_mbcnt_hi_u32_b32 %0, -1, %0" : "=v"(l)); return l; }
typedef const f32x4 (&AccRef)[2][2][4][2];

__device__ __forceinline__ float row_rstd(const float* ssp, int row) {
    const f32x4* p = (const f32x4*)(ssp + (size_t)row * 32); float s = 0.f;
#pragma unroll
    for (int j = 0; j < 8; ++j) { const f32x4 v = p[j]; s += (v.x + v.y) + (v.z + v.w); }
    return rsqrtf(s * (1.0f / D) + RMS_EPS);
}
__device__ __forceinline__ void rows_rstd(const float* ssp, int row0, int fq, int ln, float (&rs)[8]) {
    f32x4 a[8], b[8];
#pragma unroll
    for (int q = 0; q < 8; ++q) { const f32x4* p = (const f32x4*)(ssp + (size_t)(row0 + (q >> 2) * 128 + (q & 3) * 16) * 32 + 8 * fq); a[q] = p[0]; b[q] = p[1]; }
#pragma unroll
    for (int q = 0; q < 8; ++q) { float s = ((a[q].x + a[q].y) + (a[q].z + a[q].w)) + ((b[q].x + b[q].y) + (b[q].z + b[q].w));
        s += shx(s, 16, ln); s += shx(s, 32, ln); rs[q] = rsqrtf(s * (1.0f / D) + RMS_EPS); }
}
__device__ __forceinline__ void store16_wt(__amdgpu_buffer_rsrc_t rsrc, unsigned byte_off, v4u v) { __builtin_amdgcn_raw_buffer_store_b128(v, rsrc, byte_off, 0, 16); }
struct EpiSwiGLU {
    static constexpr bool PERM = true, KEEP = false;
    __device__ __forceinline__ bool keep(const Unit&) const { return false; }
    bf16* H; const float* ss;
    __device__ __forceinline__ void operator()(AccRef acc, const Unit& u, int wr, int wc, int, int) const {
        const int ln_ = fresh_lane(), fr = ln_ & 15, fq = ln_ >> 4;
        const int row0 = u.pm * 256 + wr * 64 + fr, col0 = u.pn * 128 + wc * 32 + 8 * fq;
        const __amdgpu_buffer_rsrc_t rsrc = __builtin_amdgcn_make_buffer_rsrc((void*)H, 0, (int)((size_t)M * DFF * 2), 0x00020000);
        float rs[8]; rows_rstd(ss, row0, fq, ln_, rs);
#pragma unroll
        for (int ai = 0; ai < 2; ++ai)
#pragma unroll
            for (int m = 0; m < 4; ++m) {
                const int row = row0 + ai * 128 + m * 16;
                const float r = rs[ai * 4 + m];
                float h[8];
#pragma unroll
                for (int n = 0; n < 2; ++n)
#pragma unroll
                    for (int j = 0; j < 4; ++j) { const float a = acc[ai][0][m][n][j] * r, b = acc[ai][1][m][n][j] * r; h[4 * n + j] = a * __builtin_amdgcn_rcpf(1.0f + __expf(-a)) * b; }
                v4u w; w.x = cvt_pk_bf16(h[0], h[1]); w.y = cvt_pk_bf16(h[2], h[3]); w.z = cvt_pk_bf16(h[4], h[5]); w.w = cvt_pk_bf16(h[6], h[7]);
                store16_wt(rsrc, (unsigned)(((size_t)row * DFF + col0) * 2), w);
            }
    }
};
struct EpiResid {
    static constexpr bool PERM = true, KEEP = false;
    __device__ __forceinline__ bool keep(const Unit&) const { return false; }
    const float* xin32;
    float* xout32;
    bf16* xb; bf16* xl; float* ss; float alpha; float pscale, pspike;
    __device__ __forceinline__ void operator()(AccRef acc, const Unit& u, int wr, int wc, int, int) const {
        const int ln_ = fresh_lane(), fr = ln_ & 15, fq = ln_ >> 4;
        const int row0 = u.pm * 256 + wr * 64 + fr, col0 = u.pn * 256 + wc * 32 + 8 * fq;
#pragma unroll
        for (int ai = 0; ai < 2; ++ai)
#pragma unroll
            for (int m = 0; m < 4; ++m) {
                const int row = row0 + ai * 128 + m * 16; float s = 0.f;
#pragma unroll
                for (int bj = 0; bj < 2; ++bj) {
                    const size_t p = (size_t)row * D + col0 + bj * 128;
                    f32x4 x0, x1;
                    if (xin32) { x0 = *(const f32x4*)(xin32 + p); x1 = *(const f32x4*)(xin32 + p + 4); }
                    else { const v4u h = *(const v4u*)(xb + p), lo = *(const v4u*)(xl + p);
                        x0 = (f32x4){bflo(h.x) + bflo(lo.x), bfhi(h.x) + bfhi(lo.x), bflo(h.y) + bflo(lo.y), bfhi(h.y) + bfhi(lo.y)};
                        x1 = (f32x4){bflo(h.z) + bflo(lo.z), bfhi(h.z) + bfhi(lo.z), bflo(h.w) + bflo(lo.w), bfhi(h.w) + bfhi(lo.w)}; }
                    x0 = x0 + alpha * acc[ai][bj][m][0]; x1 = x1 + alpha * acc[ai][bj][m][1];
                    if (PROBE_ON) { x0 = x0 * pscale; x1 = x1 * pscale; if (p == 0) x0[0] += pspike; }
                    if (xout32) { *(f32x4*)(xout32 + p) = x0; *(f32x4*)(xout32 + p + 4) = x1; }
                    else {
                        v4u w; w.x = cvt_pk_bf16(x0[0], x0[1]); w.y = cvt_pk_bf16(x0[2], x0[3]); w.z = cvt_pk_bf16(x1[0], x1[1]); w.w = cvt_pk_bf16(x1[2], x1[3]);
                        *(v4u*)(xb + p) = w;
                        const f32x4 r0 = {x0[0] - bflo(w.x), x0[1] - bfhi(w.x), x0[2] - bflo(w.y), x0[3] - bfhi(w.y)}, r1 = {x1[0] - bflo(w.z), x1[1] - bfhi(w.z), x1[2] - bflo(w.w), x1[3] - bfhi(w.w)};
                        v4u q; q.x = cvt_pk_bf16(r0[0], r0[1]); q.y = cvt_pk_bf16(r0[2], r0[3]); q.z = cvt_pk_bf16(r1[0], r1[1]); q.w = cvt_pk_bf16(r1[2], r1[3]);
                        *(v4u*)(xl + p) = q;
                    }
                    s += (x0[0] * x0[0] + x0[1] * x0[1]) + (x0[2] * x0[2] + x0[3] * x0[3]) + (x1[0] * x1[0] + x1[1] * x1[1]) + (x1[2] * x1[2] + x1[3] * x1[3]);
                }
                s += shx(s, 16, ln_); s += shx(s, 32, ln_);
                if (fq == 0) ss[(size_t)row * 32 + u.pn * 4 + wc] = s;
                if (m == 3) asm volatile("" ::: "memory");
            }
    }
};
struct EpiProj {
    static constexpr bool PERM = true, KEEP = false;
    __device__ __forceinline__ bool keep(const Unit&) const { return false; }
    bf16* O; const float* ss;
    __device__ __forceinline__ void operator()(AccRef acc, const Unit& u, int wr, int wc, int, int) const {
        const int ln_ = fresh_lane(), fr = ln_ & 15, fq = ln_ >> 4;
        const int row0 = u.pm * 256 + wr * 64 + fr, col0 = u.pn * 256 + wc * 32 + 8 * fq;
        const __amdgpu_buffer_rsrc_t rsrc = __builtin_amdgcn_make_buffer_rsrc((void*)O, 0, (int)((size_t)M * DINP * 2), 0x00020000);
        float rs[8]; rows_rstd(ss, row0, fq, ln_, rs);
#pragma unroll
        for (int ai = 0; ai < 2; ++ai)
#pragma unroll
            for (int m = 0; m < 4; ++m) {
                const int row = row0 + ai * 128 + m * 16;
                const float r = rs[ai * 4 + m];
#pragma unroll
                for (int bj = 0; bj < 2; ++bj) {
                    const f32x4 v0 = acc[ai][bj][m][0] * r, v1 = acc[ai][bj][m][1] * r;
                    v4u w; w.x = cvt_pk_bf16(v0[0], v0[1]); w.y = cvt_pk_bf16(v0[2], v0[3]); w.z = cvt_pk_bf16(v1[0], v1[1]); w.w = cvt_pk_bf16(v1[2], v1[3]);
                    store16_wt(rsrc, (unsigned)(((size_t)row * DINP + col0 + bj * 128) * 2), w);
                }
            }
    }
};
typedef f32x4 (&AccMut)[2][2][4][2];
struct EpiBranch3 {
    static constexpr bool PERM = true, KEEP = true;
    const bf16* PROJ; bf16* MGB;
    __device__ __forceinline__ bool keep(const Unit& u) const { return u.seg < 2; }
    __device__ __forceinline__ void operator()(AccMut acc, const Unit& u, int wr, int wc, int, int) const {
        const int ln_ = fresh_lane(), fr = ln_ & 15, fq = ln_ >> 4;
        const int row0 = u.pm * 256 + wr * 64 + fr, col0 = u.pn * 256 + wc * 32 + 8 * fq;
#pragma unroll
        for (int ai = 0; ai < 2; ++ai)
#pragma unroll
            for (int m = 0; m < 4; ++m) {
#pragma unroll
                for (int bj = 0; bj < 2; ++bj) {
                    const int row = row0 + ai * 128 + m * 16, col = col0 + bj * 128;
                    const bf16* gp = PROJ + (size_t)row * DINP + GATE_OFF + col;
                    float sc[8];
                    if (u.seg < 2) {
                        const v4u ga = *(const v4u*)(gp + u.seg * D), gb = *(const v4u*)(gp + (u.seg + 1) * D);
                        const float la[8] = {bflo(ga.x), bfhi(ga.x), bflo(ga.y), bfhi(ga.y), bflo(ga.z), bfhi(ga.z), bflo(ga.w), bfhi(ga.w)};
                        const float lb[8] = {bflo(gb.x), bfhi(gb.x), bflo(gb.y), bfhi(gb.y), bflo(gb.z), bfhi(gb.z), bflo(gb.w), bfhi(gb.w)};
#pragma unroll
                        for (int j = 0; j < 8; ++j) { const float ea = __expf(-fminf(fmaxf(la[j], -30.f), 30.f)), eb = __expf(-fminf(fmaxf(lb[j], -30.f), 30.f)); sc[j] = (1.0f + eb) * __builtin_amdgcn_rcpf(1.0f + ea); }
                    } else {
                        const v4u ga = *(const v4u*)(gp + 2 * D);
                        const float la[8] = {bflo(ga.x), bfhi(ga.x), bflo(ga.y), bfhi(ga.y), bflo(ga.z), bfhi(ga.z), bflo(ga.w), bfhi(ga.w)};
#pragma unroll
                        for (int j = 0; j < 8; ++j) sc[j] = sigmoidf_(la[j]);
                    }
                    f32x4 x0 = acc[ai][bj][m][0], x1 = acc[ai][bj][m][1];
                    x0 = (f32x4){x0[0] * sc[0], x0[1] * sc[1], x0[2] * sc[2], x0[3] * sc[3]}; x1 = (f32x4){x1[0] * sc[4], x1[1] * sc[5], x1[2] * sc[6], x1[3] * sc[7]};
                    if (u.seg < 2) { acc[ai][bj][m][0] = x0; acc[ai][bj][m][1] = x1; }
                    else { v4u w; w.x = cvt_pk_bf16(x0[0], x0[1]); w.y = cvt_pk_bf16(x0[2], x0[3]); w.z = cvt_pk_bf16(x1[0], x1[1]); w.w = cvt_pk_bf16(x1[2], x1[3]); *(v4u*)(MGB + (size_t)row * D + col) = w; }
                }
                if (m == 3) asm volatile("" ::: "memory");
            }
    }
};
template <class F> struct EpiF {
    static constexpr bool PERM = true, KEEP = false;
    __device__ __forceinline__ bool keep(const Unit&) const { return false; }
    F f;
    __device__ __forceinline__ void operator()(AccRef acc, const Unit& u, int wr, int wc, int, int) const {
        const int ln_ = fresh_lane(), fr = ln_ & 15, fq = ln_ >> 4;
        const int row0 = u.pm * 256 + wr * 64 + fr, col0 = u.pn * 256 + wc * 32 + 8 * fq;
#pragma unroll
        for (int ai = 0; ai < 2; ++ai)
#pragma unroll
            for (int m = 0; m < 4; ++m)
            {
#pragma unroll
                for (int bj = 0; bj < 2; ++bj) f(row0 + ai * 128 + m * 16, col0 + bj * 128, acc[ai][bj][m][0], acc[ai][bj][m][1]);
                if (m & 1) asm volatile("" ::: "memory");
            }
    }
};
struct FDecay { const float* w0; float* out;
    __device__ __forceinline__ void operator()(int row, int col, f32x4 v0, f32x4 v1) const {
        float o[8];
#pragma unroll
        for (int j = 0; j < 8; ++j) { const float x = w0[col + j] + (j < 4 ? v0[j & 3] : v1[j & 3]); o[j] = __expf(-0.6065306597126334f * sigmoidf_(x)); }
        float* p = out + (size_t)row * RW + col; *(f32x4*)p = (f32x4){o[0], o[1], o[2], o[3]}; *(f32x4*)(p + 4) = (f32x4){o[4], o[5], o[6], o[7]}; } };
struct FASig { const float* a0; bf16* out;
    __device__ __forceinline__ void operator()(int row, int col, f32x4 v0, f32x4 v1) const {
        float o[8];
#pragma unroll
        for (int j = 0; j < 8; ++j) o[j] = sigmoidf_(a0[col + j] + (j < 4 ? v0[j & 3] : v1[j & 3]));
        v4u w; w.x = cvt_pk_bf16(o[0], o[1]); w.y = cvt_pk_bf16(o[2], o[3]); w.z = cvt_pk_bf16(o[4], o[5]); w.w = cvt_pk_bf16(o[6], o[7]);
        *(v4u*)(out + (size_t)row * RW + col) = w; } };
struct FStoreF32 { float* out; int ld;
    __device__ __forceinline__ void operator()(int row, int col, f32x4 v0, f32x4 v1) const { float* p = out + (size_t)row * ld + col; *(f32x4*)p = v0; *(f32x4*)(p + 4) = v1; } };
struct FStoreBf16 { bf16* out; int ld;
    __device__ __forceinline__ void operator()(int row, int col, f32x4 v0, f32x4 v1) const {
        v4u w; w.x = cvt_pk_bf16(v0[0], v0[1]); w.y = cvt_pk_bf16(v0[2], v0[3]); w.z = cvt_pk_bf16(v1[0], v1[1]); w.w = cvt_pk_bf16(v1[2], v1[3]);
        *(v4u*)(out + (size_t)row * ld + col) = w; } };
struct FVres { const float* v0p; bf16* VP; const bf16* VF;
    __device__ __forceinline__ void operator()(int row, int col, f32x4 a0, f32x4 a1) const {
        const size_t p = (size_t)row * RW + col;
        const v4u xv = *(const v4u*)(VP + p), fv = *(const v4u*)(VF + p);
        const float x[8] = {bflo(xv.x), bfhi(xv.x), bflo(xv.y), bfhi(xv.y), bflo(xv.z), bfhi(xv.z), bflo(xv.w), bfhi(xv.w)};
        const float f[8] = {bflo(fv.x), bfhi(fv.x), bflo(fv.y), bfhi(fv.y), bflo(fv.z), bfhi(fv.z), bflo(fv.w), bfhi(fv.w)};
        float o[8];
#pragma unroll
        for (int j = 0; j < 8; ++j) o[j] = x[j] + (f[j] - x[j]) * sigmoidf_(v0p[col + j] + (j < 4 ? a0[j & 3] : a1[j & 3]));
        v4u w; w.x = cvt_pk_bf16(o[0], o[1]); w.y = cvt_pk_bf16(o[2], o[3]); w.z = cvt_pk_bf16(o[4], o[5]); w.w = cvt_pk_bf16(o[6], o[7]);
        *(v4u*)(VP + p) = w; } };
struct FGlu { const bf16* Z; bf16* Y;
    __device__ __forceinline__ void operator()(int row, int col, f32x4 a0, f32x4 a1) const {
        const size_t p = (size_t)row * 1024 + col; const v4u z = *(const v4u*)(Z + p);
        const float z0 = bflo(z.x), z1 = bfhi(z.x), z2 = bflo(z.y), z3 = bfhi(z.y), z4 = bflo(z.z), z5 = bfhi(z.z), z6 = bflo(z.w), z7 = bfhi(z.w);
        v4u w; w.x = cvt_pk_bf16(z0 * sigmoidf_(a0[0]), z1 * sigmoidf_(a0[1])); w.y = cvt_pk_bf16(z2 * sigmoidf_(a0[2]), z3 * sigmoidf_(a0[3]));
        w.z = cvt_pk_bf16(z4 * sigmoidf_(a1[0]), z5 * sigmoidf_(a1[1])); w.w = cvt_pk_bf16(z6 * sigmoidf_(a1[2]), z7 * sigmoidf_(a1[3]));
        *(v4u*)(Y + p) = w; } };
template <int MODE> struct FBranch { const bf16* PROJ; int goff; float* MG; bf16* MGB;
    __device__ __forceinline__ void operator()(int row, int col, f32x4 a0, f32x4 a1) const {
        const v4u gq = *(const v4u*)(PROJ + (size_t)row * DINP + goff + col);
        const float g0 = sigmoidf_(bflo(gq.x)), g1 = sigmoidf_(bfhi(gq.x)), g2 = sigmoidf_(bflo(gq.y)), g3 = sigmoidf_(bfhi(gq.y)), g4 = sigmoidf_(bflo(gq.z)), g5 = sigmoidf_(bfhi(gq.z)), g6 = sigmoidf_(bflo(gq.w)), g7 = sigmoidf_(bfhi(gq.w));
        const size_t p = (size_t)row * D + col;
        f32x4 x0 = (f32x4){g0 * a0[0], g1 * a0[1], g2 * a0[2], g3 * a0[3]}, x1 = (f32x4){g4 * a1[0], g5 * a1[1], g6 * a1[2], g7 * a1[3]};
        if (MODE != 0) { x0 = x0 + *(const f32x4*)(MG + p); x1 = x1 + *(const f32x4*)(MG + p + 4); }
        if (MODE != 2) { *(f32x4*)(MG + p) = x0; *(f32x4*)(MG + p + 4) = x1; }
        else { v4u w; w.x = cvt_pk_bf16(x0[0], x0[1]); w.y = cvt_pk_bf16(x0[2], x0[3]); w.z = cvt_pk_bf16(x1[0], x1[1]); w.w = cvt_pk_bf16(x1[2], x1[3]); *(v4u*)(MGB + p) = w; } } };

__device__ __forceinline__ void norm_frag(v4u r0, v4u r1, const float (&g16)[16], int lane, pg8::bf16x8& f0, pg8::bf16x8& f1) {
    float x[16] = {bflo(r0.x), bfhi(r0.x), bflo(r0.y), bfhi(r0.y), bflo(r0.z), bfhi(r0.z), bflo(r0.w), bfhi(r0.w), bflo(r1.x), bfhi(r1.x), bflo(r1.y), bfhi(r1.y), bflo(r1.z), bfhi(r1.z), bflo(r1.w), bfhi(r1.w)};
    float ss = 0.f;
#pragma unroll
    for (int j = 0; j < 16; ++j) ss += x[j] * x[j];
    ss += shx(ss, 16, lane); ss += shx(ss, 32, lane);
    const float r = rsqrtf(ss * (1.0f / 64) + RMS_EPS);
#pragma unroll
    for (int j = 0; j < 16; ++j) x[j] = x[j] * r * g16[j];
    v4u a, b; a.x = pg8::cvt_pk_bf16(x[0], x[1]); a.y = pg8::cvt_pk_bf16(x[2], x[3]); a.z = pg8::cvt_pk_bf16(x[4], x[5]); a.w = pg8::cvt_pk_bf16(x[6], x[7]);
    b.x = pg8::cvt_pk_bf16(x[8], x[9]); b.y = pg8::cvt_pk_bf16(x[10], x[11]); b.z = pg8::cvt_pk_bf16(x[12], x[13]); b.w = pg8::cvt_pk_bf16(x[14], x[15]);
    f0 = __builtin_bit_cast(pg8::bf16x8, a); f1 = __builtin_bit_cast(pg8::bf16x8, b);
}
struct ConvItem { const float* W; const float* ks; bf16* dst; int ldw, Ksrc, srcc, ldd, drow0, k0, ncols; };
template <int MAP> __device__ __forceinline__ ConvItem conv_mk(const float* W, int ldw, int Ksrc, int Kdst, int Nsrc, int Ndst, const float* ks, bf16* dst, int item, int ldd = 0) {
    const int nblk = Ndst / 64, kb = item / nblk, nb = item % nblk, n0 = 64 * nb;
    int srcc;
    if (MAP == 0) srcc = (n0 < Nsrc) ? n0 : -1;
    else { const int tile = n0 >> 8, within = n0 & 255, bj = within >> 7, c = within & 127; srcc = bj * DFF + tile * 128 + c; }
    ConvItem ci; ci.W = W; ci.ks = ks; ci.dst = dst; ci.ldw = ldw; ci.Ksrc = Ksrc; ci.srcc = srcc; ci.ldd = ldd ? ldd : Kdst; ci.drow0 = n0; ci.k0 = 64 * kb; ci.ncols = (MAP == 0) ? Nsrc : 2 * DFF; return ci;
}
__device__ __forceinline__ void conv_load(const ConvItem& ci, int lane, float (&v)[64]) {
    const bool okc = ci.srcc >= 0 && (ci.srcc + lane) < ci.ncols;
    const float* base = ci.W + (okc ? ci.srcc + lane : 0);
    const int kmax = ci.Ksrc - 1;
#pragma unroll
    for (int i = 0; i < 64; ++i) { const int k = ci.k0 + i, kk = k < kmax ? k : kmax; v[i] = __builtin_nontemporal_load(base + (size_t)kk * ci.ldw); }
#pragma unroll
    for (int i = 0; i < 64; ++i) v[i] = (okc && (ci.k0 + i) < ci.Ksrc) ? v[i] : 0.f;
}
__device__ __forceinline__ void conv_store(const ConvItem& ci, LAS float* scr, int lane, const float (&v)[64]) {
    const int c = lane & 7;
    f32x4 s0 = {1.f, 1.f, 1.f, 1.f}, s1 = s0;
    if (ci.ks) { const int kb = ci.k0 + 8 * c < ci.Ksrc - 8 ? ci.k0 + 8 * c : ci.Ksrc - 8; s0 = *(const f32x4*)(ci.ks + kb); s1 = *(const f32x4*)(ci.ks + kb + 4); }
#pragma unroll
    for (int i = 0; i < 64; ++i) scr[i * 65 + lane] = v[i];
    LDS_WAIT(); asm volatile("" ::: "memory");
#pragma unroll
    for (int j = 0; j < 8; ++j) { const int n = (lane >> 3) + 8 * j; const LAS float* s = scr + (8 * c) * 65 + n;
        v4u o; o.x = cvt_pk_bf16(s[0 * 65] * s0[0], s[1 * 65] * s0[1]); o.y = cvt_pk_bf16(s[2 * 65] * s0[2], s[3 * 65] * s0[3]); o.z = cvt_pk_bf16(s[4 * 65] * s1[0], s[5 * 65] * s1[1]); o.w = cvt_pk_bf16(s[6 * 65] * s1[2], s[7 * 65] * s1[3]);
        *(v4u*)(ci.dst + (size_t)(ci.drow0 + n) * ci.ldd + ci.k0 + 8 * c) = o; }
    LDS_WAIT(); asm volatile("" ::: "memory");
}

__device__ __forceinline__ bool in_range(int lo, int hi, int k) { asm volatile("" : "+s"(k)); return lo <= k && k < hi; }
struct Args { const float* in[38]; float* out; unsigned char* ws; int ph_lo, ph_hi, use_bar, pad; };
typedef const Args __attribute__((address_space(4)))* KArgs;

__global__ void __launch_bounds__(NWAVES * 64, 2) mk_fwd(Args args) {
    extern __shared__ __attribute__((aligned(16))) unsigned char lds_raw[];
    LAS unsigned char* lds = (LAS unsigned char*)lds_raw;
    for (int u = threadIdx.x; u < (LDS_BYTES - LDSCTL_OFF) / 4; u += NWAVES * 64) ((LAS unsigned*)(lds + LDSCTL_OFF))[u] = 0u;
    __syncthreads();
    XcdBarrier bar; bar.bar = (unsigned*)(args.ws + WS_CTL) + CW_BAR; bar.x = 0; bar.st = nullptr;
    if (args.use_bar) bar = xcd_barrier_post((unsigned*)(args.ws + WS_CTL) + CW_BAR, (volatile LAS unsigned*)(lds + LDSCTL_OFF + 64));

    const int lo = args.ph_lo, hi = args.ph_hi, use_bar = args.use_bar;
    const int wave0 = __builtin_amdgcn_readfirstlane((int)threadIdx.x >> 6);
#ifndef PHMASK
#define PHMASK 0xFFFF
#endif
#define EN(p) ((PHMASK >> (p)) & 1)
#define IN(k) in_range(lo, hi, (k))
#define SEAM(k) do { if (IN(k) && IN((k) + 1)) { if (use_bar) { XcdBarrier b_ = bar; asm volatile("" : "+s"(b_.bar), "+s"(b_.x)); xcd_barrier(b_); } } } while (0)
#define DBG_ACC ((unsigned*)(args.ws + WS_CTL + 128 * 1024))
#define STAMP(k) do { if (PROBE_ON && wave0 == 0 && blockIdx.x == 0) { if (fresh_lane() == 0) { unsigned* a_ = DBG_ACC; const unsigned now_ = (unsigned)__builtin_amdgcn_s_memrealtime(); \
        const int ty_ = (k) == 0 ? 15 : ((k) - 1) % NPH; a_[ty_] += now_ - a_[32]; a_[32] = now_; } } } while (0)
#define PH_LOCALS \
    int lane; asm volatile("v_mbcnt_lo_u32_b32 %0, -1, 0\n\tv_mbcnt_hi_u32_b32 %0, -1, %0" : "=v"(lane)); int wave = wave0; asm volatile("" : "+s"(wave)); const int tid = wave * 64 + lane; \
    int G = gridDim.x, bid = blockIdx.x; asm volatile("" : "+s"(G), "+s"(bid)); \
    KArgs ka = (KArgs)__builtin_amdgcn_kernarg_segment_ptr(); asm volatile("" : "+s"(ka)); \
    unsigned char* ws = ka->ws; \
    const int gw = bid * NWAVES + wave, NGW = G * NWAVES; const size_t gtid = (size_t)bid * (NWAVES * 64) + tid, NT = (size_t)G * (NWAVES * 64); \
    (void)lane; (void)gw; (void)NGW; (void)gtid; (void)NT;
#define P_XL ((bf16*)(ws + WS_X))
#define P_XB ((bf16*)(ws + WS_XB))
#define P_HID ((bf16*)(ws + WS_HID))
#define P_PROJ ((bf16*)(ws + WS_PROJ))
#define P_SS ((float*)(ws + WS_SSP))
#define P_RP ((bf16*)(ws + WS_RP))
#define P_KP ((bf16*)(ws + WS_KP))
#define P_VP ((bf16*)(ws + WS_VP))
#define P_DECAY ((float*)(ws + WS_DECAY))
#define P_ASIG ((bf16*)(ws + WS_ASIG))
#define P_GG ((bf16*)(ws + WS_G))
#define P_KK ((bf16*)(ws + WS_KK))
#define P_VFIRST ((bf16*)(ws + WS_VFIRST))
#define P_YRAW ((bf16*)(ws + WS_YRAW))
#define P_LORA ((bf16*)(ws + WS_LORA))
#define P_AV ((bf16*)(ws + WS_VP))
#define P_V1O ((bf16*)(ws + WS_V1O))
#define P_QN ((bf16*)(ws + WS_QN))
#define P_KN ((bf16*)(ws + WS_KN))
#define P_Z ((bf16*)(ws + WS_Z))
#define P_YS5 ((bf16*)(ws + WS_YS5))
#define P_YATT ((bf16*)(ws + WS_MERGED))
#define P_YRWKV ((bf16*)(ws + WS_YRWKV))
#define P_MERGED ((float*)(ws + WS_MERGED))
#define P_MERGEDB ((bf16*)(ws + WS_MERGEDB))
#define P_SBUF ((f32x2*)(ws + WS_SBUF))

    if (PROBE_ON && wave0 == 0 && blockIdx.x == 0) { if (fresh_lane() == 0) DBG_ACC[32] = (unsigned)__builtin_amdgcn_s_memrealtime(); }
    if (IN(0)) {
        PH_LOCALS
        const float* x = ka->in[0];
        for (int m = gw; m < M; m += NGW) {
            const f32x4* xr = (const f32x4*)(x + (size_t)m * D) + lane; float s = 0.f;
            v2u* o = (v2u*)(P_XB + (size_t)m * D) + lane;
#pragma unroll
            for (int j = 0; j < 8; ++j) { const f32x4 v = xr[64 * j]; s += (v.x * v.x + v.y * v.y) + (v.z * v.z + v.w * v.w); v2u w; w.x = pk2(v.x, v.y); w.y = pk2(v.z, v.w); o[64 * j] = w; }
            s = wave_sum(s, lane);
            if (lane < 32) P_SS[(size_t)m * 32 + lane] = lane == 0 ? s : 0.f;
        }
    }
    STAMP(0);

    for (int l = 0; l < DEPTH; ++l) {
        const int pb = 1 + l * NPH;
        if (hi <= pb || lo >= pb + NPH) continue;
        if (EN(0) && IN(pb + 0)) {
            PH_LOCALS
            LAS float* scr = (LAS float*)(lds + RING_OFF + wave * 16640);   static_assert(8 * 16640 <= LDSCTL_OFF, "converter scratch below the LDS control words");
            constexpr int I_UP = (D / 64) * (NUP / 64), I_DN = (DFF / 64) * (D / 64), I_IN = (D / 64) * (DINP / 64), I_GLU = 16 * 16, I_L = 4 * 16, I_V1 = 16 * 4, I_V2 = 4 * 16,
                          I_BS5 = 16 * 32, I_BAT = 8 * 32, I_BRW = 16 * 32, I_OUT = 32 * 32;
            constexpr int NITEMS = 2 * I_UP + 2 * I_DN + I_IN + I_GLU + 3 * I_L + I_V1 + I_V2 + I_BS5 + I_BAT + I_BRW + I_OUT;
            const int lv = l > 0 ? l - 1 : 0;
#define CONV_DESC(dst_, it_) do { int r = (it_); \
                if (r < I_UP) { dst_ = conv_mk<1>(ka->in[2] + (size_t)l * D * NUP, NUP, D, D, NUP, NUP, ka->in[1] + l * D, (bf16*)(ws + W_UP1), r); break; } r -= I_UP; \
                if (r < I_UP) { dst_ = conv_mk<1>(ka->in[36] + (size_t)l * D * NUP, NUP, D, D, NUP, NUP, ka->in[35] + l * D, (bf16*)(ws + W_UP2), r); break; } r -= I_UP; \
                if (r < I_IN) { dst_ = conv_mk<0>(ka->in[5] + (size_t)l * D * DIN, DIN, D, D, DIN, DINP, ka->in[4] + l * D, (bf16*)(ws + W_IN), r); break; } r -= I_IN; \
                if (r < I_DN) { dst_ = conv_mk<0>(ka->in[3] + (size_t)l * DFF * D, D, DFF, DFF, D, D, nullptr, (bf16*)(ws + W_DN1), r); break; } r -= I_DN; \
                if (r < I_DN) { dst_ = conv_mk<0>(ka->in[37] + (size_t)l * DFF * D, D, DFF, DFF, D, D, nullptr, (bf16*)(ws + W_DN2), r); break; } r -= I_DN; \
                if (r < I_OUT) { dst_ = conv_mk<0>(ka->in[34] + (size_t)l * D * D, D, D, D, D, D, nullptr, (bf16*)(ws + W_OUT), r); break; } r -= I_OUT; \
                if (r < I_BS5) { dst_ = conv_mk<0>(ka->in[31] + (size_t)l * 1024 * D, D, 1024, 1024, D, D, nullptr, (bf16*)(ws + W_BS5), r); break; } r -= I_BS5; \
                if (r < I_BAT) { dst_ = conv_mk<0>(ka->in[32] + (size_t)l * 512 * D, D, 512, 512, D, D, nullptr, (bf16*)(ws + W_BAT2), r, 1024); break; } r -= I_BAT; \
                if (r < I_BRW) { dst_ = conv_mk<0>(ka->in[33] + (size_t)l * 1024 * D, D, 1024, 1024, D, D, nullptr, (bf16*)(ws + W_BRW), r); break; } r -= I_BRW; \
                if (r < I_GLU) { dst_ = conv_mk<0>(ka->in[14] + (size_t)l * 1024 * 1024, 1024, 1024, 1024, 1024, 1024, nullptr, (bf16*)(ws + W_GLU), r); break; } r -= I_GLU; \
                if (r < I_L) { dst_ = conv_mk<0>(ka->in[19] + (size_t)l * 96 * RW, RW, 96, 256, RW, RW, nullptr, (bf16*)(ws + W_W2), r); break; } r -= I_L; \
                if (r < I_L) { dst_ = conv_mk<0>(ka->in[21] + (size_t)l * 96 * RW, RW, 96, 256, RW, RW, nullptr, (bf16*)(ws + W_A2), r); break; } r -= I_L; \
                if (r < I_L) { dst_ = conv_mk<0>(ka->in[22] + (size_t)l * 256 * RW, RW, 256, 256, RW, RW, nullptr, (bf16*)(ws + W_G2), r); break; } r -= I_L; \
                if (r < I_V1) { dst_ = conv_mk<0>(ka->in[29] + (size_t)lv * RW * 64, 64, RW, RW, 64, 256, nullptr, (bf16*)(ws + W_V1), r); break; } r -= I_V1; \
                dst_ = conv_mk<0>(ka->in[30] + (size_t)lv * 64 * RW, RW, 64, 256, RW, RW, nullptr, (bf16*)(ws + W_V2), r); } while (0)
            for (int it = gw; it < NITEMS; it += NGW) {
                ConvItem ca; CONV_DESC(ca, it);
                float va[64];
                conv_load(ca, lane, va);
                conv_store(ca, scr, lane, va);
            }
#undef CONV_DESC
        }
        SEAM(pb + 0); STAMP(pb + 0);
        if (EN(1) && IN(pb + 1)) {
            PH_LOCALS
            pg8::Gemm g{P_XB, (const bf16*)(ws + W_UP1), M, NUP, D, D, D}; pg8::StaticOrder S; S.init(M, NUP, G, bid);
            EpiSwiGLU E{P_HID, P_SS + (size_t)(3 * l + 0) * M * 32};
            pg8::gemm_phase<EpiSwiGLU, pg8::StaticOrder, true, true>(lds + RING_OFF, g, S, E, tid);
        }
        SEAM(pb + 1); STAMP(pb + 1);
        if (EN(2) && IN(pb + 2)) {
            PH_LOCALS
            pg8::Gemm g{P_HID, (const bf16*)(ws + W_DN1), M, D, DFF, DFF, DFF}; pg8::StaticOrder S; S.init(M, D, G, bid);
            EpiResid E{l == 0 ? ka->in[0] : nullptr, nullptr, P_XB, P_XL, P_SS + (size_t)(3 * l + 1) * M * 32, 0.5f, 1.0f, 0.0f};
            pg8::gemm_phase<EpiResid, pg8::StaticOrder, true, true>(lds + RING_OFF, g, S, E, tid);
        }
        SEAM(pb + 2); STAMP(pb + 2);
        if (EN(3) && IN(pb + 3)) {
            PH_LOCALS
            pg8::Gemm g{P_XB, (const bf16*)(ws + W_IN), M, DINP, D, D, D}; pg8::StaticOrder S; S.init(M, DINP, G, bid);
            EpiProj E{P_PROJ, P_SS + (size_t)(3 * l + 1) * M * 32};
            pg8::gemm_phase<EpiProj, pg8::StaticOrder, true, true>(lds + RING_OFF, g, S, E, tid);
        }
        SEAM(pb + 3); STAMP(pb + 3);
        if (EN(4) && IN(pb + 4)) {
            PH_LOCALS
            const float* mu = ka->in[17] + (size_t)l * RWP;
            const bf16* PROJ = P_PROJ; bf16* LORA = P_LORA; bf16* RPp = P_RP; bf16* KPp = P_KP; bf16* VPp = P_VP; bf16* VFp = P_VFIRST; bf16* KKp = P_KK;
#pragma unroll 1
            for (int ch = lane; ch < RWP / 8; ch += 64) {
                const int c = ch * 8;
                const f32x4 m0 = *(const f32x4*)(mu + c), m1 = *(const f32x4*)(mu + c + 4);
                f32x4 q0 = {0.f, 0.f, 0.f, 0.f}, q1 = q0;
                if (c >= 1024 && c < 2048) { q0 = *(const f32x4*)(ka->in[23] + l * RW + c - 1024); q1 = *(const f32x4*)(ka->in[23] + l * RW + c - 1024 + 4); }
#pragma unroll 1
                for (int m = gw; m < M; m += NGW) {
                    const bool has_prev = (m % T) != 0;
                    const bf16* prow = PROJ + (size_t)m * DINP;
                    const v4u pc = *(const v4u*)(prow + RW_OFF + c);
                    v4u pp = {0u, 0u, 0u, 0u}; if (has_prev) pp = *(const v4u*)(prow - DINP + RW_OFF + c);
                    float p[8];
                    { const float c0 = bflo(pc.x), c1 = bfhi(pc.x), c2 = bflo(pc.y), c3 = bfhi(pc.y), c4 = bflo(pc.z), c5 = bfhi(pc.z), c6 = bflo(pc.w), c7 = bfhi(pc.w);
                      p[0] = c0 + (bflo(pp.x) - c0) * m0[0]; p[1] = c1 + (bfhi(pp.x) - c1) * m0[1]; p[2] = c2 + (bflo(pp.y) - c2) * m0[2]; p[3] = c3 + (bfhi(pp.y) - c3) * m0[3];
                      p[4] = c4 + (bflo(pp.z) - c4) * m1[0]; p[5] = c5 + (bfhi(pp.z) - c5) * m1[1]; p[6] = c6 + (bflo(pp.w) - c6) * m1[2]; p[7] = c7 + (bfhi(pp.w) - c7) * m1[3]; }
                    if (c >= 1024 && c < 2048) {
                        float kk[8] = {p[0] * q0[0], p[1] * q0[1], p[2] * q0[2], p[3] * q0[3], p[4] * q1[0], p[5] * q1[1], p[6] * q1[2], p[7] * q1[3]};
                        float ssq = (kk[0] * kk[0] + kk[1] * kk[1]) + (kk[2] * kk[2] + kk[3] * kk[3]) + (kk[4] * kk[4] + kk[5] * kk[5]) + (kk[6] * kk[6] + kk[7] * kk[7]);
                        ssq += shx(ssq, 1, lane); ssq += shx(ssq, 2, lane); ssq += shx(ssq, 4, lane);
                        const float rn = rsqrtf(fmaxf(ssq, 1e-24f));
                        v4u w; w.x = cvt_pk_bf16(kk[0] * rn, kk[1] * rn); w.y = cvt_pk_bf16(kk[2] * rn, kk[3] * rn); w.z = cvt_pk_bf16(kk[4] * rn, kk[5] * rn); w.w = cvt_pk_bf16(kk[6] * rn, kk[7] * rn);
                        *(v4u*)(KKp + (size_t)m * RW + (c - 1024)) = w;
                    }
                    if (c < 3072) {
                        bf16* dst = (c < 1024 ? RPp : (c < 2048 ? KPp : VPp)) + (size_t)m * RW + (c & 1023);
                        v4u w; w.x = cvt_pk_bf16(p[0], p[1]); w.y = cvt_pk_bf16(p[2], p[3]); w.z = cvt_pk_bf16(p[4], p[5]); w.w = cvt_pk_bf16(p[6], p[7]);
                        *(v4u*)dst = w;
                        if (c >= 2048 && l == 0) *(v4u*)(VFp + (size_t)m * RW + (c & 1023)) = w;
                    } else {
                        int dcol;
                        if (c < 3168) { dcol = c - 3072;
#pragma unroll
                            for (int j = 0; j < 8; ++j) p[j] = 1.0f - 2.0f / (1.0f + __expf(2.0f * p[j])); }
                        else if (c < 3264) dcol = 256 + c - 3168;
                        else { dcol = 512 + c - 3264;
#pragma unroll
                            for (int j = 0; j < 8; ++j) p[j] = sigmoidf_(p[j]); }
                        v4u w; w.x = cvt_pk_bf16(p[0], p[1]); w.y = cvt_pk_bf16(p[2], p[3]); w.z = cvt_pk_bf16(p[4], p[5]); w.w = cvt_pk_bf16(p[6], p[7]);
                        *(v4u*)(LORA + (size_t)m * 768 + dcol) = w;
                    }
                }
            }
#pragma unroll 1
            for (int m = gw; m < M; m += NGW)
                if (lane < 40) { const unsigned z0 = (unsigned)lane >> 8; const v4u z = {z0, z0, z0, z0};     *(v4u*)(LORA + (size_t)m * 768 + (lane < 20 ? 96 + 8 * lane : 352 + 8 * (lane - 20))) = z; }
        }
        if (EN(4) && IN(pb + 4)) {
            PH_LOCALS
            const bf16* PROJ = P_PROJ; bf16* Z = P_Z;
            LAS float* BUs = (LAS float*)(lds + wave * 12800);
            LAS unsigned* Ss = (LAS unsigned*)(lds + wave * 12800 + 8448);
            LAS float* Ex = (LAS float*)(lds + 8 * 12800);
            const int g4 = lane >> 4, i16 = lane & 15;
            for (int item = bid; item < 256; item += G) {
                const int b = item >> 6, g = item & 63;
                const float dt = expf(ka->in[12][l * 64 + g]);
                float ab_re, ab_im;
                { const float lam_re = fminf(ka->in[6][(l * 64 + g) * 64 + lane], -1e-4f), lam_im = ka->in[7][(l * 64 + g) * 64 + lane];
                  const float mag = expf(lam_re * dt); ab_re = mag * cosf(lam_im * dt); ab_im = mag * sinf(lam_im * dt); }
                pg8::bf16x8 Abb[8];
#pragma unroll
                for (int mt = 0; mt < 4; ++mt) {
                    const int pp = 16 * mt + i16;
                    const float lam_re = fminf(ka->in[6][(l * 64 + g) * 64 + pp], -1e-4f), lam_im = ka->in[7][(l * 64 + g) * 64 + pp];
                    const float mag = expf(lam_re * dt), are = mag * cosf(lam_im * dt), aim = mag * sinf(lam_im * dt);
                    const float den = lam_re * lam_re + lam_im * lam_im, nre = are - 1.0f;
                    const float cr = (nre * lam_re + aim * lam_im) / den, ci = (aim * lam_re - nre * lam_im) / den;
                    v4u wr_ = {0u, 0u, 0u, 0u}, wi_ = {0u, 0u, 0u, 0u};
                    if (g4 < 2) {
                        const float* bre = ka->in[8] + ((size_t)(l * 64 + g) * 64 + pp) * 16 + 8 * g4; const float* bim = ka->in[9] + ((size_t)(l * 64 + g) * 64 + pp) * 16 + 8 * g4;
                        const f32x4 r0 = *(const f32x4*)bre, r1 = *(const f32x4*)(bre + 4), m0_ = *(const f32x4*)bim, m1_ = *(const f32x4*)(bim + 4);
                        const f32x4 xr0 = cr * r0 - ci * m0_, xr1 = cr * r1 - ci * m1_, xi0 = cr * m0_ + ci * r0, xi1 = cr * m1_ + ci * r1;
                        wr_.x = cvt_pk_bf16(xr0[0], xr0[1]); wr_.y = cvt_pk_bf16(xr0[2], xr0[3]); wr_.z = cvt_pk_bf16(xr1[0], xr1[1]); wr_.w = cvt_pk_bf16(xr1[2], xr1[3]);
                        wi_.x = cvt_pk_bf16(xi0[0], xi0[1]); wi_.y = cvt_pk_bf16(xi0[2], xi0[3]); wi_.z = cvt_pk_bf16(xi1[0], xi1[1]); wi_.w = cvt_pk_bf16(xi1[2], xi1[3]);
                    }
                    Abb[mt] = __builtin_bit_cast(pg8::bf16x8, wr_); Abb[4 + mt] = __builtin_bit_cast(pg8::bf16x8, wi_);
                }
                pg8::bf16x8 Cop[4];
#pragma unroll
                for (int kb = 0; kb < 4; ++kb) {
                    const float* cre = ka->in[10] + ((size_t)(l * 64 + g) * 16 + i16) * 64 + 16 * kb + 4 * g4; const float* cim = ka->in[11] + ((size_t)(l * 64 + g) * 16 + i16) * 64 + 16 * kb + 4 * g4;
                    const f32x4 r = *(const f32x4*)cre, m = *(const f32x4*)cim;
                    v4u w; w.x = cvt_pk_bf16(r[0], -m[0]); w.y = cvt_pk_bf16(r[1], -m[1]); w.z = cvt_pk_bf16(r[2], -m[2]); w.w = cvt_pk_bf16(r[3], -m[3]);
                    Cop[kb] = __builtin_bit_cast(pg8::bf16x8, w);
                }
                const size_t tok0 = (size_t)b * T + wave * 256;
                float s_re = 0.f, s_im = 0.f;
#pragma unroll 1
                for (int pass = 0; pass < 2; ++pass) {
                    v4u uwn = *(const v4u*)(PROJ + (tok0 + i16) * DINP + U_OFF + g * 16 + 8 * (g4 & 1));
#pragma unroll 1
                    for (int st = 0; st < 16; ++st) {
                        const size_t rowt = tok0 + st * 16 + i16;
                        v4u uw = uwn; if (g4 >= 2) { uw.x = 0u; uw.y = 0u; uw.z = 0u; uw.w = 0u; }
                        { const int stn = st < 15 ? st + 1 : 15; uwn = *(const v4u*)(PROJ + (tok0 + stn * 16 + i16) * DINP + U_OFF + g * 16 + 8 * (g4 & 1)); }
                        const v2u uq = *(const v2u*)(PROJ + rowt * DINP + U_OFF + g * 16 + 4 * g4);
                        const pg8::bf16x8 Uop = __builtin_bit_cast(pg8::bf16x8, uw);
#pragma unroll
                        for (int mt = 0; mt < 8; ++mt) { f32x4 d = {0.f, 0.f, 0.f, 0.f}; d = __builtin_amdgcn_mfma_f32_16x16x32_bf16(Abb[mt], Uop, d, 0, 0, 0);
                            *(LAS f32x4*)(BUs + i16 * 132 + 16 * mt + 4 * g4) = d; }
                        asm volatile("s_waitcnt lgkmcnt(0)" ::: "memory");
#pragma unroll
                        for (int tt = 0; tt < 16; ++tt) {
                            const float bur = BUs[tt * 132 + lane], bui = BUs[tt * 132 + 64 + lane];
                            const float nr = ab_re * s_re - ab_im * s_im + bur, ni = ab_re * s_im + ab_im * s_re + bui; s_re = nr; s_im = ni;
                            if (pass == 1) Ss[tt * 68 + lane] = cvt_pk_bf16(s_re, s_im);
                        }
                        asm volatile("s_waitcnt lgkmcnt(0)" ::: "memory");
                        if (pass == 1) {
                            f32x4 y = {0.f, 0.f, 0.f, 0.f};
#pragma unroll
                            for (int kb = 0; kb < 4; ++kb) { const pg8::bf16x8 Sop = *(const LAS pg8::bf16x8*)((const LAS unsigned char*)Ss + i16 * 272 + 64 * kb + 16 * g4);
                                y = __builtin_amdgcn_mfma_f32_16x16x32_bf16(Cop[kb], Sop, y, 0, 0, 0); }
                            const f32x4 dsk = *(const f32x4*)(ka->in[13] + l * 1024 + g * 16 + 4 * g4);
                            const float uu[4] = {bflo(uq.x), bfhi(uq.x), bflo(uq.y), bfhi(uq.y)}; float zz[4];
#pragma unroll
                            for (int i = 0; i < 4; ++i) { const float yy = y[i] + dsk[i] * uu[i]; const float a = 0.7978845608028654f * (yy + 0.044715f * yy * yy * yy);
                                const float th = 1.0f - 2.0f / (1.0f + __expf(2.0f * a)); zz[i] = 0.5f * yy * (1.0f + th); }
                            v2u zo; zo.x = cvt_pk_bf16(zz[0], zz[1]); zo.y = cvt_pk_bf16(zz[2], zz[3]);
                            *(v2u*)(Z + rowt * 1024 + g * 16 + 4 * g4) = zo;
                            asm volatile("s_waitcnt lgkmcnt(0)" ::: "memory");
                        }
                    }
                    if (pass == 0) {
                        Ex[(wave * 64 + lane) * 2] = s_re; Ex[(wave * 64 + lane) * 2 + 1] = s_im;
                        float pr = ab_re, pi = ab_im;
#pragma unroll
                        for (int q = 0; q < 8; ++q) { const float t_ = pr * pr - pi * pi; pi = 2.0f * pr * pi; pr = t_; }
                        __syncthreads();
                        float cr_ = 0.f, ci_ = 0.f;
                        for (int w2 = 0; w2 < wave; ++w2) { const float er = Ex[(w2 * 64 + lane) * 2], ei = Ex[(w2 * 64 + lane) * 2 + 1];
                            const float nr = pr * cr_ - pi * ci_ + er, ni = pr * ci_ + pi * cr_ + ei; cr_ = nr; ci_ = ni; }
                        s_re = cr_; s_im = ci_;
                    }
                }
                __syncthreads();
            }
        }
        if (EN(4) && IN(pb + 4)) {
            PH_LOCALS
            const bf16* PROJ = P_PROJ; bf16* YATT = P_YATT;
            LAS float* Ol = (LAS float*)lds;
            LAS float* Dl = (LAS float*)(lds + 256 * 68 * 4);
            LAS unsigned char* Vs = lds + 256 * 68 * 4 + 1024 + wave * 5120;
            const int g4 = lane >> 4, i16 = lane & 15;
            float mq = fabsf(ka->in[15][l * 64 + lane]), mk = fabsf(ka->in[16][l * 64 + lane]);
#pragma unroll
            for (int o = 32; o >= 1; o >>= 1) { mq = fmaxf(mq, shx(mq, o, lane)); mk = fmaxf(mk, shx(mk, o, lane)); }
            float gq16[16], gk16[16];
#pragma unroll
            for (int j = 0; j < 8; ++j) { gq16[j] = ka->in[15][l * 64 + 8 * g4 + j]; gq16[8 + j] = ka->in[15][l * 64 + 32 + 8 * g4 + j]; gk16[j] = ka->in[16][l * 64 + 8 * g4 + j]; gk16[8 + j] = ka->in[16][l * 64 + 32 + 8 * g4 + j]; }
            const float Mref = 8.5f * mq * mk;
            for (int item = bid; item < 256; item += G) {
                const int b = item >> 6, hh = (item >> 3) & 7, t0 = (item & 7) * 256;
                for (int gi = 0; gi < 3; ++gi) {
                    const int sh = 2 * gi, head = gi * 8 + hh, nts = 16 >> sh, mmax = (T >> sh) - 1;
                    const float slope_d = exp2f(-8.0f * (float)(head + 1) / 24.0f) * (float)(1 << sh);
                    for (int ti = 0; ti < 2; ++ti) {
                        const int tau = wave * 2 + ti, c = tau / nts, mt = tau % nts, m0 = (t0 >> sh) + 16 * mt;
                        const size_t rowq = (size_t)b * T + (size_t)(((m0 + i16) << sh) + c);
                        pg8::bf16x8 qf0, qf1;
                        norm_frag(*(const v4u*)(PROJ + rowq * DINP + Q_OFF + head * 64 + 8 * g4), *(const v4u*)(PROJ + rowq * DINP + Q_OFF + head * 64 + 32 + 8 * g4), gq16, lane, qf0, qf1);
                        f32x4 O0 = {0.f, 0.f, 0.f, 0.f}, O1 = O0, O2 = O0, O3 = O0; float den = 0.f;
                        v4u kfr[2][2]; v4u vrow[4];
#define ATT_LOAD(kp_, KF_, VR_) do { _Pragma("unroll") for (int hf_ = 0; hf_ < 2; ++hf_) { int mkl_ = m0 - 128 + 16 * (2 * (kp_) + hf_) + i16; mkl_ = mkl_ < 0 ? 0 : (mkl_ > mmax ? mmax : mkl_); \
                                const size_t rk_ = (size_t)b * T + (size_t)((mkl_ << sh) + c); KF_[hf_][0] = *(const v4u*)(PROJ + rk_ * DINP + K_OFF + head * 64 + 8 * g4); KF_[hf_][1] = *(const v4u*)(PROJ + rk_ * DINP + K_OFF + head * 64 + 32 + 8 * g4); } \
                            _Pragma("unroll") for (int r_ = 0; r_ < 4; ++r_) { const int ci_ = lane + 64 * r_, key_ = ci_ >> 3, ch_ = ci_ & 7; int mk_ = m0 - 128 + 32 * (kp_) + key_; mk_ = mk_ < 0 ? 0 : (mk_ > mmax ? mmax : mk_); \
                                const size_t rk_ = (size_t)b * T + (size_t)((mk_ << sh) + c); VR_[r_] = *(const v4u*)(PROJ + rk_ * DINP + V_OFF + head * 64 + ch_ * 8); } } while (0)
                        ATT_LOAD(0, kfr, vrow);
#pragma unroll
                        for (int kp = 0; kp < 5; ++kp) {
                            v4u kfn[2][2]; v4u vrn[4];
                            if (kp < 4) ATT_LOAD(kp + 1, kfn, vrn);
#pragma unroll
                            for (int r = 0; r < 4; ++r) { const int ci = lane + 64 * r, key = ci >> 3, ch = ci & 7; *(LAS v4u*)(Vs + key * 160 + ch * 16) = vrow[r]; }
                            float pv[8];
#pragma unroll
                            for (int hf = 0; hf < 2; ++hf) {
                                const int kt = 2 * kp + hf;
                                if (kt == 9) { pv[4] = 0.f; pv[5] = 0.f; pv[6] = 0.f; pv[7] = 0.f; continue; }
                                f32x4 sc = {0.f, 0.f, 0.f, 0.f};
                                pg8::bf16x8 kn0, kn1; norm_frag(kfr[hf][0], kfr[hf][1], gk16, lane, kn0, kn1);
                                sc = __builtin_amdgcn_mfma_f32_16x16x32_bf16(kn0, qf0, sc, 0, 0, 0); sc = __builtin_amdgcn_mfma_f32_16x16x32_bf16(kn1, qf1, sc, 0, 0, 0);
#pragma unroll
                                for (int i = 0; i < 4; ++i) { const int n = 4 * g4 + i, diff = i16 - n + 128 - 16 * kt, mkn = m0 - 128 + 16 * kt + n;
                                    const bool valid = diff >= 0 && diff <= 128 && mkn >= 0;
                                    const float p = valid ? __expf(sc[i] * 0.125f - slope_d * (float)diff - Mref) : 0.f; den += p; pv[hf * 4 + i] = p; }
                            }
                            v4u bw; bw.x = cvt_pk_bf16(pv[0], pv[1]); bw.y = cvt_pk_bf16(pv[2], pv[3]); bw.z = cvt_pk_bf16(pv[4], pv[5]); bw.w = cvt_pk_bf16(pv[6], pv[7]);
                            const pg8::bf16x8 Bp = __builtin_bit_cast(pg8::bf16x8, bw);
                            asm volatile("s_waitcnt lgkmcnt(0)" ::: "memory");
                            const unsigned va = (unsigned)(size_t)(Vs + (4 * g4 + (i16 >> 2)) * 160 + 8 * (i16 & 3));
                            v2u l0, l1, l2, l3, h0, h1, h2, h3;
                            asm volatile("ds_read_b64_tr_b16 %0, %8\n\tds_read_b64_tr_b16 %1, %8 offset:32\n\tds_read_b64_tr_b16 %2, %8 offset:64\n\tds_read_b64_tr_b16 %3, %8 offset:96\n\t"
                                         "ds_read_b64_tr_b16 %4, %8 offset:2560\n\tds_read_b64_tr_b16 %5, %8 offset:2592\n\tds_read_b64_tr_b16 %6, %8 offset:2624\n\tds_read_b64_tr_b16 %7, %8 offset:2656\n\ts_waitcnt lgkmcnt(0)"
                                         : "=&v"(l0), "=&v"(l1), "=&v"(l2), "=&v"(l3), "=&v"(h0), "=&v"(h1), "=&v"(h2), "=&v"(h3) : "v"(va) : "memory");
                            { v4u a; a.x = l0.x; a.y = l0.y; a.z = h0.x; a.w = h0.y; O0 = __builtin_amdgcn_mfma_f32_16x16x32_bf16(__builtin_bit_cast(pg8::bf16x8, a), Bp, O0, 0, 0, 0); }
                            { v4u a; a.x = l1.x; a.y = l1.y; a.z = h1.x; a.w = h1.y; O1 = __builtin_amdgcn_mfma_f32_16x16x32_bf16(__builtin_bit_cast(pg8::bf16x8, a), Bp, O1, 0, 0, 0); }
                            { v4u a; a.x = l2.x; a.y = l2.y; a.z = h2.x; a.w = h2.y; O2 = __builtin_amdgcn_mfma_f32_16x16x32_bf16(__builtin_bit_cast(pg8::bf16x8, a), Bp, O2, 0, 0, 0); }
                            { v4u a; a.x = l3.x; a.y = l3.y; a.z = h3.x; a.w = h3.y; O3 = __builtin_amdgcn_mfma_f32_16x16x32_bf16(__builtin_bit_cast(pg8::bf16x8, a), Bp, O3, 0, 0, 0); }
                            if (kp < 4) {
#pragma unroll
                                for (int hf = 0; hf < 2; ++hf) { kfr[hf][0] = kfn[hf][0]; kfr[hf][1] = kfn[hf][1]; }
#pragma unroll
                                for (int r = 0; r < 4; ++r) vrow[r] = vrn[r];
                            }
                        }
#undef ATT_LOAD
                        den += shx(den, 16, lane); den += shx(den, 32, lane);
                        const int x = ((16 * mt + i16) << sh) + c;
                        LAS f32x4* op = (LAS f32x4*)(Ol + x * 68 + 4 * g4);
                        if (gi == 0) { op[0] = O0; op[4] = O1; op[8] = O2; op[12] = O3; if (g4 == 0) Dl[x] = den; }
                        else { op[0] = op[0] + O0; op[4] = op[4] + O1; op[8] = op[8] + O2; op[12] = op[12] + O3; if (g4 == 0) Dl[x] = Dl[x] + den; }
                    }
                    __syncthreads();
                }
                { const int x = tid >> 1, hf = tid & 1; const float rd = 1.0f / Dl[x]; const LAS f32x4* op = (const LAS f32x4*)(Ol + x * 68 + 32 * hf);
                  bf16* yo = YATT + ((size_t)b * T + t0 + x) * 1024 + hh * 64 + 32 * hf;
#pragma unroll
                  for (int q = 0; q < 4; ++q) { const f32x4 a = op[2 * q] * rd, c2 = op[2 * q + 1] * rd;
                      v4u w; w.x = cvt_pk_bf16(a[0], a[1]); w.y = cvt_pk_bf16(a[2], a[3]); w.z = cvt_pk_bf16(c2[0], c2[1]); w.w = cvt_pk_bf16(c2[2], c2[3]); *(v4u*)(yo + 8 * q) = w; } }
                __syncthreads();
            }
        }
        SEAM(pb + 4); STAMP(pb + 4);
        STAMP(pb + 5);
        if (EN(6) && IN(pb + 6)) {
            { PH_LOCALS
              pg8::Gemm g{P_LORA, (const bf16*)(ws + W_W2), M, RW, 256, 768, 256}; pg8::StaticOrder S; S.init(M, RW, G, l > 0 && G == 256 ? (bid >= 32 && bid < 160 ? bid - 32 : 1 << 20) : bid);
              EpiF<FDecay> E{FDecay{ka->in[18] + l * RW, P_DECAY}}; pg8::gemm_phase<EpiF<FDecay>, pg8::StaticOrder, true, true>(lds + RING_OFF, g, S, E, tid); }
            { PH_LOCALS
              pg8::Gemm g{P_LORA + 256, (const bf16*)(ws + W_A2), M, RW, 256, 768, 256}; pg8::StaticOrder S; S.init(M, RW, G, l > 0 && G == 256 ? (bid >= 160 ? bid - 160 : (bid >= 32 && bid < 64 ? 96 + bid - 32 : 1 << 20)) : (bid + G / 2) % G);
              EpiF<FASig> E{FASig{ka->in[20] + l * RW, P_ASIG}}; pg8::gemm_phase<EpiF<FASig>, pg8::StaticOrder, true, true>(lds + RING_OFF, g, S, E, tid); }
            { PH_LOCALS
              pg8::Gemm g{P_LORA + 512, (const bf16*)(ws + W_G2), M, RW, 256, 768, 256}; pg8::StaticOrder S; S.init(M, RW, G, l > 0 && G == 256 ? (bid >= 64 && bid < 160 ? bid - 64 : (bid >= 160 && bid < 192 ? 96 + bid - 160 : 1 << 20)) : bid);
              EpiF<FStoreBf16> E{FStoreBf16{P_GG, RW}}; pg8::gemm_phase<EpiF<FStoreBf16>, pg8::StaticOrder, true, true>(lds + RING_OFF, g, S, E, tid); }
            if (l > 0) { PH_LOCALS
              pg8::Gemm g{P_AV, (const bf16*)(ws + W_V1), M, 256, RW, RW, RW}; pg8::StaticOrder S; S.init(M, 256, G, G == 256 ? bid : (bid + G / 2) % G);
              EpiF<FStoreBf16> E{FStoreBf16{P_V1O, 256}}; pg8::gemm_phase<EpiF<FStoreBf16>, pg8::StaticOrder, true, true>(lds + RING_OFF, g, S, E, tid); }
        }
        SEAM(pb + 6); STAMP(pb + 6);
        if (EN(7) && IN(pb + 7)) {
            if (l > 0) { PH_LOCALS
              pg8::Gemm g{P_V1O, (const bf16*)(ws + W_V2), M, RW, 256, 256, 256}; pg8::StaticOrder S; S.init(M, RW, G, bid);
              EpiF<FVres> E{FVres{ka->in[28] + (size_t)(l - 1) * RW, P_VP, P_VFIRST}}; pg8::gemm_phase<EpiF<FVres>, pg8::StaticOrder, true, true>(lds + RING_OFF, g, S, E, tid); }
            { PH_LOCALS
              pg8::Gemm g{P_Z, (const bf16*)(ws + W_GLU), M, 1024, 1024, 1024, 1024}; pg8::StaticOrder S; S.init(M, 1024, G, (bid + G / 2) % G);
              EpiF<FGlu> E{FGlu{P_Z, P_YS5}}; pg8::gemm_phase<EpiF<FGlu>, pg8::StaticOrder, true, true>(lds + RING_OFF, g, S, E, tid); }
        }
        STAMP(pb + 7);
        if (EN(8) && IN(pb + 8)) {
            PH_LOCALS
            const float* DECAY = P_DECAY; const bf16* ASIG = P_ASIG; const bf16* KP = P_KP; const bf16* RP = P_RP; const bf16* VP = P_VP; const bf16* KKs = P_KK;
            unsigned char* REC = ws + WS_SBUF;
            const __amdgpu_buffer_rsrc_t rs_w = __builtin_amdgcn_make_buffer_rsrc((void*)DECAY, 0, (int)((size_t)M * RW * 4), 0x00020000), rs_a = __builtin_amdgcn_make_buffer_rsrc((void*)ASIG, 0, (int)((size_t)M * RW * 2), 0x00020000),
                rs_q = __builtin_amdgcn_make_buffer_rsrc((void*)KKs, 0, (int)((size_t)M * RW * 2), 0x00020000), rs_k = __builtin_amdgcn_make_buffer_rsrc((void*)KP, 0, (int)((size_t)M * RW * 2), 0x00020000),
                rs_r = __builtin_amdgcn_make_buffer_rsrc((void*)RP, 0, (int)((size_t)M * RW * 2), 0x00020000);
            LAS unsigned char* wl = lds + wave * 13824;
            const int c16 = lane & 15, g4 = lane >> 4;
            for (int it = gw; it < 8192; it += NGW) {
                const int h = it & 15, c = (it >> 4) & 127, b = it >> 11;
                int ln = lane; asm volatile("" : "+v"(ln));
                const size_t r0 = ((size_t)b * T + c * 16) * RW + h * 64;
                const float kac = (ka->in[24] + l * RW + h * 64)[ln];
                float at[16], rt[16]; unsigned bhp[8], khp[8];
                float Wc = 1.0f;
                {
                    float dw[16]; unsigned short da[16], dq[16], dk[16], dr[16];
#pragma unroll
                    for (int t = 0; t < 16; ++t) { const int r = (int)r0 + t * RW;
                        dw[t] = __builtin_bit_cast(float, __builtin_amdgcn_raw_buffer_load_b32(rs_w, ln * 4, r * 4, 0));
                        da[t] = __builtin_amdgcn_raw_buffer_load_b16(rs_a, ln * 2, r * 2, 0); dq[t] = __builtin_amdgcn_raw_buffer_load_b16(rs_q, ln * 2, r * 2, 0); dk[t] = __builtin_amdgcn_raw_buffer_load_b16(rs_k, ln * 2, r * 2, 0);
                        dr[t] = __builtin_amdgcn_raw_buffer_load_b16(rs_r, ln * 2, r * 2, 0); }
                    __builtin_amdgcn_sched_barrier(0);
#pragma unroll
                    for (int t = 0; t < 16; t += 2) {
                        float bh2[2], kh2[2];
#pragma unroll
                        for (int e = 0; e < 2; ++e) {
                            const float as_ = bf2f(da[t + e]), kk_ = bf2f(dq[t + e]), k_ = bf2f(dk[t + e]), r_ = bf2f(dr[t + e]);
                            const float Wp = Wc; Wc = Wc * dw[t + e]; const float inv = __builtin_amdgcn_rcpf(Wc);
                            at[t + e] = -(Wp * kk_); rt[t + e] = Wc * r_; bh2[e] = kk_ * as_ * inv; kh2[e] = k_ * (1.0f + (as_ - 1.0f) * kac) * inv;
                        }
                        bhp[t >> 1] = cvt_nat(bh2[0], bh2[1]); khp[t >> 1] = cvt_nat(kh2[0], kh2[1]);
                    }
                }
                const __amdgpu_buffer_rsrc_t rs_o = __builtin_amdgcn_make_buffer_rsrc((void*)(REC + (size_t)it * 12288), 0, 12288, 0x00020000);
                {
                    const bool sw = (ln & 8) != 0;
                    v4u lo, hi;
                    lo.x = bhp[0]; lo.y = bhp[1]; lo.z = bhp[2]; lo.w = bhp[3]; hi.x = bhp[4]; hi.y = bhp[5]; hi.z = bhp[6]; hi.w = bhp[7];
                    __builtin_amdgcn_raw_buffer_store_b128(sw ? hi : lo, rs_o, ln * 32 + 4096, 0, 0); __builtin_amdgcn_raw_buffer_store_b128(sw ? lo : hi, rs_o, ln * 32 + 4096 + 16, 0, 0);
                    lo.x = khp[0]; lo.y = khp[1]; lo.z = khp[2]; lo.w = khp[3]; hi.x = khp[4]; hi.y = khp[5]; hi.z = khp[6]; hi.w = khp[7];
                    __builtin_amdgcn_raw_buffer_store_b128(sw ? hi : lo, rs_o, ln * 32 + 6144, 0, 0); __builtin_amdgcn_raw_buffer_store_b128(sw ? lo : hi, rs_o, ln * 32 + 6144 + 16, 0, 0);
                }
                __builtin_amdgcn_raw_buffer_store_b32(__builtin_bit_cast(unsigned, Wc), rs_o, ln * 4, 11264, 0);
#pragma unroll
                for (int t = 0; t < 16; ++t) {
                    *(LAS bf16*)(wl + 0 + t * 144 + ln * 2) = (bf16)(cvt_nat(at[t], 0.f) & 0xffffu);
                    *(LAS bf16*)(wl + 2304 + t * 144 + ln * 2) = (bf16)((t & 1) ? (bhp[t >> 1] >> 16) : (bhp[t >> 1] & 0xffffu));
                    *(LAS bf16*)(wl + 4608 + t * 144 + ln * 2) = (bf16)((t & 1) ? (khp[t >> 1] >> 16) : (khp[t >> 1] & 0xffffu));
                    *(LAS bf16*)(wl + 6912 + t * 144 + ln * 2) = (bf16)(cvt_nat(rt[t], 0.f) & 0xffffu);
                }
                LDS_WAIT(); asm volatile("" ::: "memory");
                {
                    pg8::bf16x8 Aop[2], Bop[2], Kop[2], Rop[2];
#pragma unroll
                    for (int m = 0; m < 2; ++m) { const int o = c16 * 144 + 64 * m + 16 * g4;
                        Aop[m] = *(const LAS pg8::bf16x8*)(wl + 0 + o); Bop[m] = *(const LAS pg8::bf16x8*)(wl + 2304 + o); Kop[m] = *(const LAS pg8::bf16x8*)(wl + 4608 + o); Rop[m] = *(const LAS pg8::bf16x8*)(wl + 6912 + o); }
                    f32x4 nba = {0.f, 0.f, 0.f, 0.f}, nka = nba, nbr = nba, nkr = nba;
#pragma unroll
                    for (int m = 0; m < 2; ++m) {
                        nba = __builtin_amdgcn_mfma_f32_16x16x32_bf16(Aop[m], Bop[m], nba, 0, 0, 0); nka = __builtin_amdgcn_mfma_f32_16x16x32_bf16(Aop[m], Kop[m], nka, 0, 0, 0);
                        nbr = __builtin_amdgcn_mfma_f32_16x16x32_bf16(Rop[m], Bop[m], nbr, 0, 0, 0); nkr = __builtin_amdgcn_mfma_f32_16x16x32_bf16(Rop[m], Kop[m], nkr, 0, 0, 0);
                    }
#pragma unroll
                    for (int e = 0; e < 4; ++e) { const int t = 4 * g4 + e; const bool lt = c16 < t, le = c16 <= t; LAS float* np = (LAS float*)(wl + 9216) + t * 16 + c16;
                        np[0] = lt ? nba[e] : 0.f; np[256] = lt ? nka[e] : 0.f; np[512] = le ? nbr[e] : 0.f; np[768] = le ? nkr[e] : 0.f; }
                }
                LDS_WAIT(); asm volatile("" ::: "memory");
                float a2[16], a4[16];
                {
                    const LAS float* NB_ = (const LAS float*)(wl + 9216);
                    f32x4 nc[4], nn[4]; float rc = NB_[256 + c16], rn = 0.f;
#pragma unroll
                    for (int q = 0; q < 4; ++q) { nc[q] = (f32x4){0.f, 0.f, 0.f, 0.f}; nn[q] = nc[q]; }
#pragma unroll
                    for (int t = 0; t < 16; ++t) {
                        if (t < 15) { rn = NB_[256 + (t + 1) * 16 + c16];
#pragma unroll
                            for (int sq = 0; sq < (t + 4) / 4; ++sq) nn[sq] = *(const LAS f32x4*)(NB_ + (t + 1) * 16 + 4 * sq); }
                        float x1 = at[t], x2 = rc;
#pragma unroll
                        for (int sq = 0; sq < (t + 3) / 4; ++sq) {
#pragma unroll
                            for (int e = 0; e < 4; ++e) if (4 * sq + e < t) { x1 += nc[sq][e] * at[4 * sq + e]; x2 += nc[sq][e] * a2[4 * sq + e]; } }
                        asm volatile("" : "+v"(x1), "+v"(x2) :: "memory");
                        at[t] = x1; a2[t] = x2; rc = rn;
#pragma unroll
                        for (int q = 0; q < 4; ++q) nc[q] = nn[q];
                    }
                    rc = NB_[768 + c16]; nc[0] = *(const LAS f32x4*)(NB_ + 512);
#pragma unroll
                    for (int t = 0; t < 16; ++t) {
                        if (t < 15) { rn = NB_[768 + (t + 1) * 16 + c16];
#pragma unroll
                            for (int sq = 0; sq < (t + 5) / 4; ++sq) nn[sq] = *(const LAS f32x4*)(NB_ + 512 + (t + 1) * 16 + 4 * sq); }
                        float x3 = rt[t], x4 = rc;
#pragma unroll
                        for (int sq = 0; sq < (t + 4) / 4; ++sq) {
#pragma unroll
                            for (int e = 0; e < 4; ++e) if (4 * sq + e <= t) { x3 += nc[sq][e] * at[4 * sq + e]; x4 += nc[sq][e] * a2[4 * sq + e]; } }
                        asm volatile("" : "+v"(x3), "+v"(x4) :: "memory");
                        rt[t] = x3; a4[t] = x4; rc = rn;
#pragma unroll
                        for (int q = 0; q < 4; ++q) nc[q] = nn[q];
                    }
                }
                LDS_WAIT(); asm volatile("" ::: "memory");
#pragma unroll
                for (int t = 0; t < 16; ++t) { const int o = (((ln >> 3) ^ (t >> 1)) << 4) + (ln & 7) * 2;
                    __builtin_amdgcn_raw_buffer_store_b16((bf16)(cvt_nat(at[t], 0.f) & 0xffffu), rs_o, o, t * 128, 0); __builtin_amdgcn_raw_buffer_store_b16((bf16)(cvt_nat(rt[t], 0.f) & 0xffffu), rs_o, o, 2048 + t * 128, 0); }
                if (ln < 16) {
#pragma unroll
                    for (int t = 0; t < 16; ++t) { const int o = (((ln >> 2) ^ (((t >> 3) & 1) << 1)) << 3) + (ln & 3) * 2;
                        __builtin_amdgcn_raw_buffer_store_b16((bf16)(cvt_nat(a2[t], 0.f) & 0xffffu), rs_o, o, 10240 + t * 32, 0); __builtin_amdgcn_raw_buffer_store_b16((bf16)(cvt_nat(a4[t], 0.f) & 0xffffu), rs_o, o, 10752 + t * 32, 0); }
                }
            }
        }
        SEAM(pb + 8); STAMP(pb + 8);
        if (EN(9) && IN(pb + 9)) {
            PH_LOCALS
            constexpr int NB = 10, RECB = 12288, NCH = T / 16;   static_assert(NB * RECB <= LDSCTL_OFF, "chunk ring below the LDS control words");
            const unsigned char* REC = ws + WS_SBUF; bf16* YRAW = P_YRAW;
            for (int item = bid; item < 256; item += G) {
                const int bh = (item & 7) * 8 + (item >> 5), rg = (item >> 3) & 3, b = bh >> 4, h = bh & 15;
                const unsigned char* rbase = REC + ((size_t)b * NCH * 16 + h) * RECB;
                if (wave >= 2) {
                    const int lw = wave - 2;
                    const bool vw = lw == 4;
                    const unsigned char* sbase = vw ? (const unsigned char*)(P_VP + ((size_t)b * T + ((lane & 31) >> 1)) * RW + h * 64 + 16 * rg) + (lane & 1) * 16 : rbase + lw * 2048 + lane * 16;
                    const size_t cstride = vw ? (size_t)16 * RW * 2 : (size_t)16 * RECB; const int o1 = vw ? 0 : 1024;
#define RW_ISSUE(cc) do { const int cc_ = (cc); const int cs_ = cc_ < NCH ? cc_ : NCH - 1; const unsigned char* src_ = sbase + (size_t)cs_ * cstride; \
                        LAS unsigned char* dst_ = lds + (cc_ % NB) * RECB + lw * 2048; \
                        __builtin_amdgcn_global_load_lds((const unsigned*)src_, (LAS unsigned*)dst_, 16, 0, 0); __builtin_amdgcn_global_load_lds((const unsigned*)(src_ + o1), (LAS unsigned*)(dst_ + 1024), 16, 0, 0); } while (0)
#pragma unroll 1
                    for (int cc = 0; cc < NB - 2; ++cc) RW_ISSUE(cc);
#pragma unroll 1
                    for (int c = 0; c < NCH; ++c) {
                        asm volatile("s_waitcnt vmcnt(14)" ::: "memory");   static_assert(2 * (NB - 3) == 14, "counted wait");
                        __builtin_amdgcn_s_barrier();
                        RW_ISSUE(c + NB - 2);
                    }
                    asm volatile("s_waitcnt vmcnt(0)" ::: "memory");
#undef RW_ISSUE
                } else if (wave == 1) {
#pragma unroll 1
                    for (int c = 0; c < NCH; ++c) __builtin_amdgcn_s_barrier();
                } else {
                    const int c16 = lane & 15, g4 = lane >> 4, gs = g4 ^ (((c16 >> 3) & 1) << 1);
                    const int oA0 = c16 * 128 + (((0 + (g4 >> 1)) ^ (c16 >> 1)) << 4) + 8 * (g4 & 1), oA1 = c16 * 128 + (((2 + (g4 >> 1)) ^ (c16 >> 1)) << 4) + 8 * (g4 & 1);
                    const int oA2 = c16 * 128 + (((4 + (g4 >> 1)) ^ (c16 >> 1)) << 4) + 8 * (g4 & 1), oA3 = c16 * 128 + (((6 + (g4 >> 1)) ^ (c16 >> 1)) << 4) + 8 * (g4 & 1);
                    const int oBT = 4096 + c16 * 32 + gs * 8, oVT = 8192 + (4 * g4 + (c16 >> 2)) * 32 + 8 * (c16 & 3), oS2 = 10240 + c16 * 32 + gs * 8, oWL = 11264 + g4 * 16;
                    f32x4 acc0 = {0.f, 0.f, 0.f, 0.f}, acc1 = acc0, acc2 = acc0, acc3 = acc0;
                    bf16* const ybase = YRAW + ((size_t)b * T + 4 * g4) * RW + h * 64 + 16 * rg + c16;
                    struct Ops { v2u a1[4], a3[4], bt[4], kt[4], vt, a2, a4; f32x4 wl[4]; };
#define RW_LD(O_, c_) do { const LAS unsigned char* sb_ = lds + ((c_) % NB) * RECB; \
                        O_.a1[0] = *(const LAS v2u*)(sb_ + oA0); O_.a1[1] = *(const LAS v2u*)(sb_ + oA1); O_.a1[2] = *(const LAS v2u*)(sb_ + oA2); O_.a1[3] = *(const LAS v2u*)(sb_ + oA3); \
                        O_.a3[0] = *(const LAS v2u*)(sb_ + 2048 + oA0); O_.a3[1] = *(const LAS v2u*)(sb_ + 2048 + oA1); O_.a3[2] = *(const LAS v2u*)(sb_ + 2048 + oA2); O_.a3[3] = *(const LAS v2u*)(sb_ + 2048 + oA3); \
                        _Pragma("unroll") for (int jt_ = 0; jt_ < 4; ++jt_) { O_.bt[jt_] = *(const LAS v2u*)(sb_ + oBT + jt_ * 512); O_.kt[jt_] = *(const LAS v2u*)(sb_ + 2048 + oBT + jt_ * 512); O_.wl[jt_] = *(const LAS f32x4*)(sb_ + oWL + jt_ * 64); } \
                        O_.vt = __builtin_bit_cast(v2u, __builtin_amdgcn_ds_read_tr16_b64_v4i16((LAS v4s_*)(sb_ + oVT)));     O_.a2 = *(const LAS v2u*)(sb_ + oS2); O_.a4 = *(const LAS v2u*)(sb_ + 512 + oS2); } while (0)
#define RW_MK(x_, y_, z_, w_) __builtin_bit_cast(pg8::bf16x8, (v4u){(x_), (y_), (z_), (w_)})
#define RW_STEP(O_, c_) do { \
                        const pg8::bf16x8 s0_ = RW_MK(cvt_nat(acc0[0], acc0[1]), cvt_nat(acc0[2], acc0[3]), cvt_nat(acc1[0], acc1[1]), cvt_nat(acc1[2], acc1[3])); \
                        const pg8::bf16x8 s1_ = RW_MK(cvt_nat(acc2[0], acc2[1]), cvt_nat(acc2[2], acc2[3]), cvt_nat(acc3[0], acc3[1]), cvt_nat(acc3[2], acc3[3])); \
                        const pg8::bf16x8 vop_ = RW_MK(O_.vt.x, O_.vt.y, 0u, 0u); \
                        f32x4 u_ = {0.f, 0.f, 0.f, 0.f}, y_ = u_; \
                        u_ = __builtin_amdgcn_mfma_f32_16x16x32_bf16(RW_MK(O_.a1[0].x, O_.a1[0].y, O_.a1[1].x, O_.a1[1].y), s0_, u_, 0, 0, 0); \
                        u_ = __builtin_amdgcn_mfma_f32_16x16x32_bf16(RW_MK(O_.a1[2].x, O_.a1[2].y, O_.a1[3].x, O_.a1[3].y), s1_, u_, 0, 0, 0); \
                        u_ = __builtin_amdgcn_mfma_f32_16x16x32_bf16(RW_MK(O_.a2.x, O_.a2.y, 0u, 0u), vop_, u_, 0, 0, 0); \
                        y_ = __builtin_amdgcn_mfma_f32_16x16x32_bf16(RW_MK(O_.a3[0].x, O_.a3[0].y, O_.a3[1].x, O_.a3[1].y), s0_, y_, 0, 0, 0); \
                        y_ = __builtin_amdgcn_mfma_f32_16x16x32_bf16(RW_MK(O_.a3[2].x, O_.a3[2].y, O_.a3[3].x, O_.a3[3].y), s1_, y_, 0, 0, 0); \
                        y_ = __builtin_amdgcn_mfma_f32_16x16x32_bf16(RW_MK(O_.a4.x, O_.a4.y, 0u, 0u), vop_, y_, 0, 0, 0); \
                        const pg8::bf16x8 uv_ = RW_MK(cvt_nat(u_[0], u_[1]), cvt_nat(u_[2], u_[3]), O_.vt.x, O_.vt.y); \
                        acc0 = __builtin_amdgcn_mfma_f32_16x16x32_bf16(RW_MK(O_.bt[0].x, O_.bt[0].y, O_.kt[0].x, O_.kt[0].y), uv_, acc0, 0, 0, 0); \
                        acc1 = __builtin_amdgcn_mfma_f32_16x16x32_bf16(RW_MK(O_.bt[1].x, O_.bt[1].y, O_.kt[1].x, O_.kt[1].y), uv_, acc1, 0, 0, 0); \
                        acc2 = __builtin_amdgcn_mfma_f32_16x16x32_bf16(RW_MK(O_.bt[2].x, O_.bt[2].y, O_.kt[2].x, O_.kt[2].y), uv_, acc2, 0, 0, 0); \
                        acc3 = __builtin_amdgcn_mfma_f32_16x16x32_bf16(RW_MK(O_.bt[3].x, O_.bt[3].y, O_.kt[3].x, O_.kt[3].y), uv_, acc3, 0, 0, 0); \
                        acc0 *= O_.wl[0]; acc1 *= O_.wl[1]; acc2 *= O_.wl[2]; acc3 *= O_.wl[3]; \
                        bf16* yb_ = ybase + (size_t)(c_) * (16 * RW); \
                        _Pragma("unroll") for (int e_ = 0; e_ < 4; ++e_) yb_[e_ * RW] = (bf16)(cvt_nat(y_[e_], 0.f) & 0xffffu); } while (0)
                    Ops A, B;
                    asm volatile("" ::: "memory"); __builtin_amdgcn_s_barrier(); asm volatile("" ::: "memory");
                    RW_LD(A, 0);
#pragma unroll 1
                    for (int c = 0; c < NCH; c += 2) {
                        asm volatile("" ::: "memory"); __builtin_amdgcn_s_barrier(); asm volatile("" ::: "memory");
                        RW_LD(B, c + 1);
                        RW_STEP(A, c);
                        if (c + 2 < NCH) { asm volatile("" ::: "memory"); __builtin_amdgcn_s_barrier(); asm volatile("" ::: "memory"); RW_LD(A, c + 2); }
                        RW_STEP(B, c + 1);
                    }
#undef RW_LD
#undef RW_MK
#undef RW_STEP
                }
                __syncthreads();
            }
        }
        SEAM(pb + 9); STAMP(pb + 9);
        if (EN(10) && IN(pb + 10)) {
            PH_LOCALS
            const bf16* YRAW = P_YRAW; const bf16* RPp = P_RP; const bf16* KPp = P_KP; const bf16* VPp = P_VP; const bf16* GGp = P_GG; const bf16* ASIGp = P_ASIG; bf16* YRWKV = P_YRWKV;
            const int c = (gw & 3) * 256 + 4 * lane;
            const f32x4 lnw = *(const f32x4*)(ka->in[26] + l * RW + c), lnb = *(const f32x4*)(ka->in[27] + l * RW + c), rk4 = *(const f32x4*)(ka->in[25] + l * RW + c), ka4 = *(const f32x4*)(ka->in[24] + l * RW + c);
            static_assert((M * 4) % 4 == 0, "row quarters");
#pragma unroll 1
            for (int it0 = gw; it0 < M * 4; it0 += 4 * NGW) {
                v2u y4[4], r4[4], k4[4], a4_[4], v4[4], g4_[4];
#pragma unroll
                for (int u = 0; u < 4; ++u) { const int it = it0 + u * NGW; const size_t p = (size_t)(it < M * 4 ? it : it0) * 256 + 4 * lane;
                    y4[u] = *(const v2u*)(YRAW + p); r4[u] = *(const v2u*)(RPp + p); k4[u] = *(const v2u*)(KPp + p); a4_[u] = *(const v2u*)(ASIGp + p); v4[u] = *(const v2u*)(VPp + p); g4_[u] = *(const v2u*)(GGp + p); }
#pragma unroll
                for (int u = 0; u < 4; ++u) { const int it = it0 + u * NGW; if (it < M * 4) {
                    const size_t p = (size_t)it * 256 + 4 * lane;
                    const v2u y_ = y4[u], r_ = r4[u], k_ = k4[u], a_ = a4_[u], v_ = v4[u], g_ = g4_[u];
                    const f32x4 y = {bflo(y_.x), bfhi(y_.x), bflo(y_.y), bfhi(y_.y)};
                    const f32x4 r = {bflo(r_.x), bfhi(r_.x), bflo(r_.y), bfhi(r_.y)}, kp = {bflo(k_.x), bfhi(k_.x), bflo(k_.y), bfhi(k_.y)}, as = {bflo(a_.x), bfhi(a_.x), bflo(a_.y), bfhi(a_.y)},
                                v = {bflo(v_.x), bfhi(v_.x), bflo(v_.y), bfhi(v_.y)}, gg = {bflo(g_.x), bfhi(g_.x), bflo(g_.y), bfhi(g_.y)};
                    const float mean = row16_sum((y[0] + y[1]) + (y[2] + y[3])) * (1.0f / 64);
                    const f32x4 d = y - mean;
                    const float var = row16_sum((d[0] * d[0] + d[1] * d[1]) + (d[2] * d[2] + d[3] * d[3])) * (1.0f / 64);
                    const float rs = rsqrtf(var + 64e-5f);
                    const f32x4 kf = kp * (1.0f + (as - 1.0f) * ka4);
                    const f32x4 t = r * kf * rk4;
                    const float rk = row16_sum((t[0] + t[1]) + (t[2] + t[3]));
                    const f32x4 o = ((d * rs) * lnw + lnb + rk * v) * gg;
                    v2u w; w.x = cvt_pk_bf16(o[0], o[1]); w.y = cvt_pk_bf16(o[2], o[3]);
                    *(v2u*)(YRWKV + p) = w; } }
            }
        }
        SEAM(pb + 10); STAMP(pb + 10);
        if (EN(11) && IN(pb + 11)) {
            PH_LOCALS
            pg8::Gemm g{P_YS5, (const bf16*)(ws + W_BS5), M, D, 1024, 1024, 1024};
            pg8::Seg3Order S; S.init(M, D, G, bid);
            S.A0 = P_YS5; S.B0 = (const bf16*)(ws + W_BS5); S.dA1 = (long)WS_MERGED - (long)WS_YS5; S.dA2 = (long)WS_YRWKV - (long)WS_YS5; S.dB1 = (long)W_BAT2 - (long)W_BS5; S.dB2 = (long)W_BRW - (long)W_BS5;
            S.K0 = 1024; S.K1 = 512; S.K2 = 1024;
            EpiBranch3 E{P_PROJ, P_MERGEDB};
            pg8::gemm_phase<EpiBranch3, pg8::Seg3Order, true, true>(lds + RING_OFF, g, S, E, tid);
        }
        SEAM(pb + 11); STAMP(pb + 11);
        if (EN(12) && IN(pb + 12)) {
            PH_LOCALS
            pg8::Gemm g{P_MERGEDB, (const bf16*)(ws + W_OUT), M, D, D, D, D}; pg8::StaticOrder S; S.init(M, D, G, bid);
            EpiResid E{nullptr, nullptr, P_XB, P_XL, P_SS + (size_t)(3 * l + 2) * M * 32, 1.0f, 1.0f, 0.0f};
            pg8::gemm_phase<EpiResid, pg8::StaticOrder, true, true>(lds + RING_OFF, g, S, E, tid);
        }
        SEAM(pb + 12); STAMP(pb + 12);
        if (EN(13) && IN(pb + 13)) {
            PH_LOCALS
            pg8::Gemm g{P_XB, (const bf16*)(ws + W_UP2), M, NUP, D, D, D}; pg8::StaticOrder S; S.init(M, NUP, G, bid);
            EpiSwiGLU E{P_HID, P_SS + (size_t)(3 * l + 2) * M * 32};
            pg8::gemm_phase<EpiSwiGLU, pg8::StaticOrder, true, true>(lds + RING_OFF, g, S, E, tid);
        }
        SEAM(pb + 13); STAMP(pb + 13);
        if (EN(14) && IN(pb + 14)) {
            PH_LOCALS
            pg8::Gemm g{P_HID, (const bf16*)(ws + W_DN2), M, D, DFF, DFF, DFF}; pg8::StaticOrder S; S.init(M, D, G, bid);
            float psc = 1.0f, psp = 0.0f;
            if (PROBE_ON && l == DEPTH - 1) { const unsigned* a_ = (const unsigned*)(ws + WS_CTL + 128 * 1024); if (PROBE_A >= 0) psc = 1.0f + 1e-5f * (float)a_[PROBE_A >= 0 ? PROBE_A : 0]; if (PROBE_B >= 0) psp = 1e-4f * (float)a_[PROBE_B >= 0 ? PROBE_B : 0]; }
            EpiResid E{nullptr, l == DEPTH - 1 ? ka->out : nullptr, P_XB, P_XL, P_SS + (size_t)(3 * l + 3) * M * 32, 0.5f, psc, psp};
            pg8::gemm_phase<EpiResid, pg8::StaticOrder, true, true>(lds + RING_OFF, g, S, E, tid);
        }
        SEAM(pb + 14); STAMP(pb + 14);
    }
#undef IN
#undef SEAM
}

extern "C" void kernel_launch(void* const* d_in, const int* in_sizes, int n_in, void* d_out, int out_size, void* d_ws, size_t ws_size, hipStream_t stream) {
    static int grid = 0;
    if (grid == 0) {
        if (n_in != 38 || in_sizes[0] != M * D || out_size != M * D || ws_size < WS_END) {
            fprintf(stderr, "kernel_launch: unexpected shapes/workspace (n_in %d, in0 %d, out %d, ws %zu, need %zu); nothing launched\n", n_in, n_in > 0 ? in_sizes[0] : -1, out_size, ws_size, (size_t)WS_END); grid = -1; return; }
        int dev = 0, cus = 0, per_cu = 0;
        if (hipGetDevice(&dev) != hipSuccess || hipDeviceGetAttribute(&cus, hipDeviceAttributeMultiprocessorCount, dev) != hipSuccess) { grid = -1; return; }
        if (hipFuncSetAttribute((const void*)mk_fwd, hipFuncAttributeMaxDynamicSharedMemorySize, LDS_BYTES) != hipSuccess) { fprintf(stderr, "kernel_launch: hipFuncSetAttribute failed\n"); grid = -1; return; }
        if (hipOccupancyMaxActiveBlocksPerMultiprocessor(&per_cu, (const void*)mk_fwd, NWAVES * 64, LDS_BYTES) != hipSuccess || per_cu < 1)
            fprintf(stderr, "kernel_launch: note: occupancy query reports %d workgroups per CU\n", per_cu);
        (void)hipGetLastError();
        grid = cus;
    }
    if (grid < 0) return;
    if (hipMemsetAsync((char*)d_ws + WS_CTL, 0, CTL_ZERO_BYTES, stream) != hipSuccess) { fprintf(stderr, "kernel_launch: memset failed\n"); return; }
#ifdef DBG_ZERO_WS
    (void)hipMemsetAsync((char*)d_ws + CTL_ZERO_BYTES, 0, WS_END - CTL_ZERO_BYTES, stream);
#endif
    Args a{};
    for (int i = 0; i < 38; ++i) a.in[i] = (const float*)d_in[i];
    a.out = (float*)d_out; a.ws = (unsigned char*)d_ws; a.pad = 0;
#if MK_ONE_LAUNCH
    a.ph_lo = 0; a.ph_hi = NPHASES; a.use_bar = 1;
    hipLaunchKernelGGL(mk_fwd, dim3(grid), dim3(NWAVES * 64), LDS_BYTES, stream, a);
#else
    for (int ph = 0; ph < NPHASES; ++ph) {
        a.ph_lo = ph; a.ph_hi = ph + 1; a.use_bar = 0;
        hipLaunchKernelGGL(mk_fwd, dim3(grid), dim3(NWAVES * 64), LDS_BYTES, stream, a);
    }
#endif
    const hipError_t le = hipPeekAtLastError();
    if (le != hipSuccess) fprintf(stderr, "kernel_launch: launch failed: %s\n", hipGetErrorName(le));
}
```

```cpp
#include <hip/hip_runtime.h>
#include <cstdio>
#include <cstdint>

#ifndef PROBE_A
#define PROBE_A -1
#endif
#ifndef PROBE_B
#define PROBE_B -1
#endif
#define PROBE_ON (PROBE_A >= 0 || PROBE_B >= 0)
#ifndef MK_ONE_LAUNCH
#define MK_ONE_LAUNCH 1
#endif

namespace pg8 {
#define PG8_LAS __attribute__((address_space(3)))
typedef unsigned short bf16_t;
typedef short bf16x8 __attribute__((ext_vector_type(8)));
typedef float f32x4 __attribute__((ext_vector_type(4)));
typedef unsigned u32x4 __attribute__((ext_vector_type(4)));
constexpr int BM = 256, BK = 64, HALF = 128, HTB = HALF * BK * 2, STAGE_BYTES = 8 * HTB, NXCD = 8, WGM = 8;

__host__ __device__ __forceinline__ int lds_byte(int r, int c) { const int st = (r >> 4) * 2 + (c >> 5), rr = r & 15, cc = c & 31, ob = rr * 64 + cc * 2; return st * 1024 + (ob ^ (((ob >> 9) & 1) << 5)); }
__host__ __device__ __forceinline__ void stage_rc(int b, int& R, int& C) { const int st = b / 1024, sb = b % 1024, swz = sb ^ (((sb >> 9) & 1) << 5); R = (st >> 1) * 16 + swz / 64; C = (st & 1) * 32 + (swz % 64) / 2; }
__host__ __device__ __forceinline__ int perm32(int rho) { const int n = rho >> 4, i = rho & 15; return 8 * (i >> 2) + 4 * n + (i & 3); }

struct Unit { int pm, pn, seg; };
struct Gemm { const bf16_t* A; const bf16_t* Bt; int M, N, K, lda, ldb; };

struct StaticOrder {
    int nM, nN, nwg, G, c;
    __host__ __device__ void init(int M, int N, int G_, int c_) { nM = M / BM; nN = N / BM; nwg = nM * nN; G = G_; c = c_; }
    __host__ __device__ bool next(int i, Unit& u) const {
        const long L = (long)i * G + c; if (L >= nwg) return false;
        int wgid = (int)L; { const int q = nwg / NXCD, r = nwg % NXCD, xcd = wgid % NXCD, off = wgid / NXCD; wgid = (xcd < r ? xcd * (q + 1) : r * (q + 1) + (xcd - r) * q) + off; }
        const int nig = WGM * nN, gid = wgid / nig, fm = gid * WGM, gsz = (nM - fm) < WGM ? (nM - fm) : WGM;
        u.pm = fm + ((wgid % nig) % gsz); u.pn = (wgid % nig) / gsz; u.seg = 0; return true;
    }
    __device__ __forceinline__ void a_ready(const Unit&) const {}
    __device__ __forceinline__ void done(const Unit&) const {}
    __device__ __forceinline__ const char* a_base(const Gemm& g, const Unit& u, size_t tstepA) const { return (const char*)g.A + (size_t)u.pm * tstepA; }
    __device__ __forceinline__ const char* b_base(const Gemm& g, const Unit& u, size_t tstepB) const { return (const char*)g.Bt + (size_t)u.pn * tstepB; }
    __device__ __forceinline__ int ktiles(const Gemm& g, const Unit&) const { return g.K / BK; }
};
struct Seg3Order : StaticOrder {
    const bf16_t *A0, *B0; long dA1, dA2, dB1, dB2; int K0, K1, K2;
    __host__ __device__ bool next(int i, Unit& u) const { const bool ok = StaticOrder::next(i / 3, u); u.seg = i % 3; return ok; }
    __device__ __forceinline__ const char* a_base(const Gemm&, const Unit& u, size_t tstepA) const { long d1 = dA1, d2 = dA2; asm volatile("" : "+s"(d1), "+s"(d2)); const long d = u.seg == 1 ? d1 : (u.seg == 2 ? d2 : 0); return (const char*)A0 + d + (size_t)u.pm * tstepA; }
    __device__ __forceinline__ const char* b_base(const Gemm&, const Unit& u, size_t tstepB) const { long d1 = dB1, d2 = dB2; asm volatile("" : "+s"(d1), "+s"(d2)); const long d = u.seg == 1 ? d1 : (u.seg == 2 ? d2 : 0); return (const char*)B0 + d + (size_t)u.pn * tstepB; }
    __device__ __forceinline__ int ktiles(const Gemm&, const Unit& u) const { int k0 = K0, k1 = K1, k2 = K2; asm volatile("" : "+s"(k0), "+s"(k1), "+s"(k2)); return (u.seg == 1 ? k1 : (u.seg == 2 ? k2 : k0)) / BK; }
};

__device__ __forceinline__ unsigned cvt_pk_bf16(float lo, float hi) { unsigned r; asm volatile("v_cvt_pk_bf16_f32 %0, %1, %2" : "=v"(r) : "v"(lo), "v"(hi)); return r; }

template <class Epi, class Sched, bool ALIGN_EPI = false, bool SP2 = false>
__device__ __forceinline__ void gemm_phase(PG8_LAS unsigned char* lds, const Gemm g, const Sched& S, const Epi& E, int tid_) {
    asm volatile("" : "+v"(tid_));
    const int tid = tid_, wid = __builtin_amdgcn_readfirstlane(tid >> 6), lane = tid & 63, wr = wid >> 2, wc = wid & 3, fr = lane & 15, fq = lane >> 4;
    unsigned voffA[2], voffB[2];
#pragma unroll
    for (int i = 0; i < 2; ++i) { int R, C; stage_rc(tid * 16 + i * 8192, R, C); const int Rb = Epi::PERM ? ((R & ~31) + perm32(R & 31)) : R;
        voffA[i] = (unsigned)(R * g.lda + C) * 2u; voffB[i] = (unsigned)(Rb * g.ldb + C) * 2u; }
    const size_t kstep = (size_t)(BK * 2);
    const size_t hstepA = (size_t)HALF * g.lda * 2, hstepB = (size_t)HALF * g.ldb * 2;
    const size_t tstepA = 2 * hstepA, tstepB = 2 * hstepB;
    const unsigned ldsw = (unsigned)wid * 1024u;
    const int aoff = lds_byte(wr * 64 + fr, fq * 8), boff = lds_byte(wc * 32 + fr, fq * 8);
#define PG8_SA(b, h) (((b) * 2 + (h)) * HTB)
#define PG8_SB(b, h) ((4 + (b) * 2 + (h)) * HTB)
#define PG8_STAGE(bufoff, gbase, voff) do { _Pragma("unroll") for (int _i = 0; _i < 2; ++_i) \
        __builtin_amdgcn_global_load_lds((const unsigned*)((const char*)(gbase) + (voff)[_i]), (PG8_LAS unsigned*)(lds + (bufoff) + ldsw + _i * 8192), 16, 0, 0); } while (0)
#define PG8_LDA(dst, b, h) do { _Pragma("unroll") for (int m = 0; m < 4; ++m) _Pragma("unroll") for (int k = 0; k < 2; ++k) dst[m][k] = *(const PG8_LAS bf16x8*)(lds + PG8_SA(b, h) + aoff + m * 2048 + k * 1024); } while (0)
#define PG8_LDB(dst, b, h) do { _Pragma("unroll") for (int n = 0; n < 2; ++n) _Pragma("unroll") for (int k = 0; k < 2; ++k) dst[n][k] = *(const PG8_LAS bf16x8*)(lds + PG8_SB(b, h) + boff + n * 2048 + k * 1024); } while (0)
#define PG8_MMA(ai, bj, At, Bt) do { __builtin_amdgcn_s_setprio(1); _Pragma("unroll") for (int m = 0; m < 4; ++m) _Pragma("unroll") for (int n = 0; n < 2; ++n) _Pragma("unroll") for (int k = 0; k < 2; ++k) \
        acc[ai][bj][m][n] = __builtin_amdgcn_mfma_f32_16x16x32_bf16(Bt[n][k], At[m][k], acc[ai][bj][m][n], 0, 0, 0); __builtin_amdgcn_s_setprio(0); } while (0)
#define PG8_WAIT_V(n) asm volatile("s_waitcnt vmcnt(" #n ")" ::: "memory")
#define PG8_WAIT_L(n) asm volatile("s_waitcnt lgkmcnt(" #n ")" ::: "memory")
#define PG8_BAR __builtin_amdgcn_s_barrier()
#define PG8_SCHED __builtin_amdgcn_sched_barrier(0)
    Unit cur, nxt; int ui = 0;
    if (!S.next(0, cur)) return;
    f32x4 acc[2][2][4][2];
#pragma unroll
    for (int a = 0; a < 2; ++a)
#pragma unroll
        for (int b = 0; b < 2; ++b)
#pragma unroll
            for (int m = 0; m < 4; ++m)
#pragma unroll
                for (int n = 0; n < 2; ++n) acc[a][b][m][n] = (f32x4){0.f, 0.f, 0.f, 0.f};
    bf16x8 At[4][2], B0[2][2], B1[2][2];
    const char* cA = S.a_base(g, cur, tstepA); const char* cB = S.b_base(g, cur, tstepB);
    S.a_ready(cur);
    if constexpr (SP2) {
        PG8_STAGE(PG8_SB(0, 0), cB, voffB); PG8_STAGE(PG8_SB(0, 1), cB + hstepB, voffB); PG8_STAGE(PG8_SA(0, 0), cA, voffA); PG8_STAGE(PG8_SA(0, 1), cA + hstepA, voffA);
        if (wr == 1) PG8_BAR;
        PG8_WAIT_V(2); PG8_BAR;
        PG8_STAGE(PG8_SB(1, 0), cB + kstep, voffB); PG8_STAGE(PG8_SA(1, 0), cA + kstep, voffA); PG8_STAGE(PG8_SB(1, 1), cB + hstepB + kstep, voffB);
        PG8_WAIT_V(6); PG8_BAR;
    } else {
        PG8_STAGE(PG8_SB(0, 0), cB, voffB); PG8_STAGE(PG8_SA(0, 0), cA, voffA); PG8_STAGE(PG8_SB(0, 1), cB + hstepB, voffB); PG8_STAGE(PG8_SA(0, 1), cA + hstepA, voffA);
        if (wr == 1) PG8_BAR;
        PG8_WAIT_V(4); PG8_BAR;
        PG8_STAGE(PG8_SB(1, 0), cB + kstep, voffB); PG8_STAGE(PG8_SA(1, 0), cA + kstep, voffA); PG8_STAGE(PG8_SB(1, 1), cB + hstepB + kstep, voffB);
        PG8_WAIT_V(6); PG8_BAR;
    }
    for (;;) {
        const bool has_next = S.next(ui + 1, nxt);
        const char* nA = has_next ? S.a_base(g, nxt, tstepA) : cA; const char* nB = has_next ? S.b_base(g, nxt, tstepB) : cB;
        const int nt = S.ktiles(g, cur);
        for (int t = 0; t < nt; t += 2) {
            const bool last = (t == nt - 2);
            const char* a1 = cA + (size_t)(t + 1) * kstep;
            const char* a2 = last ? nA : cA + (size_t)(t + 2) * kstep; const char* b2 = last ? nB : cB + (size_t)(t + 2) * kstep;
            const char* a3 = a2 + kstep; const char* b3 = b2 + kstep;
            if (last && has_next) S.a_ready(nxt);
            if constexpr (SP2) {
            PG8_LDB(B0, 0, 0); PG8_LDB(B1, 0, 1); PG8_SCHED; PG8_LDA(At, 0, 0); PG8_STAGE(PG8_SA(1, 1), a1 + hstepA, voffA);
            PG8_WAIT_V(8); PG8_WAIT_L(0); PG8_BAR; PG8_MMA(0, 0, At, B0); PG8_MMA(0, 1, At, B1); PG8_BAR; PG8_SCHED;
            PG8_LDA(At, 0, 1); PG8_STAGE(PG8_SB(0, 0), b2, voffB); PG8_STAGE(PG8_SB(0, 1), b2 + hstepB, voffB); PG8_STAGE(PG8_SA(0, 0), a2, voffA);
            PG8_WAIT_V(8); PG8_WAIT_L(0); PG8_BAR; PG8_MMA(1, 0, At, B0); PG8_MMA(1, 1, At, B1); PG8_BAR; PG8_SCHED;
            PG8_LDB(B0, 1, 0); PG8_LDB(B1, 1, 1); PG8_SCHED; PG8_LDA(At, 1, 0); PG8_STAGE(PG8_SA(0, 1), a2 + hstepA, voffA);
            PG8_WAIT_V(8); PG8_WAIT_L(0); PG8_BAR; PG8_MMA(0, 0, At, B0); PG8_MMA(0, 1, At, B1); PG8_BAR; PG8_SCHED;
            PG8_LDA(At, 1, 1); PG8_STAGE(PG8_SB(1, 0), b3, voffB); PG8_STAGE(PG8_SB(1, 1), b3 + hstepB, voffB); PG8_STAGE(PG8_SA(1, 0), a3, voffA);
            PG8_WAIT_V(8); PG8_WAIT_L(0); PG8_BAR; PG8_MMA(1, 0, At, B0); PG8_MMA(1, 1, At, B1); PG8_BAR; PG8_SCHED;
            } else {
            PG8_LDB(B0, 0, 0); PG8_SCHED; PG8_LDA(At, 0, 0); PG8_STAGE(PG8_SA(1, 1), a1 + hstepA, voffA);
            PG8_WAIT_L(8); PG8_BAR; PG8_WAIT_L(0); PG8_MMA(0, 0, At, B0); PG8_BAR; PG8_SCHED;
            PG8_LDB(B1, 0, 1); PG8_STAGE(PG8_SB(0, 0), b2, voffB);
            PG8_BAR; PG8_WAIT_L(0); PG8_MMA(0, 1, At, B1); PG8_BAR;
            PG8_LDA(At, 0, 1); PG8_STAGE(PG8_SA(0, 0), a2, voffA);
            PG8_BAR; PG8_WAIT_L(0); PG8_MMA(1, 0, At, B0); PG8_BAR; PG8_SCHED;
            PG8_STAGE(PG8_SB(0, 1), b2 + hstepB, voffB);
            PG8_WAIT_V(6); PG8_BAR; PG8_MMA(1, 1, At, B1); PG8_BAR;
            PG8_LDB(B0, 1, 0); PG8_SCHED; PG8_LDA(At, 1, 0); PG8_STAGE(PG8_SA(0, 1), a2 + hstepA, voffA);
            PG8_WAIT_L(8); PG8_BAR; PG8_WAIT_L(0); PG8_MMA(0, 0, At, B0); PG8_BAR; PG8_SCHED;
            PG8_LDB(B1, 1, 1); PG8_STAGE(PG8_SB(1, 0), b3, voffB);
            PG8_BAR; PG8_WAIT_L(0); PG8_MMA(0, 1, At, B1); PG8_BAR;
            PG8_LDA(At, 1, 1); PG8_STAGE(PG8_SA(1, 0), a3, voffA);
            PG8_BAR; PG8_WAIT_L(0); PG8_MMA(1, 0, At, B0); PG8_BAR; PG8_SCHED;
            PG8_STAGE(PG8_SB(1, 1), b3 + hstepB, voffB);
            PG8_WAIT_V(6); PG8_BAR; PG8_MMA(1, 1, At, B1); PG8_BAR;
            }
        }
        if constexpr (ALIGN_EPI) { if (wr == 0) PG8_BAR; }
        E(acc, cur, wr, wc, fr, fq); S.done(cur);
        if (!has_next) break;
        if (!(Epi::KEEP && E.keep(cur))) {
#pragma unroll
        for (int a = 0; a < 2; ++a)
#pragma unroll
            for (int b = 0; b < 2; ++b)
#pragma unroll
                for (int m = 0; m < 4; ++m)
#pragma unroll
                    for (int n = 0; n < 2; ++n) acc[a][b][m][n] = (f32x4){0.f, 0.f, 0.f, 0.f};
        }
        cur = nxt; cA = nA; cB = nB; ++ui;
        if constexpr (ALIGN_EPI) { if (wr == 1) PG8_BAR; }
    }
    PG8_WAIT_V(0);
    if constexpr (!ALIGN_EPI) { if (wr == 0) PG8_BAR; }
    PG8_BAR;
#undef PG8_SA
#undef PG8_SB
#undef PG8_STAGE
#undef PG8_LDA
#undef PG8_LDB
#undef PG8_MMA
#undef PG8_WAIT_V
#undef PG8_WAIT_L
#undef PG8_BAR
#undef PG8_SCHED
}
}

constexpr int NWAVES = 8;
constexpr int M = 8192, T = 2048, D = 2048, DFF = 5504, NUP = 2 * DFF, DIN = 15296, DINP = 15360, DEPTH = 4;
constexpr int U_OFF = 0, Q_OFF = 1024, K_OFF = 2560, V_OFF = 4096, RW_OFF = 5632, GATE_OFF = 9152;
constexpr int RWP = 3520, RW = 1024, AW = 1536;
constexpr float RMS_EPS = 1e-6f;
constexpr int NPH = 15;
constexpr int NPHASES = 1 + DEPTH * NPH;

constexpr size_t MiB = 1u << 20;
constexpr size_t WS_CTL = 0, CTL_ZERO_BYTES = 1 * MiB;
constexpr int CW_BAR = 4096;
constexpr size_t SS_OFF = 256 * 1024;
constexpr size_t WS_X = 1 * MiB;
constexpr size_t WS_XB = WS_X + 64 * MiB;
constexpr size_t WS_HID = WS_XB + 32 * MiB;
constexpr size_t WS_PROJ = WS_HID + 86 * MiB;
constexpr size_t WS_W = WS_PROJ + 240 * MiB;
constexpr size_t W_UP1 = WS_W, W_DN1 = W_UP1 + 43 * MiB, W_IN = W_DN1 + 22 * MiB, W_GLU = W_IN + 60 * MiB, W_W2 = W_GLU + 2 * MiB, W_A2 = W_W2 + MiB / 2,
                 W_G2 = W_A2 + MiB / 2, W_V1 = W_G2 + MiB / 2, W_V2 = W_V1 + MiB / 2, W_BS5 = W_V2 + MiB / 2, W_BAT = W_BS5 + 4 * MiB, W_BRW = W_BAT + 2 * MiB,
                 W_OUT = W_BRW + 4 * MiB, W_UP2 = W_OUT + 8 * MiB, W_DN2 = W_UP2 + 43 * MiB, W_BAT2 = W_DN2 + 22 * MiB, WS_WEND = W_BAT2 + 4 * MiB;
constexpr size_t WS_RP = WS_WEND, WS_KP = WS_RP + 32 * MiB, WS_VP = WS_KP + 32 * MiB, WS_DECAY = WS_VP + 32 * MiB, WS_ASIG = WS_DECAY + 32 * MiB, WS_G = WS_ASIG + 32 * MiB,
                 WS_KK = WS_G + 32 * MiB, WS_VFIRST = WS_KK + 32 * MiB, WS_YRAW = WS_VFIRST + 32 * MiB;
constexpr size_t WS_LORA = WS_YRAW + 32 * MiB;
constexpr size_t WS_AV = WS_LORA + 12 * MiB;
constexpr size_t WS_V1O = WS_AV + 16 * MiB;
constexpr size_t WS_QN = WS_V1O + 4 * MiB, WS_KN = WS_QN + 24 * MiB;
constexpr size_t WS_Z = WS_KN + 24 * MiB, WS_YS5 = WS_Z + 16 * MiB, WS_YATT = WS_YS5 + 16 * MiB, WS_YRWKV = WS_YATT + 8 * MiB;
constexpr size_t WS_MERGED = WS_YRWKV + 16 * MiB, WS_MERGEDB = WS_MERGED + 64 * MiB;
constexpr size_t WS_SBUF = WS_MERGEDB + 32 * MiB;
constexpr size_t WS_SSP = WS_SBUF + 256 * MiB;
constexpr size_t WS_END = WS_SSP + 16 * MiB;

constexpr int RING_OFF = 0, RING_BYTES = 131072, LDSCTL_OFF = 143360, LDS_BYTES = 147456;

#define GAS __attribute__((address_space(1)))
#define LAS __attribute__((address_space(3)))
typedef unsigned short bf16;
typedef unsigned v4u __attribute__((ext_vector_type(4)));
typedef unsigned v2u __attribute__((ext_vector_type(2)));
typedef float f32x4 __attribute__((ext_vector_type(4)));
typedef float f32x2 __attribute__((ext_vector_type(2)));
typedef short v4s_ __attribute__((ext_vector_type(4)));
#define LDS_WAIT() asm volatile("s_waitcnt lgkmcnt(0)" ::: "memory")
#define VM_WAIT() asm volatile("s_waitcnt vmcnt(0)" ::: "memory")
__device__ __forceinline__ unsigned f2bf(float f) { unsigned u = __builtin_bit_cast(unsigned, f); return (u + 0x7fffu + ((u >> 16) & 1u)) >> 16; }
__device__ __forceinline__ unsigned pk2(float lo, float hi) { return f2bf(lo) | (f2bf(hi) << 16); }
typedef __bf16 bf16n2 __attribute__((ext_vector_type(2)));
__device__ __forceinline__ unsigned cvt_nat(float lo, float hi) { const f32x2 v = {lo, hi}; return __builtin_bit_cast(unsigned, __builtin_convertvector(v, bf16n2)); }
__device__ __forceinline__ float bf2f(unsigned short b) { return __builtin_bit_cast(float, (unsigned)b << 16); }
__device__ __forceinline__ float bflo(unsigned w) { return __builtin_bit_cast(float, w << 16); }
__device__ __forceinline__ float bfhi(unsigned w) { return __builtin_bit_cast(float, w & 0xffff0000u); }
__device__ __forceinline__ float shx(float v, int o, int lane) { return __builtin_bit_cast(float, __builtin_amdgcn_ds_bpermute((lane ^ o) << 2, __builtin_bit_cast(int, v))); }
__device__ __forceinline__ float wave_sum(float v, int lane) {
#pragma unroll
    for (int o = 32; o >= 1; o >>= 1) v += shx(v, o, lane);
    return v;
}
__device__ __forceinline__ float row16_sum(float v) {
    v += __builtin_bit_cast(float, __builtin_amdgcn_update_dpp(0, __builtin_bit_cast(int, v), 0x128, 0xf, 0xf, false));
    v += __builtin_bit_cast(float, __builtin_amdgcn_update_dpp(0, __builtin_bit_cast(int, v), 0x124, 0xf, 0xf, false));
    v += __builtin_bit_cast(float, __builtin_amdgcn_update_dpp(0, __builtin_bit_cast(int, v), 0x122, 0xf, 0xf, false));
    v += __builtin_bit_cast(float, __builtin_amdgcn_update_dpp(0, __builtin_bit_cast(int, v), 0x121, 0xf, 0xf, false));
    return v;
}
__device__ __forceinline__ float sigmoidf_(float x) { return 1.0f / (1.0f + __expf(-x)); }

#define XB_TMO      128
#define XB_XCNT(j)  (256  + 64 * (j))
#define XB_XSUB(j)  (1280 + 64 * (j))
#define XB_XGEN(j)  (2304 + 64 * (j))
#define XB_TOP      3328
#define XB_TOPGEN   3392
#define XCD_BAR_WORDS 3456
#define XB_SPIN_CAP (1u << 18)
__device__ __forceinline__ unsigned xb_ld(unsigned* p)              { return __hip_atomic_load(p, __ATOMIC_RELAXED, __HIP_MEMORY_SCOPE_AGENT); }
__device__ __forceinline__ unsigned xb_add(unsigned* p, unsigned v) { return __hip_atomic_fetch_add(p, v, __ATOMIC_RELAXED, __HIP_MEMORY_SCOPE_AGENT); }
__device__ __forceinline__ unsigned xb_xcc_id() { return (unsigned)__builtin_amdgcn_s_getreg((3 << 11) | 20) & 0xFu; }
#define XB_SPIN(cond, bar) do { unsigned _sp = 0; while (cond) { __builtin_amdgcn_s_sleep(1); \
    if ((++_sp & 255u) == 0u) { if (xb_ld(&(bar)[XB_TMO])) break; if (_sp > XB_SPIN_CAP) { atomicAdd(&(bar)[XB_TMO], 1u); break; } } } } while (0)
struct XcdBarrier { unsigned* bar; unsigned x; volatile LAS unsigned* st; };
__device__ __forceinline__ XcdBarrier xcd_barrier_post(unsigned* bar, volatile LAS unsigned* st) {
    XcdBarrier b; b.bar = bar; b.x = xb_xcc_id(); b.st = st;
    if (threadIdx.x == 0) (void)xb_add(&bar[XB_XCNT(b.x)], 1u);
    return b;
}
__device__ __forceinline__ void xcd_barrier_complete(unsigned* bar, unsigned x, unsigned& nloc, unsigned& nx) {
    const unsigned G = gridDim.x * gridDim.y * gridDim.z;
    unsigned sum, cnt, mine, sp = 0u;
    for (;;) {
        sum = 0u; cnt = 0u; mine = 0u;
#pragma unroll
        for (unsigned j = 0; j < 16; ++j) { const unsigned c = xb_ld(&bar[XB_XCNT(j)]); sum += c; cnt += (c > 0u) ? 1u : 0u; mine = (j == x) ? c : mine; }
        if (sum == G) break;
        __builtin_amdgcn_s_sleep(1);
        if ((++sp & 255u) == 0u) { if (xb_ld(&bar[XB_TMO])) break; if (sp > XB_SPIN_CAP) { atomicAdd(&bar[XB_TMO], 1u); break; } }
    }
    nloc = mine > 0u ? mine : 1u; nx = cnt > 0u ? cnt : 1u;
}
__device__ __forceinline__ void xcd_barrier(const XcdBarrier& b) {
    asm volatile("s_waitcnt vmcnt(0)" ::: "memory");
    __syncthreads();
    if (threadIdx.x == 0) {
        unsigned* bar = b.bar;
        __builtin_amdgcn_s_waitcnt(0);
        unsigned nloc = b.st[0], nx = b.st[1];
        if (nloc == 0u) { xcd_barrier_complete(bar, b.x, nloc, nx); b.st[0] = nloc; b.st[1] = nx; }
        const unsigned old = xb_add(&bar[XB_XSUB(b.x)], 1u);
        const unsigned gen = old / nloc;
        if (old + 1u == (gen + 1u) * nloc) {
            __builtin_amdgcn_fence(__ATOMIC_RELEASE, "agent");
            asm volatile("s_waitcnt vmcnt(0)" ::: "memory");
            const unsigned og = xb_add(&bar[XB_TOP], 1u);
            const unsigned tg = og / nx;
            if (og + 1u == (tg + 1u) * nx) {
#pragma unroll
                for (unsigned j = 0; j < 16; ++j) (void)xb_add(&bar[XB_XGEN(j)], 1u);
            }
        }
        XB_SPIN(xb_ld(&bar[XB_XGEN(b.x)]) == gen, bar);
        __builtin_amdgcn_fence(__ATOMIC_ACQUIRE, "agent");
        asm volatile("s_waitcnt vmcnt(0)" ::: "memory");
    }
    __syncthreads();
}

using pg8::Unit; using pg8::cvt_pk_bf16;
__device__ __forceinline__ int fresh_lane() { int l; asm volatile("v_mbcnt_lo_u32_b32 %0, -1, 0\n\tv_mbcnt_hi_u32_b32 %0, -1, %0" : "=v"(l)); return l; }
typedef const f32x4 (&AccRef)[2][2][4][2];

__device__ __forceinline__ float row_rstd(const float* ssp, int row) {
    const f32x4* p = (const f32x4*)(ssp + (size_t)row * 32); float s = 0.f;
#pragma unroll
    for (int j = 0; j < 8; ++j) { const f32x4 v = p[j]; s += (v.x + v.y) + (v.z + v.w); }
    return rsqrtf(s * (1.0f / D) + RMS_EPS);
}
__device__ __forceinline__ void rows_rstd(const float* ssp, int row0, int fq, int ln, float (&rs)[8]) {
    f32x4 a[8], b[8];
#pragma unroll
    for (int q = 0; q < 8; ++q) { const f32x4* p = (const f32x4*)(ssp + (size_t)(row0 + (q >> 2) * 128 + (q & 3) * 16) * 32 + 8 * fq); a[q] = p[0]; b[q] = p[1]; }
#pragma unroll
    for (int q = 0; q < 8; ++q) { float s = ((a[q].x + a[q].y) + (a[q].z + a[q].w)) + ((b[q].x + b[q].y) + (b[q].z + b[q].w));
        s += shx(s, 16, ln); s += shx(s, 32, ln); rs[q] = rsqrtf(s * (1.0f / D) + RMS_EPS); }
}
__device__ __forceinline__ void store16_wt(__amdgpu_buffer_rsrc_t rsrc, unsigned byte_off, v4u v) { __builtin_amdgcn_raw_buffer_store_b128(v, rsrc, byte_off, 0, 16); }
struct EpiSwiGLU {
    static constexpr bool PERM = true, KEEP = false;
    __device__ __forceinline__ bool keep(const Unit&) const { return false; }
    bf16* H; const float* ss;
    __device__ __forceinline__ void operator()(AccRef acc, const Unit& u, int wr, int wc, int, int) const {
        const int ln_ = fresh_lane(), fr = ln_ & 15, fq = ln_ >> 4;
        const int row0 = u.pm * 256 + wr * 64 + fr, col0 = u.pn * 128 + wc * 32 + 8 * fq;
        const __amdgpu_buffer_rsrc_t rsrc = __builtin_amdgcn_make_buffer_rsrc((void*)H, 0, (int)((size_t)M * DFF * 2), 0x00020000);
        float rs[8]; rows_rstd(ss, row0, fq, ln_, rs);
#pragma unroll
        for (int ai = 0; ai < 2; ++ai)
#pragma unroll
            for (int m = 0; m < 4; ++m) {
                const int row = row0 + ai * 128 + m * 16;
                const float r = rs[ai * 4 + m];
                float h[8];
#pragma unroll
                for (int n = 0; n < 2; ++n)
#pragma unroll
                    for (int j = 0; j < 4; ++j) { const float a = acc[ai][0][m][n][j] * r, b = acc[ai][1][m][n][j] * r; h[4 * n + j] = a * __builtin_amdgcn_rcpf(1.0f + __expf(-a)) * b; }
                v4u w; w.x = cvt_pk_bf16(h[0], h[1]); w.y = cvt_pk_bf16(h[2], h[3]); w.z = cvt_pk_bf16(h[4], h[5]); w.w = cvt_pk_bf16(h[6], h[7]);
                store16_wt(rsrc, (unsigned)(((size_t)row * DFF + col0) * 2), w);
            }
    }
};
struct EpiResid {
    static constexpr bool PERM = true, KEEP = false;
    __device__ __forceinline__ bool keep(const Unit&) const { return false; }
    const float* xin32;
    float* xout32;
    bf16* xb; bf16* xl; float* ss; float alpha; float pscale, pspike;
    __device__ __forceinline__ void operator()(AccRef acc, const Unit& u, int wr, int wc, int, int) const {
        const int ln_ = fresh_lane(), fr = ln_ & 15, fq = ln_ >> 4;
        const int row0 = u.pm * 256 + wr * 64 + fr, col0 = u.pn * 256 + wc * 32 + 8 * fq;
#pragma unroll
        for (int ai = 0; ai < 2; ++ai)
#pragma unroll
            for (int m = 0; m < 4; ++m) {
                const int row = row0 + ai * 128 + m * 16; float s = 0.f;
#pragma unroll
                for (int bj = 0; bj < 2; ++bj) {
                    const size_t p = (size_t)row * D + col0 + bj * 128;
                    f32x4 x0, x1;
                    if (xin32) { x0 = *(const f32x4*)(xin32 + p); x1 = *(const f32x4*)(xin32 + p + 4); }
                    else { const v4u h = *(const v4u*)(xb + p), lo = *(const v4u*)(xl + p);
                        x0 = (f32x4){bflo(h.x) + bflo(lo.x), bfhi(h.x) + bfhi(lo.x), bflo(h.y) + bflo(lo.y), bfhi(h.y) + bfhi(lo.y)};
                        x1 = (f32x4){bflo(h.z) + bflo(lo.z), bfhi(h.z) + bfhi(lo.z), bflo(h.w) + bflo(lo.w), bfhi(h.w) + bfhi(lo.w)}; }
                    x0 = x0 + alpha * acc[ai][bj][m][0]; x1 = x1 + alpha * acc[ai][bj][m][1];
                    if (PROBE_ON) { x0 = x0 * pscale; x1 = x1 * pscale; if (p == 0) x0[0] += pspike; }
                    if (xout32) { *(f32x4*)(xout32 + p) = x0; *(f32x4*)(xout32 + p + 4) = x1; }
                    else {
                        v4u w; w.x = cvt_pk_bf16(x0[0], x0[1]); w.y = cvt_pk_bf16(x0[2], x0[3]); w.z = cvt_pk_bf16(x1[0], x1[1]); w.w = cvt_pk_bf16(x1[2], x1[3]);
                        *(v4u*)(xb + p) = w;
                        const f32x4 r0 = {x0[0] - bflo(w.x), x0[1] - bfhi(w.x), x0[2] - bflo(w.y), x0[3] - bfhi(w.y)}, r1 = {x1[0] - bflo(w.z), x1[1] - bfhi(w.z), x1[2] - bflo(w.w), x1[3] - bfhi(w.w)};
                        v4u q; q.x = cvt_pk_bf16(r0[0], r0[1]); q.y = cvt_pk_bf16(r0[2], r0[3]); q.z = cvt_pk_bf16(r1[0], r1[1]); q.w = cvt_pk_bf16(r1[2], r1[3]);
                        *(v4u*)(xl + p) = q;
                    }
                    s += (x0[0] * x0[0] + x0[1] * x0[1]) + (x0[2] * x0[2] + x0[3] * x0[3]) + (x1[0] * x1[0] + x1[1] * x1[1]) + (x1[2] * x1[2] + x1[3] * x1[3]);
                }
                s += shx(s, 16, ln_); s += shx(s, 32, ln_);
                if (fq == 0) ss[(size_t)row * 32 + u.pn * 4 + wc] = s;
                if (m == 3) asm volatile("" ::: "memory");
            }
    }
};
struct EpiProj {
    static constexpr bool PERM = true, KEEP = false;
    __device__ __forceinline__ bool keep(const Unit&) const { return false; }
    bf16* O; const float* ss;
    __device__ __forceinline__ void operator()(AccRef acc, const Unit& u, int wr, int wc, int, int) const {
        const int ln_ = fresh_lane(), fr = ln_ & 15, fq = ln_ >> 4;
        const int row0 = u.pm * 256 + wr * 64 + fr, col0 = u.pn * 256 + wc * 32 + 8 * fq;
        const __amdgpu_buffer_rsrc_t rsrc = __builtin_amdgcn_make_buffer_rsrc((void*)O, 0, (int)((size_t)M * DINP * 2), 0x00020000);
        float rs[8]; rows_rstd(ss, row0, fq, ln_, rs);
#pragma unroll
        for (int ai = 0; ai < 2; ++ai)
#pragma unroll
            for (int m = 0; m < 4; ++m) {
                const int row = row0 + ai * 128 + m * 16;
                const float r = rs[ai * 4 + m];
#pragma unroll
                for (int bj = 0; bj < 2; ++bj) {
                    f32x4 v0 = acc[ai][bj][m][0] * r, v1 = acc[ai][bj][m][1] * r;
                    if (u.pn >= GATE_OFF / 256) {
                        const bool isg = col0 + bj * 128 >= GATE_OFF;
#pragma unroll
                        for (int j = 0; j < 4; ++j) { const float e0 = __expf(-fminf(fmaxf(v0[j], -30.f), 30.f)), e1 = __expf(-fminf(fmaxf(v1[j], -30.f), 30.f)); v0[j] = isg ? e0 : v0[j]; v1[j] = isg ? e1 : v1[j]; }
                    }
                    v4u w; w.x = cvt_pk_bf16(v0[0], v0[1]); w.y = cvt_pk_bf16(v0[2], v0[3]); w.z = cvt_pk_bf16(v1[0], v1[1]); w.w = cvt_pk_bf16(v1[2], v1[3]);
                    store16_wt(rsrc, (unsigned)(((size_t)row * DINP + col0 + bj * 128) * 2), w);
                }
            }
    }
};
typedef f32x4 (&AccMut)[2][2][4][2];
struct EpiBranch3 {
    static constexpr bool PERM = true, KEEP = true;
    const bf16* PROJ; bf16* MGB;
    __device__ __forceinline__ bool keep(const Unit& u) const { return u.seg < 2; }
    __device__ __forceinline__ void operator()(AccMut acc, const Unit& u, int wr, int wc, int, int) const {
        const int ln_ = fresh_lane(), fr = ln_ & 15, fq = ln_ >> 4;
        const int row0 = u.pm * 256 + wr * 64 + fr, col0 = u.pn * 256 + wc * 32 + 8 * fq;
#pragma unroll
        for (int ai = 0; ai < 2; ++ai)
#pragma unroll
            for (int m = 0; m < 4; ++m) {
#pragma unroll
                for (int bj = 0; bj < 2; ++bj) {
                    const int row = row0 + ai * 128 + m * 16, col = col0 + bj * 128;
                    const bf16* gp = PROJ + (size_t)row * DINP + GATE_OFF + col;
                    float sc[8];
                    if (u.seg < 2) {
                        const v4u ga = *(const v4u*)(gp + u.seg * D), gb = *(const v4u*)(gp + (u.seg + 1) * D);
                        const float la[8] = {bflo(ga.x), bfhi(ga.x), bflo(ga.y), bfhi(ga.y), bflo(ga.z), bfhi(ga.z), bflo(ga.w), bfhi(ga.w)};
                        const float lb[8] = {bflo(gb.x), bfhi(gb.x), bflo(gb.y), bfhi(gb.y), bflo(gb.z), bfhi(gb.z), bflo(gb.w), bfhi(gb.w)};
#pragma unroll
                        for (int j = 0; j < 8; ++j) sc[j] = (1.0f + lb[j]) * __builtin_amdgcn_rcpf(1.0f + la[j]);
                    } else {
                        const v4u ga = *(const v4u*)(gp + 2 * D);
                        const float la[8] = {bflo(ga.x), bfhi(ga.x), bflo(ga.y), bfhi(ga.y), bflo(ga.z), bfhi(ga.z), bflo(ga.w), bfhi(ga.w)};
#pragma unroll
                        for (int j = 0; j < 8; ++j) sc[j] = __builtin_amdgcn_rcpf(1.0f + la[j]);
                    }
                    f32x4 x0 = acc[ai][bj][m][0], x1 = acc[ai][bj][m][1];
                    x0 = (f32x4){x0[0] * sc[0], x0[1] * sc[1], x0[2] * sc[2], x0[3] * sc[3]}; x1 = (f32x4){x1[0] * sc[4], x1[1] * sc[5], x1[2] * sc[6], x1[3] * sc[7]};
                    if (u.seg < 2) { acc[ai][bj][m][0] = x0; acc[ai][bj][m][1] = x1; }
                    else { v4u w; w.x = cvt_pk_bf16(x0[0], x0[1]); w.y = cvt_pk_bf16(x0[2], x0[3]); w.z = cvt_pk_bf16(x1[0], x1[1]); w.w = cvt_pk_bf16(x1[2], x1[3]); *(v4u*)(MGB + (size_t)row * D + col) = w; }
                }
                if (m == 3) asm volatile("" ::: "memory");
            }
    }
};
template <class F> struct EpiF {
    static constexpr bool PERM = true, KEEP = false;
    __device__ __forceinline__ bool keep(const Unit&) const { return false; }
    F f;
    __device__ __forceinline__ void operator()(AccRef acc, const Unit& u, int wr, int wc, int, int) const {
        const int ln_ = fresh_lane(), fr = ln_ & 15, fq = ln_ >> 4;
        const int row0 = u.pm * 256 + wr * 64 + fr, col0 = u.pn * 256 + wc * 32 + 8 * fq;
#pragma unroll
        for (int ai = 0; ai < 2; ++ai)
#pragma unroll
            for (int m = 0; m < 4; ++m)
            {
#pragma unroll
                for (int bj = 0; bj < 2; ++bj) f(row0 + ai * 128 + m * 16, col0 + bj * 128, acc[ai][bj][m][0], acc[ai][bj][m][1]);
                if (m & 1) asm volatile("" ::: "memory");
            }
    }
};
struct FDecay { const float* w0; float* out;
    __device__ __forceinline__ void operator()(int row, int col, f32x4 v0, f32x4 v1) const {
        float o[8];
#pragma unroll
        for (int j = 0; j < 8; ++j) { const float x = w0[col + j] + (j < 4 ? v0[j & 3] : v1[j & 3]); o[j] = __expf(-0.6065306597126334f * sigmoidf_(x)); }
        float* p = out + (size_t)row * RW + col; *(f32x4*)p = (f32x4){o[0], o[1], o[2], o[3]}; *(f32x4*)(p + 4) = (f32x4){o[4], o[5], o[6], o[7]}; } };
struct FASig { const float* a0; bf16* out;
    __device__ __forceinline__ void operator()(int row, int col, f32x4 v0, f32x4 v1) const {
        float o[8];
#pragma unroll
        for (int j = 0; j < 8; ++j) o[j] = sigmoidf_(a0[col + j] + (j < 4 ? v0[j & 3] : v1[j & 3]));
        v4u w; w.x = cvt_pk_bf16(o[0], o[1]); w.y = cvt_pk_bf16(o[2], o[3]); w.z = cvt_pk_bf16(o[4], o[5]); w.w = cvt_pk_bf16(o[6], o[7]);
        *(v4u*)(out + (size_t)row * RW + col) = w; } };
struct FStoreF32 { float* out; int ld;
    __device__ __forceinline__ void operator()(int row, int col, f32x4 v0, f32x4 v1) const { float* p = out + (size_t)row * ld + col; *(f32x4*)p = v0; *(f32x4*)(p + 4) = v1; } };
struct FStoreBf16 { bf16* out; int ld;
    __device__ __forceinline__ void operator()(int row, int col, f32x4 v0, f32x4 v1) const {
        v4u w; w.x = cvt_pk_bf16(v0[0], v0[1]); w.y = cvt_pk_bf16(v0[2], v0[3]); w.z = cvt_pk_bf16(v1[0], v1[1]); w.w = cvt_pk_bf16(v1[2], v1[3]);
        *(v4u*)(out + (size_t)row * ld + col) = w; } };
struct FVres { const float* v0p; bf16* VP; const bf16* VF;
    __device__ __forceinline__ void operator()(int row, int col, f32x4 a0, f32x4 a1) const {
        const size_t p = (size_t)row * RW + col;
        const v4u xv = *(const v4u*)(VP + p), fv = *(const v4u*)(VF + p);
        const float x[8] = {bflo(xv.x), bfhi(xv.x), bflo(xv.y), bfhi(xv.y), bflo(xv.z), bfhi(xv.z), bflo(xv.w), bfhi(xv.w)};
        const float f[8] = {bflo(fv.x), bfhi(fv.x), bflo(fv.y), bfhi(fv.y), bflo(fv.z), bfhi(fv.z), bflo(fv.w), bfhi(fv.w)};
        float o[8];
#pragma unroll
        for (int j = 0; j < 8; ++j) o[j] = x[j] + (f[j] - x[j]) * sigmoidf_(v0p[col + j] + (j < 4 ? a0[j & 3] : a1[j & 3]));
        v4u w; w.x = cvt_pk_bf16(o[0], o[1]); w.y = cvt_pk_bf16(o[2], o[3]); w.z = cvt_pk_bf16(o[4], o[5]); w.w = cvt_pk_bf16(o[6], o[7]);
        *(v4u*)(VP + p) = w; } };
struct FGlu { const bf16* Z; bf16* Y;
    __device__ __forceinline__ void operator()(int row, int col, f32x4 a0, f32x4 a1) const {
        const size_t p = (size_t)row * 1024 + col; const v4u z = *(const v4u*)(Z + p);
        const float z0 = bflo(z.x), z1 = bfhi(z.x), z2 = bflo(z.y), z3 = bfhi(z.y), z4 = bflo(z.z), z5 = bfhi(z.z), z6 = bflo(z.w), z7 = bfhi(z.w);
        v4u w; w.x = cvt_pk_bf16(z0 * sigmoidf_(a0[0]), z1 * sigmoidf_(a0[1])); w.y = cvt_pk_bf16(z2 * sigmoidf_(a0[2]), z3 * sigmoidf_(a0[3]));
        w.z = cvt_pk_bf16(z4 * sigmoidf_(a1[0]), z5 * sigmoidf_(a1[1])); w.w = cvt_pk_bf16(z6 * sigmoidf_(a1[2]), z7 * sigmoidf_(a1[3]));
        *(v4u*)(Y + p) = w; } };
template <int MODE> struct FBranch { const bf16* PROJ; int goff; float* MG; bf16* MGB;
    __device__ __forceinline__ void operator()(int row, int col, f32x4 a0, f32x4 a1) const {
        const v4u gq = *(const v4u*)(PROJ + (size_t)row * DINP + goff + col);
        const float g0 = sigmoidf_(bflo(gq.x)), g1 = sigmoidf_(bfhi(gq.x)), g2 = sigmoidf_(bflo(gq.y)), g3 = sigmoidf_(bfhi(gq.y)), g4 = sigmoidf_(bflo(gq.z)), g5 = sigmoidf_(bfhi(gq.z)), g6 = sigmoidf_(bflo(gq.w)), g7 = sigmoidf_(bfhi(gq.w));
        const size_t p = (size_t)row * D + col;
        f32x4 x0 = (f32x4){g0 * a0[0], g1 * a0[1], g2 * a0[2], g3 * a0[3]}, x1 = (f32x4){g4 * a1[0], g5 * a1[1], g6 * a1[2], g7 * a1[3]};
        if (MODE != 0) { x0 = x0 + *(const f32x4*)(MG + p); x1 = x1 + *(const f32x4*)(MG + p + 4); }
        if (MODE != 2) { *(f32x4*)(MG + p) = x0; *(f32x4*)(MG + p + 4) = x1; }
        else { v4u w; w.x = cvt_pk_bf16(x0[0], x0[1]); w.y = cvt_pk_bf16(x0[2], x0[3]); w.z = cvt_pk_bf16(x1[0], x1[1]); w.w = cvt_pk_bf16(x1[2], x1[3]); *(v4u*)(MGB + p) = w; } } };

__device__ __forceinline__ void norm_frag(v4u r0, v4u r1, const float (&g16)[16], int lane, pg8::bf16x8& f0, pg8::bf16x8& f1) {
    float x[16] = {bflo(r0.x), bfhi(r0.x), bflo(r0.y), bfhi(r0.y), bflo(r0.z), bfhi(r0.z), bflo(r0.w), bfhi(r0.w), bflo(r1.x), bfhi(r1.x), bflo(r1.y), bfhi(r1.y), bflo(r1.z), bfhi(r1.z), bflo(r1.w), bfhi(r1.w)};
    float ss = 0.f;
#pragma unroll
    for (int j = 0; j < 16; ++j) ss += x[j] * x[j];
    ss += shx(ss, 16, lane); ss += shx(ss, 32, lane);
    const float r = rsqrtf(ss * (1.0f / 64) + RMS_EPS);
#pragma unroll
    for (int j = 0; j < 16; ++j) x[j] = x[j] * r * g16[j];
    v4u a, b; a.x = pg8::cvt_pk_bf16(x[0], x[1]); a.y = pg8::cvt_pk_bf16(x[2], x[3]); a.z = pg8::cvt_pk_bf16(x[4], x[5]); a.w = pg8::cvt_pk_bf16(x[6], x[7]);
    b.x = pg8::cvt_pk_bf16(x[8], x[9]); b.y = pg8::cvt_pk_bf16(x[10], x[11]); b.z = pg8::cvt_pk_bf16(x[12], x[13]); b.w = pg8::cvt_pk_bf16(x[14], x[15]);
    f0 = __builtin_bit_cast(pg8::bf16x8, a); f1 = __builtin_bit_cast(pg8::bf16x8, b);
}
struct ConvItem { const float* W; const float* ks; bf16* dst; int ldw, Ksrc, srcc, ldd, drow0, k0, ncols; };
template <int MAP> __device__ __forceinline__ ConvItem conv_mk(const float* W, int ldw, int Ksrc, int Kdst, int Nsrc, int Ndst, const float* ks, bf16* dst, int item, int ldd = 0) {
    const int nblk = Ndst / 64, kb = item / nblk, nb = item % nblk, n0 = 64 * nb;
    int srcc;
    if (MAP == 0) srcc = (n0 < Nsrc) ? n0 : -1;
    else { const int tile = n0 >> 8, within = n0 & 255, bj = within >> 7, c = within & 127; srcc = bj * DFF + tile * 128 + c; }
    ConvItem ci; ci.W = W; ci.ks = ks; ci.dst = dst; ci.ldw = ldw; ci.Ksrc = Ksrc; ci.srcc = srcc; ci.ldd = ldd ? ldd : Kdst; ci.drow0 = n0; ci.k0 = 64 * kb; ci.ncols = (MAP == 0) ? Nsrc : 2 * DFF; return ci;
}
__device__ __forceinline__ void conv_load(const ConvItem& ci, int lane, float (&v)[64]) {
    const bool okc = ci.srcc >= 0 && (ci.srcc + lane) < ci.ncols;
    const float* base = ci.W + (okc ? ci.srcc + lane : 0);
    const int kmax = ci.Ksrc - 1;
#pragma unroll
    for (int i = 0; i < 64; ++i) { const int k = ci.k0 + i, kk = k < kmax ? k : kmax; v[i] = __builtin_nontemporal_load(base + (size_t)kk * ci.ldw); }
#pragma unroll
    for (int i = 0; i < 64; ++i) v[i] = (okc && (ci.k0 + i) < ci.Ksrc) ? v[i] : 0.f;
}
__device__ __forceinline__ void conv_store(const ConvItem& ci, LAS float* scr, int lane, const float (&v)[64]) {
    const int c = lane & 7;
    f32x4 s0 = {1.f, 1.f, 1.f, 1.f}, s1 = s0;
    if (ci.ks) { const int kb = ci.k0 + 8 * c < ci.Ksrc - 8 ? ci.k0 + 8 * c : ci.Ksrc - 8; s0 = *(const f32x4*)(ci.ks + kb); s1 = *(const f32x4*)(ci.ks + kb + 4); }
#pragma unroll
    for (int i = 0; i < 64; ++i) scr[i * 65 + lane] = v[i];
    LDS_WAIT(); asm volatile("" ::: "memory");
#pragma unroll
    for (int j = 0; j < 8; ++j) { const int n = (lane >> 3) + 8 * j; const LAS float* s = scr + (8 * c) * 65 + n;
        v4u o; o.x = cvt_pk_bf16(s[0 * 65] * s0[0], s[1 * 65] * s0[1]); o.y = cvt_pk_bf16(s[2 * 65] * s0[2], s[3 * 65] * s0[3]); o.z = cvt_pk_bf16(s[4 * 65] * s1[0], s[5 * 65] * s1[1]); o.w = cvt_pk_bf16(s[6 * 65] * s1[2], s[7 * 65] * s1[3]);
        *(v4u*)(ci.dst + (size_t)(ci.drow0 + n) * ci.ldd + ci.k0 + 8 * c) = o; }
    LDS_WAIT(); asm volatile("" ::: "memory");
}

__device__ __forceinline__ bool in_range(int lo, int hi, int k) { asm volatile("" : "+s"(k)); return lo <= k && k < hi; }
struct Args { const float* in[38]; float* out; unsigned char* ws; int ph_lo, ph_hi, use_bar, pad; };
typedef const Args __attribute__((address_space(4)))* KArgs;

__global__ void __launch_bounds__(NWAVES * 64, 2) mk_fwd(Args args) {
    extern __shared__ __attribute__((aligned(16))) unsigned char lds_raw[];
    LAS unsigned char* lds = (LAS unsigned char*)lds_raw;
    for (int u = threadIdx.x; u < (LDS_BYTES - LDSCTL_OFF) / 4; u += NWAVES * 64) ((LAS unsigned*)(lds + LDSCTL_OFF))[u] = 0u;
    __syncthreads();
    XcdBarrier bar; bar.bar = (unsigned*)(args.ws + WS_CTL) + CW_BAR; bar.x = 0; bar.st = nullptr;
    if (args.use_bar) bar = xcd_barrier_post((unsigned*)(args.ws + WS_CTL) + CW_BAR, (volatile LAS unsigned*)(lds + LDSCTL_OFF + 64));

    const int lo = args.ph_lo, hi = args.ph_hi, use_bar = args.use_bar;
    const int wave0 = __builtin_amdgcn_readfirstlane((int)threadIdx.x >> 6);
#ifndef PHMASK
#define PHMASK 0xFFFF
#endif
#define EN(p) ((PHMASK >> (p)) & 1)
#define IN(k) in_range(lo, hi, (k))
#define SEAM(k) do { if (IN(k) && IN((k) + 1)) { if (use_bar) { XcdBarrier b_ = bar; asm volatile("" : "+s"(b_.bar), "+s"(b_.x)); xcd_barrier(b_); } } } while (0)
#define DBG_ACC ((unsigned*)(args.ws + WS_CTL + 128 * 1024))
#define STAMP(k) do { if (PROBE_ON && wave0 == 0 && blockIdx.x == 0) { if (fresh_lane() == 0) { unsigned* a_ = DBG_ACC; const unsigned now_ = (unsigned)__builtin_amdgcn_s_memrealtime(); \
        const int ty_ = (k) == 0 ? 15 : ((k) - 1) % NPH; a_[ty_] += now_ - a_[32]; a_[32] = now_; } } } while (0)
#define PH_LOCALS \
    int lane; asm volatile("v_mbcnt_lo_u32_b32 %0, -1, 0\n\tv_mbcnt_hi_u32_b32 %0, -1, %0" : "=v"(lane)); int wave = wave0; asm volatile("" : "+s"(wave)); const int tid = wave * 64 + lane; \
    int G = gridDim.x, bid = blockIdx.x; asm volatile("" : "+s"(G), "+s"(bid)); \
    KArgs ka = (KArgs)__builtin_amdgcn_kernarg_segment_ptr(); asm volatile("" : "+s"(ka)); \
    unsigned char* ws = ka->ws; \
    const int gw = bid * NWAVES + wave, NGW = G * NWAVES; const size_t gtid = (size_t)bid * (NWAVES * 64) + tid, NT = (size_t)G * (NWAVES * 64); \
    (void)lane; (void)gw; (void)NGW; (void)gtid; (void)NT;
#define P_XL ((bf16*)(ws + WS_X))
#define P_XB ((bf16*)(ws + WS_XB))
#define P_HID ((bf16*)(ws + WS_HID))
#define P_PROJ ((bf16*)(ws + WS_PROJ))
#define P_SS ((float*)(ws + WS_SSP))
#define P_RP ((bf16*)(ws + WS_RP))
#define P_KP ((bf16*)(ws + WS_KP))
#define P_VP ((bf16*)(ws + WS_VP))
#define P_DECAY ((float*)(ws + WS_DECAY))
#define P_ASIG ((bf16*)(ws + WS_ASIG))
#define P_GG ((bf16*)(ws + WS_G))
#define P_KK ((bf16*)(ws + WS_KK))
#define P_VFIRST ((bf16*)(ws + WS_VFIRST))
#define P_YRAW ((bf16*)(ws + WS_YRAW))
#define P_LORA ((bf16*)(ws + WS_LORA))
#define P_AV ((bf16*)(ws + WS_VP))
#define P_V1O ((bf16*)(ws + WS_V1O))
#define P_QN ((bf16*)(ws + WS_QN))
#define P_KN ((bf16*)(ws + WS_KN))
#define P_Z ((bf16*)(ws + WS_Z))
#define P_YS5 ((bf16*)(ws + WS_YS5))
#define P_YATT ((bf16*)(ws + WS_MERGED))
#define P_YRWKV ((bf16*)(ws + WS_YRWKV))
#define P_MERGED ((float*)(ws + WS_MERGED))
#define P_MERGEDB ((bf16*)(ws + WS_MERGEDB))
#define P_SBUF ((f32x2*)(ws + WS_SBUF))

    if (PROBE_ON && wave0 == 0 && blockIdx.x == 0) { if (fresh_lane() == 0) DBG_ACC[32] = (unsigned)__builtin_amdgcn_s_memrealtime(); }
    if (IN(0)) {
        PH_LOCALS
        const float* x = ka->in[0];
        for (int m = gw; m < M; m += NGW) {
            const f32x4* xr = (const f32x4*)(x + (size_t)m * D) + lane; float s = 0.f;
            v2u* o = (v2u*)(P_XB + (size_t)m * D) + lane;
#pragma unroll
            for (int j = 0; j < 8; ++j) { const f32x4 v = xr[64 * j]; s += (v.x * v.x + v.y * v.y) + (v.z * v.z + v.w * v.w); v2u w; w.x = pk2(v.x, v.y); w.y = pk2(v.z, v.w); o[64 * j] = w; }
            s = wave_sum(s, lane);
            if (lane < 32) P_SS[(size_t)m * 32 + lane] = lane == 0 ? s : 0.f;
        }
    }
    STAMP(0);

    for (int l = 0; l < DEPTH; ++l) {
        const int pb = 1 + l * NPH;
        if (hi <= pb || lo >= pb + NPH) continue;
        if (EN(0) && IN(pb + 0)) {
            PH_LOCALS
            LAS float* scr = (LAS float*)(lds + RING_OFF + wave * 16640);   static_assert(8 * 16640 <= LDSCTL_OFF, "converter scratch below the LDS control words");
            constexpr int I_UP = (D / 64) * (NUP / 64), I_DN = (DFF / 64) * (D / 64), I_IN = (D / 64) * (DINP / 64), I_GLU = 16 * 16, I_L = 4 * 16, I_V1 = 16 * 4, I_V2 = 4 * 16,
                          I_BS5 = 16 * 32, I_BAT = 8 * 32, I_BRW = 16 * 32, I_OUT = 32 * 32;
            constexpr int NITEMS = 2 * I_UP + 2 * I_DN + I_IN + I_GLU + 3 * I_L + I_V1 + I_V2 + I_BS5 + I_BAT + I_BRW + I_OUT;
            const int lv = l > 0 ? l - 1 : 0;
#define CONV_DESC(dst_, it_) do { int r = (it_); \
                if (r < I_UP) { dst_ = conv_mk<1>(ka->in[2] + (size_t)l * D * NUP, NUP, D, D, NUP, NUP, ka->in[1] + l * D, (bf16*)(ws + W_UP1), r); break; } r -= I_UP; \
                if (r < I_UP) { dst_ = conv_mk<1>(ka->in[36] + (size_t)l * D * NUP, NUP, D, D, NUP, NUP, ka->in[35] + l * D, (bf16*)(ws + W_UP2), r); break; } r -= I_UP; \
                if (r < I_IN) { dst_ = conv_mk<0>(ka->in[5] + (size_t)l * D * DIN, DIN, D, D, DIN, DINP, ka->in[4] + l * D, (bf16*)(ws + W_IN), r); break; } r -= I_IN; \
                if (r < I_DN) { dst_ = conv_mk<0>(ka->in[3] + (size_t)l * DFF * D, D, DFF, DFF, D, D, nullptr, (bf16*)(ws + W_DN1), r); break; } r -= I_DN; \
                if (r < I_DN) { dst_ = conv_mk<0>(ka->in[37] + (size_t)l * DFF * D, D, DFF, DFF, D, D, nullptr, (bf16*)(ws + W_DN2), r); break; } r -= I_DN; \
                if (r < I_OUT) { dst_ = conv_mk<0>(ka->in[34] + (size_t)l * D * D, D, D, D, D, D, nullptr, (bf16*)(ws + W_OUT), r); break; } r -= I_OUT; \
                if (r < I_BS5) { dst_ = conv_mk<0>(ka->in[31] + (size_t)l * 1024 * D, D, 1024, 1024, D, D, nullptr, (bf16*)(ws + W_BS5), r); break; } r -= I_BS5; \
                if (r < I_BAT) { dst_ = conv_mk<0>(ka->in[32] + (size_t)l * 512 * D, D, 512, 512, D, D, nullptr, (bf16*)(ws + W_BAT2), r, 1024); break; } r -= I_BAT; \
                if (r < I_BRW) { dst_ = conv_mk<0>(ka->in[33] + (size_t)l * 1024 * D, D, 1024, 1024, D, D, nullptr, (bf16*)(ws + W_BRW), r); break; } r -= I_BRW; \
                if (r < I_GLU) { dst_ = conv_mk<0>(ka->in[14] + (size_t)l * 1024 * 1024, 1024, 1024, 1024, 1024, 1024, nullptr, (bf16*)(ws + W_GLU), r); break; } r -= I_GLU; \
                if (r < I_L) { dst_ = conv_mk<0>(ka->in[19] + (size_t)l * 96 * RW, RW, 96, 256, RW, RW, nullptr, (bf16*)(ws + W_W2), r); break; } r -= I_L; \
                if (r < I_L) { dst_ = conv_mk<0>(ka->in[21] + (size_t)l * 96 * RW, RW, 96, 256, RW, RW, nullptr, (bf16*)(ws + W_A2), r); break; } r -= I_L; \
                if (r < I_L) { dst_ = conv_mk<0>(ka->in[22] + (size_t)l * 256 * RW, RW, 256, 256, RW, RW, nullptr, (bf16*)(ws + W_G2), r); break; } r -= I_L; \
                if (r < I_V1) { dst_ = conv_mk<0>(ka->in[29] + (size_t)lv * RW * 64, 64, RW, RW, 64, 256, nullptr, (bf16*)(ws + W_V1), r); break; } r -= I_V1; \
                dst_ = conv_mk<0>(ka->in[30] + (size_t)lv * 64 * RW, RW, 64, 256, RW, RW, nullptr, (bf16*)(ws + W_V2), r); } while (0)
            for (int it = gw; it < NITEMS; it += NGW) {
                ConvItem ca; CONV_DESC(ca, it);
                float va[64];
                conv_load(ca, lane, va);
                conv_store(ca, scr, lane, va);
            }
#undef CONV_DESC
        }
        SEAM(pb + 0); STAMP(pb + 0);
        if (EN(1) && IN(pb + 1)) {
            PH_LOCALS
            pg8::Gemm g{P_XB, (const bf16*)(ws + W_UP1), M, NUP, D, D, D}; pg8::StaticOrder S; S.init(M, NUP, G, bid);
            EpiSwiGLU E{P_HID, P_SS + (size_t)(3 * l + 0) * M * 32};
            pg8::gemm_phase<EpiSwiGLU, pg8::StaticOrder, true, true>(lds + RING_OFF, g, S, E, tid);
        }
        SEAM(pb + 1); STAMP(pb + 1);
        if (EN(2) && IN(pb + 2)) {
            PH_LOCALS
            pg8::Gemm g{P_HID, (const bf16*)(ws + W_DN1), M, D, DFF, DFF, DFF}; pg8::StaticOrder S; S.init(M, D, G, bid);
            EpiResid E{l == 0 ? ka->in[0] : nullptr, nullptr, P_XB, P_XL, P_SS + (size_t)(3 * l + 1) * M * 32, 0.5f, 1.0f, 0.0f};
            pg8::gemm_phase<EpiResid, pg8::StaticOrder, true, true>(lds + RING_OFF, g, S, E, tid);
        }
        SEAM(pb + 2); STAMP(pb + 2);
        if (EN(3) && IN(pb + 3)) {
            PH_LOCALS
            pg8::Gemm g{P_XB, (const bf16*)(ws + W_IN), M, DINP, D, D, D}; pg8::StaticOrder S; S.init(M, DINP, G, bid);
            EpiProj E{P_PROJ, P_SS + (size_t)(3 * l + 1) * M * 32};
            pg8::gemm_phase<EpiProj, pg8::StaticOrder, true, true>(lds + RING_OFF, g, S, E, tid);
        }
        SEAM(pb + 3); STAMP(pb + 3);
        if (EN(4) && IN(pb + 4)) {
            PH_LOCALS
            const float* mu = ka->in[17] + (size_t)l * RWP;
            const bf16* PROJ = P_PROJ; bf16* LORA = P_LORA; bf16* RPp = P_RP; bf16* KPp = P_KP; bf16* VPp = P_VP; bf16* VFp = P_VFIRST; bf16* KKp = P_KK;
#pragma unroll 1
            for (int ch = lane; ch < RWP / 8; ch += 64) {
                const int c = ch * 8;
                const f32x4 m0 = *(const f32x4*)(mu + c), m1 = *(const f32x4*)(mu + c + 4);
                f32x4 q0 = {0.f, 0.f, 0.f, 0.f}, q1 = q0;
                if (c >= 1024 && c < 2048) { q0 = *(const f32x4*)(ka->in[23] + l * RW + c - 1024); q1 = *(const f32x4*)(ka->in[23] + l * RW + c - 1024 + 4); }
#pragma unroll 1
                for (int m = gw; m < M; m += NGW) {
                    const bool has_prev = (m % T) != 0;
                    const bf16* prow = PROJ + (size_t)m * DINP;
                    const v4u pc = *(const v4u*)(prow + RW_OFF + c);
                    v4u pp = {0u, 0u, 0u, 0u}; if (has_prev) pp = *(const v4u*)(prow - DINP + RW_OFF + c);
                    float p[8];
                    { const float c0 = bflo(pc.x), c1 = bfhi(pc.x), c2 = bflo(pc.y), c3 = bfhi(pc.y), c4 = bflo(pc.z), c5 = bfhi(pc.z), c6 = bflo(pc.w), c7 = bfhi(pc.w);
                      p[0] = c0 + (bflo(pp.x) - c0) * m0[0]; p[1] = c1 + (bfhi(pp.x) - c1) * m0[1]; p[2] = c2 + (bflo(pp.y) - c2) * m0[2]; p[3] = c3 + (bfhi(pp.y) - c3) * m0[3];
                      p[4] = c4 + (bflo(pp.z) - c4) * m1[0]; p[5] = c5 + (bfhi(pp.z) - c5) * m1[1]; p[6] = c6 + (bflo(pp.w) - c6) * m1[2]; p[7] = c7 + (bfhi(pp.w) - c7) * m1[3]; }
                    if (c >= 1024 && c < 2048) {
                        float kk[8] = {p[0] * q0[0], p[1] * q0[1], p[2] * q0[2], p[3] * q0[3], p[4] * q1[0], p[5] * q1[1], p[6] * q1[2], p[7] * q1[3]};
                        float ssq = (kk[0] * kk[0] + kk[1] * kk[1]) + (kk[2] * kk[2] + kk[3] * kk[3]) + (kk[4] * kk[4] + kk[5] * kk[5]) + (kk[6] * kk[6] + kk[7] * kk[7]);
                        ssq += shx(ssq, 1, lane); ssq += shx(ssq, 2, lane); ssq += shx(ssq, 4, lane);
                        const float rn = rsqrtf(fmaxf(ssq, 1e-24f));
                        v4u w; w.x = cvt_pk_bf16(kk[0] * rn, kk[1] * rn); w.y = cvt_pk_bf16(kk[2] * rn, kk[3] * rn); w.z = cvt_pk_bf16(kk[4] * rn, kk[5] * rn); w.w = cvt_pk_bf16(kk[6] * rn, kk[7] * rn);
                        *(v4u*)(KKp + (size_t)m * RW + (c - 1024)) = w;
                    }
                    if (c < 3072) {
                        bf16* dst = (c < 1024 ? RPp : (c < 2048 ? KPp : VPp)) + (size_t)m * RW + (c & 1023);
                        v4u w; w.x = cvt_pk_bf16(p[0], p[1]); w.y = cvt_pk_bf16(p[2], p[3]); w.z = cvt_pk_bf16(p[4], p[5]); w.w = cvt_pk_bf16(p[6], p[7]);
                        *(v4u*)dst = w;
                        if (c >= 2048 && l == 0) *(v4u*)(VFp + (size_t)m * RW + (c & 1023)) = w;
                    } else {
                        int dcol;
                        if (c < 3168) { dcol = c - 3072;
#pragma unroll
                            for (int j = 0; j < 8; ++j) p[j] = 1.0f - 2.0f / (1.0f + __expf(2.0f * p[j])); }
                        else if (c < 3264) dcol = 256 + c - 3168;
                        else { dcol = 512 + c - 3264;
#pragma unroll
                            for (int j = 0; j < 8; ++j) p[j] = sigmoidf_(p[j]); }
                        v4u w; w.x = cvt_pk_bf16(p[0], p[1]); w.y = cvt_pk_bf16(p[2], p[3]); w.z = cvt_pk_bf16(p[4], p[5]); w.w = cvt_pk_bf16(p[6], p[7]);
                        *(v4u*)(LORA + (size_t)m * 768 + dcol) = w;
                    }
                }
            }
#pragma unroll 1
            for (int m = gw; m < M; m += NGW)
                if (lane < 40) { const unsigned z0 = (unsigned)lane >> 8; const v4u z = {z0, z0, z0, z0};     *(v4u*)(LORA + (size_t)m * 768 + (lane < 20 ? 96 + 8 * lane : 352 + 8 * (lane - 20))) = z; }
        }
        if (EN(4) && IN(pb + 4)) {
            PH_LOCALS
            const bf16* PROJ = P_PROJ; bf16* Z = P_Z;
            LAS float* BUs = (LAS float*)(lds + wave * 12800);
            LAS unsigned* Ss = (LAS unsigned*)(lds + wave * 12800 + 8448);
            LAS float* Ex = (LAS float*)(lds + 8 * 12800);
            const int g4 = lane >> 4, i16 = lane & 15;
            for (int item = bid; item < 256; item += G) {
                const int b = item >> 6, g = item & 63;
                const float dt = expf(ka->in[12][l * 64 + g]);
                float ab_re, ab_im;
                { const float lam_re = fminf(ka->in[6][(l * 64 + g) * 64 + lane], -1e-4f), lam_im = ka->in[7][(l * 64 + g) * 64 + lane];
                  const float mag = expf(lam_re * dt); ab_re = mag * cosf(lam_im * dt); ab_im = mag * sinf(lam_im * dt); }
                pg8::bf16x8 Abb[8];
#pragma unroll
                for (int mt = 0; mt < 4; ++mt) {
                    const int pp = 16 * mt + i16;
                    const float lam_re = fminf(ka->in[6][(l * 64 + g) * 64 + pp], -1e-4f), lam_im = ka->in[7][(l * 64 + g) * 64 + pp];
                    const float mag = expf(lam_re * dt), are = mag * cosf(lam_im * dt), aim = mag * sinf(lam_im * dt);
                    const float den = lam_re * lam_re + lam_im * lam_im, nre = are - 1.0f;
                    const float cr = (nre * lam_re + aim * lam_im) / den, ci = (aim * lam_re - nre * lam_im) / den;
                    v4u wr_ = {0u, 0u, 0u, 0u}, wi_ = {0u, 0u, 0u, 0u};
                    if (g4 < 2) {
                        const float* bre = ka->in[8] + ((size_t)(l * 64 + g) * 64 + pp) * 16 + 8 * g4; const float* bim = ka->in[9] + ((size_t)(l * 64 + g) * 64 + pp) * 16 + 8 * g4;
                        const f32x4 r0 = *(const f32x4*)bre, r1 = *(const f32x4*)(bre + 4), m0_ = *(const f32x4*)bim, m1_ = *(const f32x4*)(bim + 4);
                        const f32x4 xr0 = cr * r0 - ci * m0_, xr1 = cr * r1 - ci * m1_, xi0 = cr * m0_ + ci * r0, xi1 = cr * m1_ + ci * r1;
                        wr_.x = cvt_pk_bf16(xr0[0], xr0[1]); wr_.y = cvt_pk_bf16(xr0[2], xr0[3]); wr_.z = cvt_pk_bf16(xr1[0], xr1[1]); wr_.w = cvt_pk_bf16(xr1[2], xr1[3]);
                        wi_.x = cvt_pk_bf16(xi0[0], xi0[1]); wi_.y = cvt_pk_bf16(xi0[2], xi0[3]); wi_.z = cvt_pk_bf16(xi1[0], xi1[1]); wi_.w = cvt_pk_bf16(xi1[2], xi1[3]);
                    }
                    Abb[mt] = __builtin_bit_cast(pg8::bf16x8, wr_); Abb[4 + mt] = __builtin_bit_cast(pg8::bf16x8, wi_);
                }
                pg8::bf16x8 Cop[4];
#pragma unroll
                for (int kb = 0; kb < 4; ++kb) {
                    const float* cre = ka->in[10] + ((size_t)(l * 64 + g) * 16 + i16) * 64 + 16 * kb + 4 * g4; const float* cim = ka->in[11] + ((size_t)(l * 64 + g) * 16 + i16) * 64 + 16 * kb + 4 * g4;
                    const f32x4 r = *(const f32x4*)cre, m = *(const f32x4*)cim;
                    v4u w; w.x = cvt_pk_bf16(r[0], -m[0]); w.y = cvt_pk_bf16(r[1], -m[1]); w.z = cvt_pk_bf16(r[2], -m[2]); w.w = cvt_pk_bf16(r[3], -m[3]);
                    Cop[kb] = __builtin_bit_cast(pg8::bf16x8, w);
                }
                const size_t tok0 = (size_t)b * T + wave * 256;
                float s_re = 0.f, s_im = 0.f;
#pragma unroll 1
                for (int pass = 0; pass < 2; ++pass) {
                    v4u uwn = *(const v4u*)(PROJ + (tok0 + i16) * DINP + U_OFF + g * 16 + 8 * (g4 & 1));
#pragma unroll 1
                    for (int st = 0; st < 16; ++st) {
                        const size_t rowt = tok0 + st * 16 + i16;
                        v4u uw = uwn; if (g4 >= 2) { uw.x = 0u; uw.y = 0u; uw.z = 0u; uw.w = 0u; }
                        { const int stn = st < 15 ? st + 1 : 15; uwn = *(const v4u*)(PROJ + (tok0 + stn * 16 + i16) * DINP + U_OFF + g * 16 + 8 * (g4 & 1)); }
                        const v2u uq = *(const v2u*)(PROJ + rowt * DINP + U_OFF + g * 16 + 4 * g4);
                        const pg8::bf16x8 Uop = __builtin_bit_cast(pg8::bf16x8, uw);
#pragma unroll
                        for (int mt = 0; mt < 8; ++mt) { f32x4 d = {0.f, 0.f, 0.f, 0.f}; d = __builtin_amdgcn_mfma_f32_16x16x32_bf16(Abb[mt], Uop, d, 0, 0, 0);
                            *(LAS f32x4*)(BUs + i16 * 132 + 16 * mt + 4 * g4) = d; }
                        asm volatile("s_waitcnt lgkmcnt(0)" ::: "memory");
#pragma unroll
                        for (int tt = 0; tt < 16; ++tt) {
                            const float bur = BUs[tt * 132 + lane], bui = BUs[tt * 132 + 64 + lane];
                            const float nr = ab_re * s_re - ab_im * s_im + bur, ni = ab_re * s_im + ab_im * s_re + bui; s_re = nr; s_im = ni;
                            if (pass == 1) Ss[tt * 68 + lane] = cvt_pk_bf16(s_re, s_im);
                        }
                        asm volatile("s_waitcnt lgkmcnt(0)" ::: "memory");
                        if (pass == 1) {
                            f32x4 y = {0.f, 0.f, 0.f, 0.f};
#pragma unroll
                            for (int kb = 0; kb < 4; ++kb) { const pg8::bf16x8 Sop = *(const LAS pg8::bf16x8*)((const LAS unsigned char*)Ss + i16 * 272 + 64 * kb + 16 * g4);
                                y = __builtin_amdgcn_mfma_f32_16x16x32_bf16(Cop[kb], Sop, y, 0, 0, 0); }
                            const f32x4 dsk = *(const f32x4*)(ka->in[13] + l * 1024 + g * 16 + 4 * g4);
                            const float uu[4] = {bflo(uq.x), bfhi(uq.x), bflo(uq.y), bfhi(uq.y)}; float zz[4];
#pragma unroll
                            for (int i = 0; i < 4; ++i) { const float yy = y[i] + dsk[i] * uu[i]; const float a = 0.7978845608028654f * (yy + 0.044715f * yy * yy * yy);
                                const float th = 1.0f - 2.0f / (1.0f + __expf(2.0f * a)); zz[i] = 0.5f * yy * (1.0f + th); }
                            v2u zo; zo.x = cvt_pk_bf16(zz[0], zz[1]); zo.y = cvt_pk_bf16(zz[2], zz[3]);
                            *(v2u*)(Z + rowt * 1024 + g * 16 + 4 * g4) = zo;
                            asm volatile("s_waitcnt lgkmcnt(0)" ::: "memory");
                        }
                    }
                    if (pass == 0) {
                        Ex[(wave * 64 + lane) * 2] = s_re; Ex[(wave * 64 + lane) * 2 + 1] = s_im;
                        float pr = ab_re, pi = ab_im;
#pragma unroll
                        for (int q = 0; q < 8; ++q) { const float t_ = pr * pr - pi * pi; pi = 2.0f * pr * pi; pr = t_; }
                        __syncthreads();
                        float cr_ = 0.f, ci_ = 0.f;
                        for (int w2 = 0; w2 < wave; ++w2) { const float er = Ex[(w2 * 64 + lane) * 2], ei = Ex[(w2 * 64 + lane) * 2 + 1];
                            const float nr = pr * cr_ - pi * ci_ + er, ni = pr * ci_ + pi * cr_ + ei; cr_ = nr; ci_ = ni; }
                        s_re = cr_; s_im = ci_;
                    }
                }
                __syncthreads();
            }
        }
        if (EN(4) && IN(pb + 4)) {
            PH_LOCALS
            const bf16* PROJ = P_PROJ; bf16* YATT = P_YATT;
            LAS float* Ol = (LAS float*)lds;
            LAS float* Dl = (LAS float*)(lds + 256 * 68 * 4);
            LAS unsigned char* Vs = lds + 256 * 68 * 4 + 1024 + wave * 5120;
            const int g4 = lane >> 4, i16 = lane & 15;
            float mq = fabsf(ka->in[15][l * 64 + lane]), mk = fabsf(ka->in[16][l * 64 + lane]);
#pragma unroll
            for (int o = 32; o >= 1; o >>= 1) { mq = fmaxf(mq, shx(mq, o, lane)); mk = fmaxf(mk, shx(mk, o, lane)); }
            float gq16[16], gk16[16];
#pragma unroll
            for (int j = 0; j < 8; ++j) { gq16[j] = ka->in[15][l * 64 + 8 * g4 + j]; gq16[8 + j] = ka->in[15][l * 64 + 32 + 8 * g4 + j]; gk16[j] = ka->in[16][l * 64 + 8 * g4 + j]; gk16[8 + j] = ka->in[16][l * 64 + 32 + 8 * g4 + j]; }
            const float Mref = 8.5f * mq * mk;
            for (int item = bid; item < 256; item += G) {
                const int b = item >> 6, hh = (item >> 3) & 7, t0 = (item & 7) * 256;
                for (int gi = 0; gi < 3; ++gi) {
                    const int sh = 2 * gi, head = gi * 8 + hh, nts = 16 >> sh, mmax = (T >> sh) - 1;
                    const float slope_d = exp2f(-8.0f * (float)(head + 1) / 24.0f) * (float)(1 << sh);
                    for (int ti = 0; ti < 2; ++ti) {
                        const int tau = wave * 2 + ti, c = tau / nts, mt = tau % nts, m0 = (t0 >> sh) + 16 * mt;
                        const size_t rowq = (size_t)b * T + (size_t)(((m0 + i16) << sh) + c);
                        pg8::bf16x8 qf0, qf1;
                        norm_frag(*(const v4u*)(PROJ + rowq * DINP + Q_OFF + head * 64 + 8 * g4), *(const v4u*)(PROJ + rowq * DINP + Q_OFF + head * 64 + 32 + 8 * g4), gq16, lane, qf0, qf1);
                        f32x4 O0 = {0.f, 0.f, 0.f, 0.f}, O1 = O0, O2 = O0, O3 = O0; float den = 0.f;
                        v4u kfr[2][2]; v4u vrow[4];
#define ATT_LOAD(kp_, KF_, VR_) do { _Pragma("unroll") for (int hf_ = 0; hf_ < 2; ++hf_) { int mkl_ = m0 - 128 + 16 * (2 * (kp_) + hf_) + i16; mkl_ = mkl_ < 0 ? 0 : (mkl_ > mmax ? mmax : mkl_); \
                                const size_t rk_ = (size_t)b * T + (size_t)((mkl_ << sh) + c); KF_[hf_][0] = *(const v4u*)(PROJ + rk_ * DINP + K_OFF + head * 64 + 8 * g4); KF_[hf_][1] = *(const v4u*)(PROJ + rk_ * DINP + K_OFF + head * 64 + 32 + 8 * g4); } \
                            _Pragma("unroll") for (int r_ = 0; r_ < 4; ++r_) { const int ci_ = lane + 64 * r_, key_ = ci_ >> 3, ch_ = ci_ & 7; int mk_ = m0 - 128 + 32 * (kp_) + key_; mk_ = mk_ < 0 ? 0 : (mk_ > mmax ? mmax : mk_); \
                                const size_t rk_ = (size_t)b * T + (size_t)((mk_ << sh) + c); VR_[r_] = *(const v4u*)(PROJ + rk_ * DINP + V_OFF + head * 64 + ch_ * 8); } } while (0)
                        ATT_LOAD(0, kfr, vrow);
#pragma unroll
                        for (int kp = 0; kp < 5; ++kp) {
                            v4u kfn[2][2]; v4u vrn[4];
                            if (kp < 4) ATT_LOAD(kp + 1, kfn, vrn);
#pragma unroll
                            for (int r = 0; r < 4; ++r) { const int ci = lane + 64 * r, key = ci >> 3, ch = ci & 7; *(LAS v4u*)(Vs + key * 160 + ch * 16) = vrow[r]; }
                            float pv[8];
#pragma unroll
                            for (int hf = 0; hf < 2; ++hf) {
                                const int kt = 2 * kp + hf;
                                if (kt == 9) { pv[4] = 0.f; pv[5] = 0.f; pv[6] = 0.f; pv[7] = 0.f; continue; }
                                f32x4 sc = {0.f, 0.f, 0.f, 0.f};
                                pg8::bf16x8 kn0, kn1; norm_frag(kfr[hf][0], kfr[hf][1], gk16, lane, kn0, kn1);
                                sc = __builtin_amdgcn_mfma_f32_16x16x32_bf16(kn0, qf0, sc, 0, 0, 0); sc = __builtin_amdgcn_mfma_f32_16x16x32_bf16(kn1, qf1, sc, 0, 0, 0);
#pragma unroll
                                for (int i = 0; i < 4; ++i) { const int n = 4 * g4 + i, diff = i16 - n + 128 - 16 * kt, mkn = m0 - 128 + 16 * kt + n;
                                    const bool valid = diff >= 0 && diff <= 128 && mkn >= 0;
                                    const float p = valid ? __expf(sc[i] * 0.125f - slope_d * (float)diff - Mref) : 0.f; den += p; pv[hf * 4 + i] = p; }
                            }
                            v4u bw; bw.x = cvt_pk_bf16(pv[0], pv[1]); bw.y = cvt_pk_bf16(pv[2], pv[3]); bw.z = cvt_pk_bf16(pv[4], pv[5]); bw.w = cvt_pk_bf16(pv[6], pv[7]);
                            const pg8::bf16x8 Bp = __builtin_bit_cast(pg8::bf16x8, bw);
                            asm volatile("s_waitcnt lgkmcnt(0)" ::: "memory");
                            const unsigned va = (unsigned)(size_t)(Vs + (4 * g4 + (i16 >> 2)) * 160 + 8 * (i16 & 3));
                            v2u l0, l1, l2, l3, h0, h1, h2, h3;
                            asm volatile("ds_read_b64_tr_b16 %0, %8\n\tds_read_b64_tr_b16 %1, %8 offset:32\n\tds_read_b64_tr_b16 %2, %8 offset:64\n\tds_read_b64_tr_b16 %3, %8 offset:96\n\t"
                                         "ds_read_b64_tr_b16 %4, %8 offset:2560\n\tds_read_b64_tr_b16 %5, %8 offset:2592\n\tds_read_b64_tr_b16 %6, %8 offset:2624\n\tds_read_b64_tr_b16 %7, %8 offset:2656\n\ts_waitcnt lgkmcnt(0)"
                                         : "=&v"(l0), "=&v"(l1), "=&v"(l2), "=&v"(l3), "=&v"(h0), "=&v"(h1), "=&v"(h2), "=&v"(h3) : "v"(va) : "memory");
                            { v4u a; a.x = l0.x; a.y = l0.y; a.z = h0.x; a.w = h0.y; O0 = __builtin_amdgcn_mfma_f32_16x16x32_bf16(__builtin_bit_cast(pg8::bf16x8, a), Bp, O0, 0, 0, 0); }
                            { v4u a; a.x = l1.x; a.y = l1.y; a.z = h1.x; a.w = h1.y; O1 = __builtin_amdgcn_mfma_f32_16x16x32_bf16(__builtin_bit_cast(pg8::bf16x8, a), Bp, O1, 0, 0, 0); }
                            { v4u a; a.x = l2.x; a.y = l2.y; a.z = h2.x; a.w = h2.y; O2 = __builtin_amdgcn_mfma_f32_16x16x32_bf16(__builtin_bit_cast(pg8::bf16x8, a), Bp, O2, 0, 0, 0); }
                            { v4u a; a.x = l3.x; a.y = l3.y; a.z = h3.x; a.w = h3.y; O3 = __builtin_amdgcn_mfma_f32_16x16x32_bf16(__builtin_bit_cast(pg8::bf16x8, a), Bp, O3, 0, 0, 0); }
                            if (kp < 4) {
#pragma unroll
                                for (int hf = 0; hf < 2; ++hf) { kfr[hf][0] = kfn[hf][0]; kfr[hf][1] = kfn[hf][1]; }
#pragma unroll
                                for (int r = 0; r < 4; ++r) vrow[r] = vrn[r];
                            }
                        }
#undef ATT_LOAD
                        den += shx(den, 16, lane); den += shx(den, 32, lane);
                        const int x = ((16 * mt + i16) << sh) + c;
                        LAS f32x4* op = (LAS f32x4*)(Ol + x * 68 + 4 * g4);
                        if (gi == 0) { op[0] = O0; op[4] = O1; op[8] = O2; op[12] = O3; if (g4 == 0) Dl[x] = den; }
                        else { op[0] = op[0] + O0; op[4] = op[4] + O1; op[8] = op[8] + O2; op[12] = op[12] + O3; if (g4 == 0) Dl[x] = Dl[x] + den; }
                    }
                    __syncthreads();
                }
                { const int x = tid >> 1, hf = tid & 1; const float rd = 1.0f / Dl[x]; const LAS f32x4* op = (const LAS f32x4*)(Ol + x * 68 + 32 * hf);
                  bf16* yo = YATT + ((size_t)b * T + t0 + x) * 1024 + hh * 64 + 32 * hf;
#pragma unroll
                  for (int q = 0; q < 4; ++q) { const f32x4 a = op[2 * q] * rd, c2 = op[2 * q + 1] * rd;
                      v4u w; w.x = cvt_pk_bf16(a[0], a[1]); w.y = cvt_pk_bf16(a[2], a[3]); w.z = cvt_pk_bf16(c2[0], c2[1]); w.w = cvt_pk_bf16(c2[2], c2[3]); *(v4u*)(yo + 8 * q) = w; } }
                __syncthreads();
            }
        }
        SEAM(pb + 4); STAMP(pb + 4);
        STAMP(pb + 5);
        if (EN(6) && IN(pb + 6)) {
            { PH_LOCALS
              pg8::Gemm g{P_LORA, (const bf16*)(ws + W_W2), M, RW, 256, 768, 256}; pg8::StaticOrder S; S.init(M, RW, G, l > 0 && G == 256 ? (bid >= 32 && bid < 160 ? bid - 32 : 1 << 20) : bid);
              EpiF<FDecay> E{FDecay{ka->in[18] + l * RW, P_DECAY}}; pg8::gemm_phase<EpiF<FDecay>, pg8::StaticOrder, true, true>(lds + RING_OFF, g, S, E, tid); }
            { PH_LOCALS
              pg8::Gemm g{P_LORA + 256, (const bf16*)(ws + W_A2), M, RW, 256, 768, 256}; pg8::StaticOrder S; S.init(M, RW, G, l > 0 && G == 256 ? (bid >= 160 ? bid - 160 : (bid >= 32 && bid < 64 ? 96 + bid - 32 : 1 << 20)) : (bid + G / 2) % G);
              EpiF<FASig> E{FASig{ka->in[20] + l * RW, P_ASIG}}; pg8::gemm_phase<EpiF<FASig>, pg8::StaticOrder, true, true>(lds + RING_OFF, g, S, E, tid); }
            { PH_LOCALS
              pg8::Gemm g{P_LORA + 512, (const bf16*)(ws + W_G2), M, RW, 256, 768, 256}; pg8::StaticOrder S; S.init(M, RW, G, l > 0 && G == 256 ? (bid >= 64 && bid < 160 ? bid - 64 : (bid >= 160 && bid < 192 ? 96 + bid - 160 : 1 << 20)) : bid);
              EpiF<FStoreBf16> E{FStoreBf16{P_GG, RW}}; pg8::gemm_phase<EpiF<FStoreBf16>, pg8::StaticOrder, true, true>(lds + RING_OFF, g, S, E, tid); }
            if (l > 0) { PH_LOCALS
              pg8::Gemm g{P_AV, (const bf16*)(ws + W_V1), M, 256, RW, RW, RW}; pg8::StaticOrder S; S.init(M, 256, G, G == 256 ? bid : (bid + G / 2) % G);
              EpiF<FStoreBf16> E{FStoreBf16{P_V1O, 256}}; pg8::gemm_phase<EpiF<FStoreBf16>, pg8::StaticOrder, true, true>(lds + RING_OFF, g, S, E, tid); }
        }
        SEAM(pb + 6); STAMP(pb + 6);
        if (EN(7) && IN(pb + 7)) {
            if (l > 0) { PH_LOCALS
              pg8::Gemm g{P_V1O, (const bf16*)(ws + W_V2), M, RW, 256, 256, 256}; pg8::StaticOrder S; S.init(M, RW, G, bid);
              EpiF<FVres> E{FVres{ka->in[28] + (size_t)(l - 1) * RW, P_VP, P_VFIRST}}; pg8::gemm_phase<EpiF<FVres>, pg8::StaticOrder, true, true>(lds + RING_OFF, g, S, E, tid); }
            { PH_LOCALS
              pg8::Gemm g{P_Z, (const bf16*)(ws + W_GLU), M, 1024, 1024, 1024, 1024}; pg8::StaticOrder S; S.init(M, 1024, G, (bid + G / 2) % G);
              EpiF<FGlu> E{FGlu{P_Z, P_YS5}}; pg8::gemm_phase<EpiF<FGlu>, pg8::StaticOrder, true, true>(lds + RING_OFF, g, S, E, tid); }
        }
        STAMP(pb + 7);
        if (EN(8) && IN(pb + 8)) {
            PH_LOCALS
            const float* DECAY = P_DECAY; const bf16* ASIG = P_ASIG; const bf16* KP = P_KP; const bf16* RP = P_RP; const bf16* VP = P_VP; const bf16* KKs = P_KK;
            unsigned char* REC = ws + WS_SBUF;
            const __amdgpu_buffer_rsrc_t rs_w = __builtin_amdgcn_make_buffer_rsrc((void*)DECAY, 0, (int)((size_t)M * RW * 4), 0x00020000), rs_a = __builtin_amdgcn_make_buffer_rsrc((void*)ASIG, 0, (int)((size_t)M * RW * 2), 0x00020000),
                rs_q = __builtin_amdgcn_make_buffer_rsrc((void*)KKs, 0, (int)((size_t)M * RW * 2), 0x00020000), rs_k = __builtin_amdgcn_make_buffer_rsrc((void*)KP, 0, (int)((size_t)M * RW * 2), 0x00020000),
                rs_r = __builtin_amdgcn_make_buffer_rsrc((void*)RP, 0, (int)((size_t)M * RW * 2), 0x00020000);
            LAS unsigned char* wl = lds + wave * 13824;
            const int c16 = lane & 15, g4 = lane >> 4;
            for (int it = gw; it < 8192; it += NGW) {
                const int h = it & 15, c = (it >> 4) & 127, b = it >> 11;
                int ln = lane; asm volatile("" : "+v"(ln));
                const size_t r0 = ((size_t)b * T + c * 16) * RW + h * 64;
                const float kac = (ka->in[24] + l * RW + h * 64)[ln];
                float at[16], rt[16]; unsigned bhp[8], khp[8];
                float Wc = 1.0f;
                {
                    float dw[16]; unsigned short da[16], dq[16], dk[16], dr[16];
#pragma unroll
                    for (int t = 0; t < 16; ++t) { const int r = (int)r0 + t * RW;
                        dw[t] = __builtin_bit_cast(float, __builtin_amdgcn_raw_buffer_load_b32(rs_w, ln * 4, r * 4, 0));
                        da[t] = __builtin_amdgcn_raw_buffer_load_b16(rs_a, ln * 2, r * 2, 0); dq[t] = __builtin_amdgcn_raw_buffer_load_b16(rs_q, ln * 2, r * 2, 0); dk[t] = __builtin_amdgcn_raw_buffer_load_b16(rs_k, ln * 2, r * 2, 0);
                        dr[t] = __builtin_amdgcn_raw_buffer_load_b16(rs_r, ln * 2, r * 2, 0); }
                    __builtin_amdgcn_sched_barrier(0);
#pragma unroll
                    for (int t = 0; t < 16; t += 2) {
                        float bh2[2], kh2[2];
#pragma unroll
                        for (int e = 0; e < 2; ++e) {
                            const float as_ = bf2f(da[t + e]), kk_ = bf2f(dq[t + e]), k_ = bf2f(dk[t + e]), r_ = bf2f(dr[t + e]);
                            const float Wp = Wc; Wc = Wc * dw[t + e]; const float inv = __builtin_amdgcn_rcpf(Wc);
                            at[t + e] = -(Wp * kk_); rt[t + e] = Wc * r_; bh2[e] = kk_ * as_ * inv; kh2[e] = k_ * (1.0f + (as_ - 1.0f) * kac) * inv;
                        }
                        bhp[t >> 1] = cvt_nat(bh2[0], bh2[1]); khp[t >> 1] = cvt_nat(kh2[0], kh2[1]);
                    }
                }
                const __amdgpu_buffer_rsrc_t rs_o = __builtin_amdgcn_make_buffer_rsrc((void*)(REC + (size_t)it * 12288), 0, 12288, 0x00020000);
                {
                    const bool sw = (ln & 8) != 0;
                    v4u lo, hi;
                    lo.x = bhp[0]; lo.y = bhp[1]; lo.z = bhp[2]; lo.w = bhp[3]; hi.x = bhp[4]; hi.y = bhp[5]; hi.z = bhp[6]; hi.w = bhp[7];
                    __builtin_amdgcn_raw_buffer_store_b128(sw ? hi : lo, rs_o, ln * 32 + 4096, 0, 0); __builtin_amdgcn_raw_buffer_store_b128(sw ? lo : hi, rs_o, ln * 32 + 4096 + 16, 0, 0);
                    lo.x = khp[0]; lo.y = khp[1]; lo.z = khp[2]; lo.w = khp[3]; hi.x = khp[4]; hi.y = khp[5]; hi.z = khp[6]; hi.w = khp[7];
                    __builtin_amdgcn_raw_buffer_store_b128(sw ? hi : lo, rs_o, ln * 32 + 6144, 0, 0); __builtin_amdgcn_raw_buffer_store_b128(sw ? lo : hi, rs_o, ln * 32 + 6144 + 16, 0, 0);
                }
                __builtin_amdgcn_raw_buffer_store_b32(__builtin_bit_cast(unsigned, Wc), rs_o, ln * 4, 11264, 0);
#pragma unroll
                for (int t = 0; t < 16; ++t) {
                    *(LAS bf16*)(wl + 0 + t * 144 + ln * 2) = (bf16)(cvt_nat(at[t], 0.f) & 0xffffu);
                    *(LAS bf16*)(wl + 2304 + t * 144 + ln * 2) = (bf16)((t & 1) ? (bhp[t >> 1] >> 16) : (bhp[t >> 1] & 0xffffu));
                    *(LAS bf16*)(wl + 4608 + t * 144 + ln * 2) = (bf16)((t & 1) ? (khp[t >> 1] >> 16) : (khp[t >> 1] & 0xffffu));
                    *(LAS bf16*)(wl + 6912 + t * 144 + ln * 2) = (bf16)(cvt_nat(rt[t], 0.f) & 0xffffu);
                }
                LDS_WAIT(); asm volatile("" ::: "memory");
                {
                    pg8::bf16x8 Aop[2], Bop[2], Kop[2], Rop[2];
#pragma unroll
                    for (int m = 0; m < 2; ++m) { const int o = c16 * 144 + 64 * m + 16 * g4;
                        Aop[m] = *(const LAS pg8::bf16x8*)(wl + 0 + o); Bop[m] = *(const LAS pg8::bf16x8*)(wl + 2304 + o); Kop[m] = *(const LAS pg8::bf16x8*)(wl + 4608 + o); Rop[m] = *(const LAS pg8::bf16x8*)(wl + 6912 + o); }
                    f32x4 nba = {0.f, 0.f, 0.f, 0.f}, nka = nba, nbr = nba, nkr = nba;
#pragma unroll
                    for (int m = 0; m < 2; ++m) {
                        nba = __builtin_amdgcn_mfma_f32_16x16x32_bf16(Aop[m], Bop[m], nba, 0, 0, 0); nka = __builtin_amdgcn_mfma_f32_16x16x32_bf16(Aop[m], Kop[m], nka, 0, 0, 0);
                        nbr = __builtin_amdgcn_mfma_f32_16x16x32_bf16(Rop[m], Bop[m], nbr, 0, 0, 0); nkr = __builtin_amdgcn_mfma_f32_16x16x32_bf16(Rop[m], Kop[m], nkr, 0, 0, 0);
                    }
#pragma unroll
                    for (int e = 0; e < 4; ++e) { const int t = 4 * g4 + e; const bool lt = c16 < t, le = c16 <= t; LAS float* np = (LAS float*)(wl + 9216) + t * 16 + c16;
                        np[0] = lt ? nba[e] : 0.f; np[256] = lt ? nka[e] : 0.f; np[512] = le ? nbr[e] : 0.f; np[768] = le ? nkr[e] : 0.f; }
                }
                LDS_WAIT(); asm volatile("" ::: "memory");
                float a2[16], a4[16];
                {
                    const LAS float* NB_ = (const LAS float*)(wl + 9216);
                    f32x4 nc[4], nn[4]; float rc = NB_[256 + c16], rn = 0.f;
#pragma unroll
                    for (int q = 0; q < 4; ++q) { nc[q] = (f32x4){0.f, 0.f, 0.f, 0.f}; nn[q] = nc[q]; }
#pragma unroll
                    for (int t = 0; t < 16; ++t) {
                        if (t < 15) { rn = NB_[256 + (t + 1) * 16 + c16];
#pragma unroll
                            for (int sq = 0; sq < (t + 4) / 4; ++sq) nn[sq] = *(const LAS f32x4*)(NB_ + (t + 1) * 16 + 4 * sq); }
                        float x1 = at[t], x2 = rc;
#pragma unroll
                        for (int sq = 0; sq < (t + 3) / 4; ++sq) {
#pragma unroll
                            for (int e = 0; e < 4; ++e) if (4 * sq + e < t) { x1 += nc[sq][e] * at[4 * sq + e]; x2 += nc[sq][e] * a2[4 * sq + e]; } }
                        asm volatile("" : "+v"(x1), "+v"(x2) :: "memory");
                        at[t] = x1; a2[t] = x2; rc = rn;
#pragma unroll
                        for (int q = 0; q < 4; ++q) nc[q] = nn[q];
                    }
                    rc = NB_[768 + c16]; nc[0] = *(const LAS f32x4*)(NB_ + 512);
#pragma unroll
                    for (int t = 0; t < 16; ++t) {
                        if (t < 15) { rn = NB_[768 + (t + 1) * 16 + c16];
#pragma unroll
                            for (int sq = 0; sq < (t + 5) / 4; ++sq) nn[sq] = *(const LAS f32x4*)(NB_ + 512 + (t + 1) * 16 + 4 * sq); }
                        float x3 = rt[t], x4 = rc;
#pragma unroll
                        for (int sq = 0; sq < (t + 4) / 4; ++sq) {
#pragma unroll
                            for (int e = 0; e < 4; ++e) if (4 * sq + e <= t) { x3 += nc[sq][e] * at[4 * sq + e]; x4 += nc[sq][e] * a2[4 * sq + e]; } }
                        asm volatile("" : "+v"(x3), "+v"(x4) :: "memory");
                        rt[t] = x3; a4[t] = x4; rc = rn;
#pragma unroll
                        for (int q = 0; q < 4; ++q) nc[q] = nn[q];
                    }
                }
                LDS_WAIT(); asm volatile("" ::: "memory");
#pragma unroll
                for (int t = 0; t < 16; ++t) { const int o = (((ln >> 3) ^ (t >> 1)) << 4) + (ln & 7) * 2;
                    __builtin_amdgcn_raw_buffer_store_b16((bf16)(cvt_nat(at[t], 0.f) & 0xffffu), rs_o, o, t * 128, 0); __builtin_amdgcn_raw_buffer_store_b16((bf16)(cvt_nat(rt[t], 0.f) & 0xffffu), rs_o, o, 2048 + t * 128, 0); }
                if (ln < 16) {
#pragma unroll
                    for (int t = 0; t < 16; ++t) { const int o = (((ln >> 2) ^ (((t >> 3) & 1) << 1)) << 3) + (ln & 3) * 2;
                        __builtin_amdgcn_raw_buffer_store_b16((bf16)(cvt_nat(a2[t], 0.f) & 0xffffu), rs_o, o, 10240 + t * 32, 0); __builtin_amdgcn_raw_buffer_store_b16((bf16)(cvt_nat(a4[t], 0.f) & 0xffffu), rs_o, o, 10752 + t * 32, 0); }
                }
            }
        }
        SEAM(pb + 8); STAMP(pb + 8);
        if (EN(9) && IN(pb + 9)) {
            PH_LOCALS
            constexpr int NB = 10, RECB = 12288, NCH = T / 16;   static_assert(NB * RECB <= LDSCTL_OFF, "chunk ring below the LDS control words");
            const unsigned char* REC = ws + WS_SBUF; bf16* YRAW = P_YRAW;
            for (int item = bid; item < 256; item += G) {
                const int bh = (item & 7) * 8 + (item >> 5), rg = (item >> 3) & 3, b = bh >> 4, h = bh & 15;
                const unsigned char* rbase = REC + ((size_t)b * NCH * 16 + h) * RECB;
                if (wave >= 2) {
                    const int lw = wave - 2;
                    const bool vw = lw == 4;
                    const unsigned char* sbase = vw ? (const unsigned char*)(P_VP + ((size_t)b * T + ((lane & 31) >> 1)) * RW + h * 64 + 16 * rg) + (lane & 1) * 16 : rbase + lw * 2048 + lane * 16;
                    const size_t cstride = vw ? (size_t)16 * RW * 2 : (size_t)16 * RECB; const int o1 = vw ? 0 : 1024;
#define RW_ISSUE(cc) do { const int cc_ = (cc); const int cs_ = cc_ < NCH ? cc_ : NCH - 1; const unsigned char* src_ = sbase + (size_t)cs_ * cstride; \
                        LAS unsigned char* dst_ = lds + (cc_ % NB) * RECB + lw * 2048; \
                        __builtin_amdgcn_global_load_lds((const unsigned*)src_, (LAS unsigned*)dst_, 16, 0, 0); __builtin_amdgcn_global_load_lds((const unsigned*)(src_ + o1), (LAS unsigned*)(dst_ + 1024), 16, 0, 0); } while (0)
#pragma unroll 1
                    for (int cc = 0; cc < NB - 2; ++cc) RW_ISSUE(cc);
#pragma unroll 1
                    for (int c = 0; c < NCH; ++c) {
                        asm volatile("s_waitcnt vmcnt(14)" ::: "memory");   static_assert(2 * (NB - 3) == 14, "counted wait");
                        __builtin_amdgcn_s_barrier();
                        RW_ISSUE(c + NB - 2);
                    }
                    asm volatile("s_waitcnt vmcnt(0)" ::: "memory");
#undef RW_ISSUE
                } else if (wave == 1) {
#pragma unroll 1
                    for (int c = 0; c < NCH; ++c) __builtin_amdgcn_s_barrier();
                } else {
                    const int c16 = lane & 15, g4 = lane >> 4, gs = g4 ^ (((c16 >> 3) & 1) << 1);
                    const int oA0 = c16 * 128 + (((0 + (g4 >> 1)) ^ (c16 >> 1)) << 4) + 8 * (g4 & 1), oA1 = c16 * 128 + (((2 + (g4 >> 1)) ^ (c16 >> 1)) << 4) + 8 * (g4 & 1);
                    const int oA2 = c16 * 128 + (((4 + (g4 >> 1)) ^ (c16 >> 1)) << 4) + 8 * (g4 & 1), oA3 = c16 * 128 + (((6 + (g4 >> 1)) ^ (c16 >> 1)) << 4) + 8 * (g4 & 1);
                    const int oBT = 4096 + c16 * 32 + gs * 8, oVT = 8192 + (4 * g4 + (c16 >> 2)) * 32 + 8 * (c16 & 3), oS2 = 10240 + c16 * 32 + gs * 8, oWL = 11264 + g4 * 16;
                    f32x4 acc0 = {0.f, 0.f, 0.f, 0.f}, acc1 = acc0, acc2 = acc0, acc3 = acc0;
                    bf16* const ybase = YRAW + ((size_t)b * T + 4 * g4) * RW + h * 64 + 16 * rg + c16;
                    struct Ops { v2u a1[4], a3[4], bt[4], kt[4], vt, a2, a4; f32x4 wl[4]; };
#define RW_LD(O_, c_) do { const LAS unsigned char* sb_ = lds + ((c_) % NB) * RECB; \
                        O_.a1[0] = *(const LAS v2u*)(sb_ + oA0); O_.a1[1] = *(const LAS v2u*)(sb_ + oA1); O_.a1[2] = *(const LAS v2u*)(sb_ + oA2); O_.a1[3] = *(const LAS v2u*)(sb_ + oA3); \
                        O_.a3[0] = *(const LAS v2u*)(sb_ + 2048 + oA0); O_.a3[1] = *(const LAS v2u*)(sb_ + 2048 + oA1); O_.a3[2] = *(const LAS v2u*)(sb_ + 2048 + oA2); O_.a3[3] = *(const LAS v2u*)(sb_ + 2048 + oA3); \
                        _Pragma("unroll") for (int jt_ = 0; jt_ < 4; ++jt_) { O_.bt[jt_] = *(const LAS v2u*)(sb_ + oBT + jt_ * 512); O_.kt[jt_] = *(const LAS v2u*)(sb_ + 2048 + oBT + jt_ * 512); O_.wl[jt_] = *(const LAS f32x4*)(sb_ + oWL + jt_ * 64); } \
                        O_.vt = __builtin_bit_cast(v2u, __builtin_amdgcn_ds_read_tr16_b64_v4i16((LAS v4s_*)(sb_ + oVT)));     O_.a2 = *(const LAS v2u*)(sb_ + oS2); O_.a4 = *(const LAS v2u*)(sb_ + 512 + oS2); } while (0)
#define RW_MK(x_, y_, z_, w_) __builtin_bit_cast(pg8::bf16x8, (v4u){(x_), (y_), (z_), (w_)})
#define RW_STEP(O_, c_) do { \
                        const pg8::bf16x8 s0_ = RW_MK(cvt_nat(acc0[0], acc0[1]), cvt_nat(acc0[2], acc0[3]), cvt_nat(acc1[0], acc1[1]), cvt_nat(acc1[2], acc1[3])); \
                        const pg8::bf16x8 s1_ = RW_MK(cvt_nat(acc2[0], acc2[1]), cvt_nat(acc2[2], acc2[3]), cvt_nat(acc3[0], acc3[1]), cvt_nat(acc3[2], acc3[3])); \
                        const pg8::bf16x8 vop_ = RW_MK(O_.vt.x, O_.vt.y, 0u, 0u); \
                        f32x4 u_ = {0.f, 0.f, 0.f, 0.f}, y_ = u_; \
                        u_ = __builtin_amdgcn_mfma_f32_16x16x32_bf16(RW_MK(O_.a1[0].x, O_.a1[0].y, O_.a1[1].x, O_.a1[1].y), s0_, u_, 0, 0, 0); \
                        u_ = __builtin_amdgcn_mfma_f32_16x16x32_bf16(RW_MK(O_.a1[2].x, O_.a1[2].y, O_.a1[3].x, O_.a1[3].y), s1_, u_, 0, 0, 0); \
                        u_ = __builtin_amdgcn_mfma_f32_16x16x32_bf16(RW_MK(O_.a2.x, O_.a2.y, 0u, 0u), vop_, u_, 0, 0, 0); \
                        y_ = __builtin_amdgcn_mfma_f32_16x16x32_bf16(RW_MK(O_.a3[0].x, O_.a3[0].y, O_.a3[1].x, O_.a3[1].y), s0_, y_, 0, 0, 0); \
                        y_ = __builtin_amdgcn_mfma_f32_16x16x32_bf16(RW_MK(O_.a3[2].x, O_.a3[2].y, O_.a3[3].x, O_.a3[3].y), s1_, y_, 0, 0, 0); \
                        y_ = __builtin_amdgcn_mfma_f32_16x16x32_bf16(RW_MK(O_.a4.x, O_.a4.y, 0u, 0u), vop_, y_, 0, 0, 0); \
                        const pg8::bf16x8 uv_ = RW_MK(cvt_nat(u_[0], u_[1]), cvt_nat(u_[2], u_[3]), O_.vt.x, O_.vt.y); \
                        acc0 = __builtin_amdgcn_mfma_f32_16x16x32_bf16(RW_MK(O_.bt[0].x, O_.bt[0].y, O_.kt[0].x, O_.kt[0].y), uv_, acc0, 0, 0, 0); \
                        acc1 = __builtin_amdgcn_mfma_f32_16x16x32_bf16(RW_MK(O_.bt[1].x, O_.bt[1].y, O_.kt[1].x, O_.kt[1].y), uv_, acc1, 0, 0, 0); \
                        acc2 = __builtin_amdgcn_mfma_f32_16x16x32_bf16(RW_MK(O_.bt[2].x, O_.bt[2].y, O_.kt[2].x, O_.kt[2].y), uv_, acc2, 0, 0, 0); \
                        acc3 = __builtin_amdgcn_mfma_f32_16x16x32_bf16(RW_MK(O_.bt[3].x, O_.bt[3].y, O_.kt[3].x, O_.kt[3].y), uv_, acc3, 0, 0, 0); \
                        acc0 *= O_.wl[0]; acc1 *= O_.wl[1]; acc2 *= O_.wl[2]; acc3 *= O_.wl[3]; \
                        bf16* yb_ = ybase + (size_t)(c_) * (16 * RW); \
                        _Pragma("unroll") for (int e_ = 0; e_ < 4; ++e_) yb_[e_ * RW] = (bf16)(cvt_nat(y_[e_], 0.f) & 0xffffu); } while (0)
                    Ops A, B;
                    asm volatile("" ::: "memory"); __builtin_amdgcn_s_barrier(); asm volatile("" ::: "memory");
                    RW_LD(A, 0);
#pragma unroll 1
                    for (int c = 0; c < NCH; c += 2) {
                        asm volatile("" ::: "memory"); __builtin_amdgcn_s_barrier(); asm volatile("" ::: "memory");
                        RW_LD(B, c + 1);
                        RW_STEP(A, c);
                        if (c + 2 < NCH) { asm volatile("" ::: "memory"); __builtin_amdgcn_s_barrier(); asm volatile("" ::: "memory"); RW_LD(A, c + 2); }
                        RW_STEP(B, c + 1);
                    }
#undef RW_LD
#undef RW_MK
#undef RW_STEP
                }
                __syncthreads();
            }
        }
        SEAM(pb + 9); STAMP(pb + 9);
        if (EN(10) && IN(pb + 10)) {
            PH_LOCALS
            const bf16* YRAW = P_YRAW; const bf16* RPp = P_RP; const bf16* KPp = P_KP; const bf16* VPp = P_VP; const bf16* GGp = P_GG; const bf16* ASIGp = P_ASIG; bf16* YRWKV = P_YRWKV;
            const int c = (gw & 3) * 256 + 4 * lane;
            const f32x4 lnw = *(const f32x4*)(ka->in[26] + l * RW + c), lnb = *(const f32x4*)(ka->in[27] + l * RW + c), rk4 = *(const f32x4*)(ka->in[25] + l * RW + c), ka4 = *(const f32x4*)(ka->in[24] + l * RW + c);
            static_assert((M * 4) % 4 == 0, "row quarters");
#pragma unroll 1
            for (int it0 = gw; it0 < M * 4; it0 += 4 * NGW) {
                v2u y4[4], r4[4], k4[4], a4_[4], v4[4], g4_[4];
#pragma unroll
                for (int u = 0; u < 4; ++u) { const int it = it0 + u * NGW; const size_t p = (size_t)(it < M * 4 ? it : it0) * 256 + 4 * lane;
                    y4[u] = *(const v2u*)(YRAW + p); r4[u] = *(const v2u*)(RPp + p); k4[u] = *(const v2u*)(KPp + p); a4_[u] = *(const v2u*)(ASIGp + p); v4[u] = *(const v2u*)(VPp + p); g4_[u] = *(const v2u*)(GGp + p); }
#pragma unroll
                for (int u = 0; u < 4; ++u) { const int it = it0 + u * NGW; if (it < M * 4) {
                    const size_t p = (size_t)it * 256 + 4 * lane;
                    const v2u y_ = y4[u], r_ = r4[u], k_ = k4[u], a_ = a4_[u], v_ = v4[u], g_ = g4_[u];
                    const f32x4 y = {bflo(y_.x), bfhi(y_.x), bflo(y_.y), bfhi(y_.y)};
                    const f32x4 r = {bflo(r_.x), bfhi(r_.x), bflo(r_.y), bfhi(r_.y)}, kp = {bflo(k_.x), bfhi(k_.x), bflo(k_.y), bfhi(k_.y)}, as = {bflo(a_.x), bfhi(a_.x), bflo(a_.y), bfhi(a_.y)},
                                v = {bflo(v_.x), bfhi(v_.x), bflo(v_.y), bfhi(v_.y)}, gg = {bflo(g_.x), bfhi(g_.x), bflo(g_.y), bfhi(g_.y)};
                    const float mean = row16_sum((y[0] + y[1]) + (y[2] + y[3])) * (1.0f / 64);
                    const f32x4 d = y - mean;
                    const float var = row16_sum((d[0] * d[0] + d[1] * d[1]) + (d[2] * d[2] + d[3] * d[3])) * (1.0f / 64);
                    const float rs = rsqrtf(var + 64e-5f);
                    const f32x4 kf = kp * (1.0f + (as - 1.0f) * ka4);
                    const f32x4 t = r * kf * rk4;
                    const float rk = row16_sum((t[0] + t[1]) + (t[2] + t[3]));
                    const f32x4 o = ((d * rs) * lnw + lnb + rk * v) * gg;
                    v2u w; w.x = cvt_pk_bf16(o[0], o[1]); w.y = cvt_pk_bf16(o[2], o[3]);
                    *(v2u*)(YRWKV + p) = w; } }
            }
        }
        SEAM(pb + 10); STAMP(pb + 10);
        if (EN(11) && IN(pb + 11)) {
            PH_LOCALS
            pg8::Gemm g{P_YS5, (const bf16*)(ws + W_BS5), M, D, 1024, 1024, 1024};
            pg8::Seg3Order S; S.init(M, D, G, bid);
            S.A0 = P_YS5; S.B0 = (const bf16*)(ws + W_BS5); S.dA1 = (long)WS_MERGED - (long)WS_YS5; S.dA2 = (long)WS_YRWKV - (long)WS_YS5; S.dB1 = (long)W_BAT2 - (long)W_BS5; S.dB2 = (long)W_BRW - (long)W_BS5;
            S.K0 = 1024; S.K1 = 512; S.K2 = 1024;
            EpiBranch3 E{P_PROJ, P_MERGEDB};
            pg8::gemm_phase<EpiBranch3, pg8::Seg3Order, true, true>(lds + RING_OFF, g, S, E, tid);
        }
        SEAM(pb + 11); STAMP(pb + 11);
        if (EN(12) && IN(pb + 12)) {
            PH_LOCALS
            pg8::Gemm g{P_MERGEDB, (const bf16*)(ws + W_OUT), M, D, D, D, D}; pg8::StaticOrder S; S.init(M, D, G, bid);
            EpiResid E{nullptr, nullptr, P_XB, P_XL, P_SS + (size_t)(3 * l + 2) * M * 32, 1.0f, 1.0f, 0.0f};
            pg8::gemm_phase<EpiResid, pg8::StaticOrder, true, true>(lds + RING_OFF, g, S, E, tid);
        }
        SEAM(pb + 12); STAMP(pb + 12);
        if (EN(13) && IN(pb + 13)) {
            PH_LOCALS
            pg8::Gemm g{P_XB, (const bf16*)(ws + W_UP2), M, NUP, D, D, D}; pg8::StaticOrder S; S.init(M, NUP, G, bid);
            EpiSwiGLU E{P_HID, P_SS + (size_t)(3 * l + 2) * M * 32};
            pg8::gemm_phase<EpiSwiGLU, pg8::StaticOrder, true, true>(lds + RING_OFF, g, S, E, tid);
        }
        SEAM(pb + 13); STAMP(pb + 13);
        if (EN(14) && IN(pb + 14)) {
            PH_LOCALS
            pg8::Gemm g{P_HID, (const bf16*)(ws + W_DN2), M, D, DFF, DFF, DFF}; pg8::StaticOrder S; S.init(M, D, G, bid);
            float psc = 1.0f, psp = 0.0f;
            if (PROBE_ON && l == DEPTH - 1) { const unsigned* a_ = (const unsigned*)(ws + WS_CTL + 128 * 1024); if (PROBE_A >= 0) psc = 1.0f + 1e-5f * (float)a_[PROBE_A >= 0 ? PROBE_A : 0]; if (PROBE_B >= 0) psp = 1e-4f * (float)a_[PROBE_B >= 0 ? PROBE_B : 0]; }
            EpiResid E{nullptr, l == DEPTH - 1 ? ka->out : nullptr, P_XB, P_XL, P_SS + (size_t)(3 * l + 3) * M * 32, 0.5f, psc, psp};
            pg8::gemm_phase<EpiResid, pg8::StaticOrder, true, true>(lds + RING_OFF, g, S, E, tid);
        }
        SEAM(pb + 14); STAMP(pb + 14);
    }
#undef IN
#undef SEAM
}

extern "C" void kernel_launch(void* const* d_in, const int* in_sizes, int n_in, void* d_out, int out_size, void* d_ws, size_t ws_size, hipStream_t stream) {
    static int grid = 0;
    if (grid == 0) {
        if (n_in != 38 || in_sizes[0] != M * D || out_size != M * D || ws_size < WS_END) {
            fprintf(stderr, "kernel_launch: unexpected shapes/workspace (n_in %d, in0 %d, out %d, ws %zu, need %zu); nothing launched\n", n_in, n_in > 0 ? in_sizes[0] : -1, out_size, ws_size, (size_t)WS_END); grid = -1; return; }
        int dev = 0, cus = 0, per_cu = 0;
        if (hipGetDevice(&dev) != hipSuccess || hipDeviceGetAttribute(&cus, hipDeviceAttributeMultiprocessorCount, dev) != hipSuccess) { grid = -1; return; }
        if (hipFuncSetAttribute((const void*)mk_fwd, hipFuncAttributeMaxDynamicSharedMemorySize, LDS_BYTES) != hipSuccess) { fprintf(stderr, "kernel_launch: hipFuncSetAttribute failed\n"); grid = -1; return; }
        if (hipOccupancyMaxActiveBlocksPerMultiprocessor(&per_cu, (const void*)mk_fwd, NWAVES * 64, LDS_BYTES) != hipSuccess || per_cu < 1)
            fprintf(stderr, "kernel_launch: note: occupancy query reports %d workgroups per CU\n", per_cu);
        (void)hipGetLastError();
        grid = cus;
    }
    if (grid < 0) return;
    if (hipMemsetAsync((char*)d_ws + WS_CTL, 0, CTL_ZERO_BYTES, stream) != hipSuccess) { fprintf(stderr, "kernel_launch: memset failed\n"); return; }
#ifdef DBG_ZERO_WS
    (void)hipMemsetAsync((char*)d_ws + CTL_ZERO_BYTES, 0, WS_END - CTL_ZERO_BYTES, stream);
#endif
    Args a{};
    for (int i = 0; i < 38; ++i) a.in[i] = (const float*)d_in[i];
    a.out = (float*)d_out; a.ws = (unsigned char*)d_ws; a.pad = 0;
#if MK_ONE_LAUNCH
    a.ph_lo = 0; a.ph_hi = NPHASES; a.use_bar = 1;
    hipLaunchKernelGGL(mk_fwd, dim3(grid), dim3(NWAVES * 64), LDS_BYTES, stream, a);
#else
    for (int ph = 0; ph < NPHASES; ++ph) {
        a.ph_lo = ph; a.ph_hi = ph + 1; a.use_bar = 0;
        hipLaunchKernelGGL(mk_fwd, dim3(grid), dim3(NWAVES * 64), LDS_BYTES, stream, a);
    }
#endif
    const hipError_t le = hipPeekAtLastError();
    if (le != hipSuccess) fprintf(stderr, "kernel_launch: launch failed: %s\n", hipGetErrorName(le));
}
```
